# Optimizing an MI355X kernel written in HIP

```python
import math
import jax, jax.numpy as jnp
from jax import lax
import numpy as np

D_MODEL = 1024
BATCH = 8
SEQ = 2048
DEPTH = 1

N_META = 16
CHUNK = 64
RET_HEADS = 4
RET_DK = 256
RET_DV = 512
RET_QK = RET_HEADS * RET_DK
RET_V = RET_HEADS * RET_DV
ROPE_BASE = 10000.0
DN_HEADS = 8
DN_DK = 128
DN_DV = 128
DN_QK = DN_HEADS * DN_DK
DN_V = DN_HEADS * DN_DV
CONV_WIDTH = 5
DN_CONV_CH = 2 * DN_QK + DN_V
PEER_HEADS = 8
PEER_NKEYS = 128
PEER_DQ = 256
PEER_TOPK = 16
N_EXPERTS = PEER_NKEYS * PEER_NKEYS
IN_WIDTH = 2 * RET_QK + 2 * RET_V + 2 * DN_QK + 2 * DN_V + 4 * DN_HEADS + 2 * D_MODEL
DEEPNORM_ALPHA = (2.0 * DEPTH) ** 0.25
DEEPNORM_BETA = (8.0 * DEPTH) ** -0.25
LN_EPS = 1e-5
RMS_EPS = 1e-6

kernel_name = "hybrid_retention_gdn_peer_encoder"


def layer_norm(x, g=None, b=None):
    xf = x.astype(jnp.float32)
    mu = jnp.mean(xf, -1, keepdims=True)
    var = jnp.mean(jnp.square(xf - mu), -1, keepdims=True)
    y = (xf - mu) * lax.rsqrt(var + LN_EPS)
    if g is not None:
        y = y * g.astype(jnp.float32) + b.astype(jnp.float32)
    return y.astype(x.dtype)


def rms_norm(x, g):
    xf = x.astype(jnp.float32)
    y = xf * lax.rsqrt(jnp.mean(jnp.square(xf), -1, keepdims=True) + RMS_EPS)
    return (y * g.astype(jnp.float32)).astype(x.dtype)


def l2norm(x):
    xf = x.astype(jnp.float32)
    return (xf * lax.rsqrt(jnp.sum(jnp.square(xf), -1, keepdims=True) + RMS_EPS)).astype(x.dtype)


def rotary(x, pos):
    d = x.shape[-1]
    inv = 1.0 / (ROPE_BASE ** (jnp.arange(0, d, 2, dtype=jnp.float32) / d))
    ang = pos.astype(jnp.float32)[:, None] * inv[None, :]
    cos = jnp.cos(ang)[None, :, None, :]
    sin = jnp.sin(ang)[None, :, None, :]
    x1, x2 = jnp.split(x.astype(jnp.float32), 2, axis=-1)
    return jnp.concatenate([x1 * cos - x2 * sin, x1 * sin + x2 * cos], -1).astype(x.dtype)


def depthwise_conv(x, w):
    W = w.shape[0]
    return lax.conv_general_dilated(
        x, w[:, None, :].astype(x.dtype), (1,), [((W - 1) // 2, W // 2)],
        dimension_numbers=('NWC', 'WIO', 'NWC'), feature_group_count=x.shape[-1])


def to_chunks(t, front):
    B, L = t.shape[:2]
    pad = (-L) % CHUNK
    widths = [(0, 0), (pad, 0) if front else (0, pad)] + [(0, 0)] * (t.ndim - 2)
    t = jnp.pad(t, widths)
    n = (L + pad) // CHUNK
    t = t.reshape((B, n, CHUNK) + t.shape[2:])
    return t.transpose((1, 0, 3, 2) + tuple(range(4, t.ndim)))


def from_chunks(o, L, front):
    N, B, H, C, d = o.shape
    o = o.transpose(1, 0, 3, 2, 4).reshape(B, N * C, H, d)
    pad = N * C - L
    return o[:, pad:] if front else o[:, :L]


def chunked_retention(q, k, v, logdec, strict):
    C = q.shape[-2]
    b = jnp.cumsum(logdec, axis=-1)
    mask = jnp.tril(jnp.ones((C, C), bool), -1 if strict else 0)
    diff = b[..., :, None] - b[..., None, :]
    dmat = jnp.where(mask, jnp.exp(jnp.where(mask, diff, 0.0)), 0.0)
    scores = jnp.einsum('nbhid,nbhjd->nbhij', q, k) * dmat
    o_intra = jnp.einsum('nbhij,nbhjv->nbhiv', scores, v)
    q_dec = q * jnp.exp(b)[..., None]
    k_dec = k * jnp.exp(b[..., -1:] - b)[..., None]
    chunk_dec = jnp.exp(b[..., -1])

    def step(S, inp):
        qd, kd, vc, cd = inp
        o = jnp.einsum('bhid,bhdv->bhiv', qd, S)
        S = S * cd[..., None, None] + jnp.einsum('bhjd,bhjv->bhdv', kd, vc)
        return S, o

    S0 = jnp.zeros(q.shape[1:3] + (q.shape[-1], v.shape[-1]), q.dtype)
    _, o_inter = lax.scan(step, S0, (q_dec, k_dec, v, chunk_dec))
    return o_intra + o_inter


def chunked_gated_delta(q, k, v, g, beta):
    C = q.shape[-2]
    dv = v.shape[-1]
    b = jnp.cumsum(g, axis=-1)
    incl = jnp.tril(jnp.ones((C, C), bool), 0)
    strict = jnp.tril(jnp.ones((C, C), bool), -1)
    diff = b[..., :, None] - b[..., None, :]
    dec = jnp.where(incl, jnp.exp(jnp.where(incl, diff, 0.0)), 0.0)
    k_beta = k * beta[..., None]
    A = jnp.where(strict, jnp.einsum('nbhid,nbhjd->nbhij', k_beta, k) * dec, 0.0)
    lhs = A + jnp.eye(C, dtype=A.dtype)
    rhs = jnp.concatenate([v * beta[..., None], k_beta * jnp.exp(b)[..., None]], -1)
    sol = lax.linalg.triangular_solve(lhs.astype(jnp.float32), rhs.astype(jnp.float32),
                                      left_side=True, lower=True, unit_diagonal=True).astype(q.dtype)
    u, w = sol[..., :dv], sol[..., dv:]
    attn = jnp.einsum('nbhid,nbhjd->nbhij', q, k) * dec
    q_dec = q * jnp.exp(b)[..., None]
    k_dec = k * jnp.exp(b[..., -1:] - b)[..., None]
    chunk_dec = jnp.exp(b[..., -1])

    def step(S, inp):
        qd, kd, ac, uc, wc, cd = inp
        v_new = uc - jnp.einsum('bhid,bhdv->bhiv', wc, S)
        o = jnp.einsum('bhid,bhdv->bhiv', qd, S) + jnp.einsum('bhij,bhjv->bhiv', ac, v_new)
        S = S * cd[..., None, None] + jnp.einsum('bhjd,bhjv->bhdv', kd, v_new)
        return S, o

    S0 = jnp.zeros(q.shape[1:3] + (q.shape[-1], dv), q.dtype)
    _, o = lax.scan(step, S0, (q_dec, k_dec, attn, u, w, chunk_dec))
    return o


def retention_branch(q, k, v, gate, pos, decay_logit):
    B, L, _ = q.shape
    q = rotary(q.reshape(B, L, RET_HEADS, RET_DK), pos)
    k = rotary(k.reshape(B, L, RET_HEADS, RET_DK), pos) * (RET_DK ** -0.5)
    v = v.reshape(B, L, RET_HEADS, RET_DV)
    logdec = jax.nn.log_sigmoid(decay_logit.astype(jnp.float32)).astype(q.dtype)
    out = jnp.zeros_like(v)
    for d in range(2):
        bwd = d == 1
        seq = (lambda t: jnp.flip(t, 1)) if bwd else (lambda t: t)
        ld = jnp.broadcast_to(logdec[d], (B, L, RET_HEADS))
        o = chunked_retention(to_chunks(seq(q), not bwd), to_chunks(seq(k), not bwd),
                              to_chunks(seq(v), not bwd), to_chunks(ld, not bwd), strict=bwd)
        out = out + seq(from_chunks(o, L, not bwd))
    o = layer_norm(out).reshape(B, L, RET_V)
    return o * jax.nn.silu(gate)


def deltanet_branch(q, k, v, z, a, bgate, conv_w, a_log, dt_bias, norm_g):
    B, L, _ = q.shape
    qkv = jax.nn.silu(depthwise_conv(jnp.concatenate([q, k, v], -1), conv_w))
    q, k, v = jnp.split(qkv, [DN_QK, 2 * DN_QK], axis=-1)
    q = l2norm(q.reshape(B, L, DN_HEADS, DN_DK)) * (DN_DK ** -0.5)
    k = l2norm(k.reshape(B, L, DN_HEADS, DN_DK))
    v = v.reshape(B, L, DN_HEADS, DN_DV)
    a = a.reshape(B, L, 2, DN_HEADS)
    bgate = bgate.reshape(B, L, 2, DN_HEADS)
    g = -jnp.exp(a_log) * jax.nn.softplus(a + dt_bias)
    beta = jax.nn.sigmoid(bgate)
    out = jnp.zeros_like(v)
    for d in range(2):
        bwd = d == 1
        seq = (lambda t: jnp.flip(t, 1)) if bwd else (lambda t: t)
        o = chunked_gated_delta(to_chunks(seq(q), not bwd), to_chunks(seq(k), not bwd),
                                to_chunks(seq(v), not bwd), to_chunks(seq(g[:, :, d]), not bwd),
                                to_chunks(seq(beta[:, :, d]), not bwd))
        out = out + seq(from_chunks(o, L, not bwd))
    o = rms_norm(out, norm_g).reshape(B, L, DN_V)
    return o * jax.nn.silu(z)


def hybrid_mixer(h, pos, w_in, ret_decay_logit, dn_conv, dn_a_log, dn_dt_bias, dn_norm_g, p_ret, p_dn, w_out):
    sizes = [RET_QK, RET_QK, RET_V, RET_V, DN_QK, DN_QK, DN_V, DN_V,
             2 * DN_HEADS, 2 * DN_HEADS, D_MODEL, D_MODEL]
    points = [int(s) for s in np.cumsum(sizes)[:-1]]
    proj = h @ w_in
    (rq, rk, rv, rg, dq, dk, dv, dz, da, db, gate_a, gate_b) = jnp.split(proj, points, axis=-1)
    y_ret = retention_branch(rq, rk, rv, rg, pos, ret_decay_logit)
    y_dn = deltanet_branch(dq, dk, dv, dz, da, db, dn_conv, dn_a_log, dn_dt_bias, dn_norm_g)
    merged = jax.nn.sigmoid(gate_a) * (y_ret @ p_ret) + jax.nn.sigmoid(gate_b) * (y_dn @ p_dn)
    return merged @ w_out


def peer_ffn(x, w_q, sub_keys, u_tab, v_tab):
    B, L, _ = x.shape
    K = PEER_TOPK
    q = (x @ w_q).reshape(B, L, PEER_HEADS, 2, PEER_DQ // 2)
    s = jnp.einsum('blhpd,hpnd->blhpn', q, sub_keys)
    s_top, i_top = lax.top_k(s, K)
    cand = (s_top[..., 0, :, None] + s_top[..., 1, None, :]).reshape(B, L, PEER_HEADS, K * K)
    best, flat = lax.top_k(cand, K)
    i1 = jnp.take_along_axis(i_top[..., 0, :], flat // K, axis=-1)
    i2 = jnp.take_along_axis(i_top[..., 1, :], flat % K, axis=-1)
    expert = i1 * PEER_NKEYS + i2
    gate = jax.nn.softmax(best.astype(jnp.float32), axis=-1).astype(x.dtype)

    def per_batch(args):
        xb, eb, gb = args

        def per_head(hargs):
            e, g = hargs
            act = jax.nn.gelu(jnp.einsum('ld,lkd->lk', xb, u_tab[e]), approximate=False)
            return jnp.einsum('lk,lkd->ld', act * g, v_tab[e])

        return jnp.sum(lax.map(per_head, (eb.transpose(1, 0, 2), gb.transpose(1, 0, 2))), axis=0)

    return lax.map(per_batch, (x, expert, gate))


def setup_inputs(seed: int = 0) -> dict:
    key = jax.random.key(seed)
    ks = jax.random.split(key, 24)
    f32 = jnp.float32

    def nrm(k, shape, scale):
        return jax.random.normal(k, shape, f32) * scale

    x = nrm(ks[0], (BATCH, SEQ, D_MODEL), 1.0)
    meta_tokens = nrm(ks[1], (N_META, D_MODEL), 1.0)
    emb_ln_g = 1.0 + nrm(ks[2], (D_MODEL,), 0.02)
    emb_ln_b = nrm(ks[3], (D_MODEL,), 0.02)
    w_in = nrm(ks[4], (DEPTH, D_MODEL, IN_WIDTH), D_MODEL ** -0.5)
    gam = 1.0 - 2.0 ** (-5.0 - jnp.arange(RET_HEADS, dtype=f32))
    ret_decay_logit = (jnp.log(gam) - jnp.log1p(-gam))[None, None, :] + nrm(ks[5], (DEPTH, 2, RET_HEADS), 0.05)
    dn_conv = nrm(ks[6], (DEPTH, CONV_WIDTH, DN_CONV_CH), CONV_WIDTH ** -0.5)
    dn_a_log = jnp.log(jax.random.uniform(ks[7], (DEPTH, 2, DN_HEADS), f32, 1.0, 16.0))
    dt = jnp.exp(jax.random.uniform(ks[8], (DEPTH, 2, DN_HEADS), f32, math.log(1e-3), math.log(1e-1)))
    dn_dt_bias = dt + jnp.log(-jnp.expm1(-dt))
    dn_norm_g = 1.0 + nrm(ks[9], (DEPTH, DN_DV), 0.02)
    p_ret = nrm(ks[10], (DEPTH, RET_V, D_MODEL), RET_V ** -0.5)
    p_dn = nrm(ks[11], (DEPTH, DN_V, D_MODEL), DN_V ** -0.5)
    w_out = nrm(ks[12], (DEPTH, D_MODEL, D_MODEL), DEEPNORM_BETA * D_MODEL ** -0.5)
    ln1_g = 1.0 + nrm(ks[13], (DEPTH, D_MODEL), 0.02)
    ln1_b = nrm(ks[14], (DEPTH, D_MODEL), 0.02)
    peer_wq = nrm(ks[15], (DEPTH, D_MODEL, PEER_HEADS * PEER_DQ), D_MODEL ** -0.5)
    peer_keys = nrm(ks[16], (DEPTH, PEER_HEADS, 2, PEER_NKEYS, PEER_DQ // 2), (PEER_DQ // 2) ** -0.5)
    peer_u = nrm(ks[17], (DEPTH, N_EXPERTS, D_MODEL), D_MODEL ** -0.5)
    peer_v = nrm(ks[18], (DEPTH, N_EXPERTS, D_MODEL), DEEPNORM_BETA)
    ln2_g = 1.0 + nrm(ks[19], (DEPTH, D_MODEL), 0.02)
    ln2_b = nrm(ks[20], (DEPTH, D_MODEL), 0.02)
    return {"x": x, "meta_tokens": meta_tokens, "emb_ln_g": emb_ln_g, "emb_ln_b": emb_ln_b,
            "w_in": w_in, "ret_decay_logit": ret_decay_logit, "dn_conv": dn_conv,
            "dn_a_log": dn_a_log, "dn_dt_bias": dn_dt_bias, "dn_norm_g": dn_norm_g,
            "p_ret": p_ret, "p_dn": p_dn, "w_out": w_out, "ln1_g": ln1_g, "ln1_b": ln1_b,
            "peer_wq": peer_wq, "peer_keys": peer_keys, "peer_u": peer_u, "peer_v": peer_v,
            "ln2_g": ln2_g, "ln2_b": ln2_b}


def reference(x, meta_tokens, emb_ln_g, emb_ln_b, w_in, ret_decay_logit, dn_conv, dn_a_log, dn_dt_bias,
              dn_norm_g, p_ret, p_dn, w_out, ln1_g, ln1_b, peer_wq, peer_keys, peer_u, peer_v, ln2_g, ln2_b):
    B = x.shape[0]
    meta = jnp.broadcast_to(meta_tokens[None].astype(x.dtype), (B, N_META, D_MODEL))
    h = layer_norm(jnp.concatenate([meta, x], axis=1), emb_ln_g, emb_ln_b)
    pos = jnp.arange(h.shape[1])
    for l in range(DEPTH):
        y = hybrid_mixer(h, pos, w_in[l], ret_decay_logit[l], dn_conv[l], dn_a_log[l], dn_dt_bias[l],
                         dn_norm_g[l], p_ret[l], p_dn[l], w_out[l])
        h = layer_norm(DEEPNORM_ALPHA * h + y, ln1_g[l], ln1_b[l])
        y = peer_ffn(h, peer_wq[l], peer_keys[l], peer_u[l], peer_v[l])
        h = layer_norm(DEEPNORM_ALPHA * h + y, ln2_g[l], ln2_b[l])
    return h[:, N_META:]
```

```cpp
#include <hip/hip_runtime.h>
#include <cstdio>
#include <cstdint>
namespace pg8 {
#define PG8_LAS __attribute__((address_space(3)))
typedef unsigned short bf16_t;
typedef short bf16x8 __attribute__((ext_vector_type(8)));
typedef float f32x4 __attribute__((ext_vector_type(4)));
typedef unsigned u32x4 __attribute__((ext_vector_type(4)));
constexpr int BM = 256, BK = 64, HALF = 128, HTB = HALF * BK * 2  , STAGE_BYTES = 8 * HTB, NXCD = 8, WGM = 8;

__host__ __device__ __forceinline__ int lds_byte(int r, int c) { const int st = (r >> 4) * 2 + (c >> 5), rr = r & 15, cc = c & 31, ob = rr * 64 + cc * 2; return st * 1024 + (ob ^ (((ob >> 9) & 1) << 5)); }
__host__ __device__ __forceinline__ void stage_rc(int b, int& R, int& C) { const int st = b / 1024, sb = b % 1024, swz = sb ^ (((sb >> 9) & 1) << 5); R = (st >> 1) * 16 + swz / 64; C = (st & 1) * 32 + (swz % 64) / 2; }
__host__ __device__ __forceinline__ int perm32(int rho) { const int n = rho >> 4, i = rho & 15; return 8 * (i >> 2) + 4 * n + (i & 3); }

struct Unit { int pm, pn; };
struct Gemm { const bf16_t* A; const bf16_t* Bt; int M, N, K; };

struct StaticOrder {
    int nM, nN, nwg, G, c;
    __host__ __device__ void init(int M, int N, int G_, int c_) { nM = M / BM; nN = N / BM; nwg = nM * nN; G = G_; c = c_; }
    __host__ __device__ bool next(int i, Unit& u) const {
        const long L = (long)i * G + c; if (L >= nwg) return false;
        int wgid = (int)L; { const int q = nwg / NXCD, r = nwg % NXCD, xcd = wgid % NXCD, off = wgid / NXCD; wgid = (xcd < r ? xcd * (q + 1) : r * (q + 1) + (xcd - r) * q) + off; }
        const int nig = WGM * nN, gid = wgid / nig, fm = gid * WGM, gsz = (nM - fm) < WGM ? (nM - fm) : WGM;
        u.pm = fm + ((wgid % nig) % gsz); u.pn = (wgid % nig) / gsz; return true;
    }
    __device__ __forceinline__ void a_ready(const Unit&) const {}
    __device__ __forceinline__ void done(const Unit&) const {}
};
__device__ __forceinline__ unsigned cvt_pk_bf16(float lo, float hi) { unsigned r; asm volatile("v_cvt_pk_bf16_f32 %0, %1, %2" : "=v"(r) : "v"(lo), "v"(hi)); return r; }
template <class Epi, class Sched, bool ALIGN_EPI = false, bool SP2 = false>
__device__ __forceinline__ void gemm_phase(PG8_LAS unsigned char* lds, const Gemm g, const Sched& S, const Epi& E) {
    const int tid = threadIdx.x, wid = __builtin_amdgcn_readfirstlane(tid >> 6), lane = tid & 63, wr = wid >> 2, wc = wid & 3, fr = lane & 15, fq = lane >> 4;
    const int K = g.K, nt = K / BK;
    unsigned voffA[2], voffB[2];
#pragma unroll
    for (int i = 0; i < 2; ++i) { int R, C; stage_rc(tid * 16 + i * 8192, R, C); const int Rb = Epi::PERM ? ((R & ~31) + perm32(R & 31)) : R;
        voffA[i] = (unsigned)(R * K + C) * 2u; voffB[i] = (unsigned)(Rb * K + C) * 2u; }
    const size_t kstep = (size_t)(BK * 2);
    const size_t hstep = (size_t)HALF * K * 2;
    const size_t tstep = 2 * hstep;
    const unsigned ldsw = (unsigned)wid * 1024u;
    const int aoff = lds_byte(wr * 64 + fr, fq * 8), boff = lds_byte(wc * 32 + fr, fq * 8);
#define PG8_SA(b, h) (((b) * 2 + (h)) * HTB)
#define PG8_SB(b, h) ((4 + (b) * 2 + (h)) * HTB)
#define PG8_STAGE(bufoff, gbase, voff) do { _Pragma("unroll") for (int _i = 0; _i < 2; ++_i) \
        __builtin_amdgcn_global_load_lds((const unsigned*)((const char*)(gbase) + (voff)[_i]), (PG8_LAS unsigned*)(lds + (bufoff) + ldsw + _i * 8192), 16, 0, 0); } while (0)
#define PG8_LDA(dst, b, h) do { _Pragma("unroll") for (int m = 0; m < 4; ++m) _Pragma("unroll") for (int k = 0; k < 2; ++k) dst[m][k] = *(const PG8_LAS bf16x8*)(lds + PG8_SA(b, h) + aoff + m * 2048 + k * 1024); } while (0)
#define PG8_LDB(dst, b, h) do { _Pragma("unroll") for (int n = 0; n < 2; ++n) _Pragma("unroll") for (int k = 0; k < 2; ++k) dst[n][k] = *(const PG8_LAS bf16x8*)(lds + PG8_SB(b, h) + boff + n * 2048 + k * 1024); } while (0)
#define PG8_MMA(ai, bj, At, Bt) do { __builtin_amdgcn_s_setprio(1); _Pragma("unroll") for (int m = 0; m < 4; ++m) _Pragma("unroll") for (int n = 0; n < 2; ++n) _Pragma("unroll") for (int k = 0; k < 2; ++k) \
        acc[ai][bj][m][n] = __builtin_amdgcn_mfma_f32_16x16x32_bf16(Bt[n][k], At[m][k], acc[ai][bj][m][n], 0, 0, 0); __builtin_amdgcn_s_setprio(0); } while (0)
#define PG8_WAIT_V(n) asm volatile("s_waitcnt vmcnt(" #n ")" ::: "memory")
#define PG8_WAIT_L(n) asm volatile("s_waitcnt lgkmcnt(" #n ")" ::: "memory")
#define PG8_BAR __builtin_amdgcn_s_barrier()
#define PG8_SCHED __builtin_amdgcn_sched_barrier(0)
    Unit cur, nxt; int ui = 0;
    if (!S.next(0, cur)) return;
    f32x4 acc[2][2][4][2];
#pragma unroll
    for (int a = 0; a < 2; ++a)
#pragma unroll
        for (int b = 0; b < 2; ++b)
#pragma unroll
            for (int m = 0; m < 4; ++m)
#pragma unroll
                for (int n = 0; n < 2; ++n) acc[a][b][m][n] = (f32x4){0.f, 0.f, 0.f, 0.f};
    bf16x8 At[4][2], B0[2][2], B1[2][2];
    const char* cA = (const char*)g.A + (size_t)cur.pm * tstep; const char* cB = (const char*)g.Bt + (size_t)cur.pn * tstep;
    S.a_ready(cur);
    if constexpr (SP2) {
        PG8_STAGE(PG8_SB(0, 0), cB, voffB); PG8_STAGE(PG8_SB(0, 1), cB + hstep, voffB); PG8_STAGE(PG8_SA(0, 0), cA, voffA); PG8_STAGE(PG8_SA(0, 1), cA + hstep, voffA);
        if (wr == 1) PG8_BAR;
        PG8_WAIT_V(2); PG8_BAR;
        PG8_STAGE(PG8_SB(1, 0), cB + kstep, voffB); PG8_STAGE(PG8_SA(1, 0), cA + kstep, voffA); PG8_STAGE(PG8_SB(1, 1), cB + hstep + kstep, voffB);
        PG8_WAIT_V(6); PG8_BAR;
    } else {
        PG8_STAGE(PG8_SB(0, 0), cB, voffB); PG8_STAGE(PG8_SA(0, 0), cA, voffA); PG8_STAGE(PG8_SB(0, 1), cB + hstep, voffB); PG8_STAGE(PG8_SA(0, 1), cA + hstep, voffA);
        if (wr == 1) PG8_BAR;
        PG8_WAIT_V(4); PG8_BAR;
        PG8_STAGE(PG8_SB(1, 0), cB + kstep, voffB); PG8_STAGE(PG8_SA(1, 0), cA + kstep, voffA); PG8_STAGE(PG8_SB(1, 1), cB + hstep + kstep, voffB);
        PG8_WAIT_V(6); PG8_BAR;
    }
    for (;;) {
        const bool has_next = S.next(ui + 1, nxt);
        const char* nA = has_next ? (const char*)g.A + (size_t)nxt.pm * tstep : cA; const char* nB = has_next ? (const char*)g.Bt + (size_t)nxt.pn * tstep : cB;
        for (int t = 0; t < nt; t += 2) {
            const bool last = (t == nt - 2);
            const char* a1 = cA + (size_t)(t + 1) * kstep;
            const char* a2 = last ? nA : cA + (size_t)(t + 2) * kstep; const char* b2 = last ? nB : cB + (size_t)(t + 2) * kstep;
            const char* a3 = a2 + kstep; const char* b3 = b2 + kstep;
            if (last && has_next) S.a_ready(nxt);
            if constexpr (SP2) {
            PG8_LDB(B0, 0, 0); PG8_LDB(B1, 0, 1); PG8_SCHED; PG8_LDA(At, 0, 0); PG8_STAGE(PG8_SA(1, 1), a1 + hstep, voffA);
            PG8_WAIT_V(8); PG8_WAIT_L(0); PG8_BAR; PG8_MMA(0, 0, At, B0); PG8_MMA(0, 1, At, B1); PG8_BAR; PG8_SCHED;
            PG8_LDA(At, 0, 1); PG8_STAGE(PG8_SB(0, 0), b2, voffB); PG8_STAGE(PG8_SB(0, 1), b2 + hstep, voffB); PG8_STAGE(PG8_SA(0, 0), a2, voffA);
            PG8_WAIT_V(8); PG8_WAIT_L(0); PG8_BAR; PG8_MMA(1, 0, At, B0); PG8_MMA(1, 1, At, B1); PG8_BAR; PG8_SCHED;
            PG8_LDB(B0, 1, 0); PG8_LDB(B1, 1, 1); PG8_SCHED; PG8_LDA(At, 1, 0); PG8_STAGE(PG8_SA(0, 1), a2 + hstep, voffA);
            PG8_WAIT_V(8); PG8_WAIT_L(0); PG8_BAR; PG8_MMA(0, 0, At, B0); PG8_MMA(0, 1, At, B1); PG8_BAR; PG8_SCHED;
            PG8_LDA(At, 1, 1); PG8_STAGE(PG8_SB(1, 0), b3, voffB); PG8_STAGE(PG8_SB(1, 1), b3 + hstep, voffB); PG8_STAGE(PG8_SA(1, 0), a3, voffA);
            PG8_WAIT_V(8); PG8_WAIT_L(0); PG8_BAR; PG8_MMA(1, 0, At, B0); PG8_MMA(1, 1, At, B1); PG8_BAR; PG8_SCHED;
            } else {
            PG8_LDB(B0, 0, 0); PG8_SCHED; PG8_LDA(At, 0, 0); PG8_STAGE(PG8_SA(1, 1), a1 + hstep, voffA);
            PG8_WAIT_L(8); PG8_BAR; PG8_WAIT_L(0); PG8_MMA(0, 0, At, B0); PG8_BAR; PG8_SCHED;
            PG8_LDB(B1, 0, 1); PG8_STAGE(PG8_SB(0, 0), b2, voffB);
            PG8_BAR; PG8_WAIT_L(0); PG8_MMA(0, 1, At, B1); PG8_BAR;
            PG8_LDA(At, 0, 1); PG8_STAGE(PG8_SA(0, 0), a2, voffA);
            PG8_BAR; PG8_WAIT_L(0); PG8_MMA(1, 0, At, B0); PG8_BAR; PG8_SCHED;
            PG8_STAGE(PG8_SB(0, 1), b2 + hstep, voffB);
            PG8_WAIT_V(6); PG8_BAR; PG8_MMA(1, 1, At, B1); PG8_BAR;
            PG8_LDB(B0, 1, 0); PG8_SCHED; PG8_LDA(At, 1, 0); PG8_STAGE(PG8_SA(0, 1), a2 + hstep, voffA);
            PG8_WAIT_L(8); PG8_BAR; PG8_WAIT_L(0); PG8_MMA(0, 0, At, B0); PG8_BAR; PG8_SCHED;
            PG8_LDB(B1, 1, 1); PG8_STAGE(PG8_SB(1, 0), b3, voffB);
            PG8_BAR; PG8_WAIT_L(0); PG8_MMA(0, 1, At, B1); PG8_BAR;
            PG8_LDA(At, 1, 1); PG8_STAGE(PG8_SA(1, 0), a3, voffA);
            PG8_BAR; PG8_WAIT_L(0); PG8_MMA(1, 0, At, B0); PG8_BAR; PG8_SCHED;
            PG8_STAGE(PG8_SB(1, 1), b3 + hstep, voffB);
            PG8_WAIT_V(6); PG8_BAR; PG8_MMA(1, 1, At, B1); PG8_BAR;
            }
        }
        if constexpr (ALIGN_EPI) { if (wr == 0) PG8_BAR; }
        if constexpr (!Epi::AFTER_DRAIN) { E(acc, cur, wr, wc, fr, fq); S.done(cur); }
        if (!has_next) break;
#pragma unroll
        for (int a = 0; a < 2; ++a)
#pragma unroll
            for (int b = 0; b < 2; ++b)
#pragma unroll
                for (int m = 0; m < 4; ++m)
#pragma unroll
                    for (int n = 0; n < 2; ++n) acc[a][b][m][n] = (f32x4){0.f, 0.f, 0.f, 0.f};
        cur = nxt; cA = nA; cB = nB; ++ui;
        if constexpr (ALIGN_EPI) { if (wr == 1) PG8_BAR; }
    }
    PG8_WAIT_V(0);
    if constexpr (!ALIGN_EPI) { if (wr == 0) PG8_BAR; }
    PG8_BAR;
    if constexpr (Epi::AFTER_DRAIN) { E.fused(acc, cur, wr, wc, fr, fq, lds, wid, lane); S.done(cur); }
#undef PG8_SA
#undef PG8_SB
#undef PG8_STAGE
#undef PG8_LDA
#undef PG8_LDB
#undef PG8_MMA
#undef PG8_WAIT_V
#undef PG8_WAIT_L
#undef PG8_BAR
#undef PG8_SCHED
}
}
#define XB_TMO      128
#define XB_XCNT(j)  (256  + 64 * (j))
#define XB_XSUB(j)  (1280 + 64 * (j))
#define XB_XGEN(j)  (2304 + 64 * (j))
#define XB_TOP      3328
#define XB_TOPGEN   3392
#define XCD_BAR_WORDS 3456
#define XB_SPIN_CAP (1u << 18)
#define LAS __attribute__((address_space(3)))

__device__ __forceinline__ unsigned xb_ld(unsigned* p)              { return __hip_atomic_load(p, __ATOMIC_RELAXED, __HIP_MEMORY_SCOPE_AGENT); }
__device__ __forceinline__ unsigned xb_add(unsigned* p, unsigned v) { return __hip_atomic_fetch_add(p, v, __ATOMIC_RELAXED, __HIP_MEMORY_SCOPE_AGENT); }
__device__ __forceinline__ unsigned xb_xcc_id() { return (unsigned)__builtin_amdgcn_s_getreg((3 << 11) | 20) & 0xFu; }
#define XB_SPIN(cond, bar) do { unsigned _sp = 0; while (cond) { __builtin_amdgcn_s_sleep(1); \
    if ((++_sp & 255u) == 0u) { if (xb_ld(&(bar)[XB_TMO])) break; if (_sp > XB_SPIN_CAP) { atomicAdd(&(bar)[XB_TMO], 1u); break; } } } } while (0)

struct XcdBarrier {
    unsigned* bar; unsigned x;
    volatile LAS unsigned* st;
};

__device__ __forceinline__ XcdBarrier xcd_barrier_post(unsigned* bar, volatile LAS unsigned* st) {
    XcdBarrier b; b.bar = bar; b.x = xb_xcc_id(); b.st = st;
    if (threadIdx.x == 0) (void)xb_add(&bar[XB_XCNT(b.x)], 1u);
    return b;
}
__device__ __forceinline__ void xcd_barrier_complete(unsigned* bar, unsigned x, unsigned& nloc, unsigned& nx) {
    const unsigned G = gridDim.x * gridDim.y * gridDim.z;
    unsigned sum, cnt, mine, sp = 0u;
    for (;;) {
        sum = 0u; cnt = 0u; mine = 0u;
#pragma unroll
        for (unsigned j = 0; j < 16; ++j) { const unsigned c = xb_ld(&bar[XB_XCNT(j)]); sum += c; cnt += (c > 0u) ? 1u : 0u; mine = (j == x) ? c : mine; }
        if (sum == G) break;
        __builtin_amdgcn_s_sleep(1);
        if ((++sp & 255u) == 0u) { if (xb_ld(&bar[XB_TMO])) break; if (sp > XB_SPIN_CAP) { atomicAdd(&bar[XB_TMO], 1u); break; } }
    }
    nloc = mine > 0u ? mine : 1u; nx = cnt > 0u ? cnt : 1u;
}

__device__ __forceinline__ void xcd_barrier(const XcdBarrier& b) {
    asm volatile("s_waitcnt vmcnt(0)" ::: "memory");
    __syncthreads();
    if (threadIdx.x == 0) {
        unsigned* bar = b.bar;
        __builtin_amdgcn_s_waitcnt(0);
        unsigned nloc = b.st[0], nx = b.st[1];
        if (nloc == 0u) { xcd_barrier_complete(bar, b.x, nloc, nx); b.st[0] = nloc; b.st[1] = nx; }
        const unsigned old = xb_add(&bar[XB_XSUB(b.x)], 1u);
        const unsigned gen = old / nloc;
        if (old + 1u == (gen + 1u) * nloc) {
            __builtin_amdgcn_fence(__ATOMIC_RELEASE, "agent");
            asm volatile("s_waitcnt vmcnt(0)" ::: "memory");
            const unsigned og = xb_add(&bar[XB_TOP], 1u);
            const unsigned tg = og / nx;
            if (og + 1u == (tg + 1u) * nx) xb_add(&bar[XB_TOPGEN], 1u);
            else XB_SPIN(xb_ld(&bar[XB_TOPGEN]) == tg, bar);
            __builtin_amdgcn_fence(__ATOMIC_ACQUIRE, "agent");
            xb_add(&bar[XB_XGEN(b.x)], 1u);
            asm volatile("s_waitcnt vmcnt(0)" ::: "memory");
        } else {
            XB_SPIN(xb_ld(&bar[XB_XGEN(b.x)]) == gen, bar);
            __builtin_amdgcn_fence(__ATOMIC_ACQUIRE, "agent");
            asm volatile("s_waitcnt vmcnt(0)" ::: "memory");
        }
    }
    __syncthreads();
}

constexpr int D = 1024, BATCH = 8, SEQ = 2048, NMETA = 16, LTOT = SEQ + NMETA;
constexpr int NREAL = BATCH * SEQ;
constexpr int MROWS = 16640;
constexpr int NROWS_D = NREAL + BATCH * NMETA;
constexpr int IN_W = 12320;
constexpr int RH = 4, RDK = 256, RDV = 512;
constexpr int DH = 8, DDK = 128, DDV = 128;
constexpr int NEXP = 16384, PH = 8, PK = 16;
constexpr int WT_ROWS = 12544, WT_A0 = 0, WT_A_N = 4096, WT_B0 = 4096, WT_B_N = 3328, WT_C0 = 7424, WT_C_N = 5120;
constexpr float LN_EPS = 1e-5f, RMS_EPS = 1e-6f;
constexpr float DN_ALPHA = 1.189207115f;

constexpr size_t MiB = 1u << 20;
constexpr size_t WS_CTL = 0, CTL_ZERO_BYTES = 1 * MiB;
constexpr size_t WS_HB = 1 * MiB;
constexpr size_t WS_WT = WS_HB + (size_t)MROWS * D * 2;
constexpr size_t WS_AR = 58 * MiB;
constexpr size_t WS_END = 264 * MiB;
static_assert(WS_WT + (size_t)WT_ROWS * D * 2 <= WS_AR, "map");
constexpr size_t AR_QKVR = WS_AR;
constexpr size_t AR_RAWD = WS_AR;
constexpr size_t AR_GBETA = WS_AR + 97 * MiB + 512 * 1024;
constexpr size_t AR_QKVD = WS_AR + 100 * MiB;
constexpr size_t AR_OD = WS_AR;
constexpr size_t AR_GRG = WS_AR + 32 * MiB, AR_GDZ = WS_AR + 96 * MiB, AR_GGA = WS_AR + 128 * MiB, AR_GGB = WS_AR + 160 * MiB;
constexpr size_t AR_PRETT = WS_AR + 192 * MiB, AR_PDNT = WS_AR + 196 * MiB, AR_WOUTT = WS_AR + 198 * MiB, AR_W2T = WS_AR + 200 * MiB;
constexpr size_t AR_M1 = WS_AR + 32 * MiB, AR_MERGED = WS_AR + 64 * MiB, AR_PRE = WS_AR + 96 * MiB;
constexpr size_t AR_H1 = WS_AR;
constexpr size_t WS_UB = 1 * MiB, AR_VB = WS_AR + 160 * MiB;
constexpr size_t AR_SCORES = WS_AR + 32 * MiB;
constexpr size_t WS_EXP = WS_WT, WS_GATE = WS_WT + 8 * MiB;
static_assert(AR_QKVD + (size_t)NROWS_D * 3072 * 2 <= WS_END && AR_W2T + 4 * MiB <= WS_END && AR_GBETA + (size_t)MROWS * 32 * 4 <= AR_QKVD, "map");
constexpr int CW_BAR = 4096;

constexpr int RING_BYTES = 131072, MISC_OFF = RING_BYTES + 320, LDS_BYTES = 147456;
constexpr int NWAVES = 8, NTHREADS = 512;

#define GAS __attribute__((address_space(1)))
#define LAS __attribute__((address_space(3)))
typedef unsigned short bf16;
typedef unsigned v4u __attribute__((ext_vector_type(4)));
typedef unsigned v2u __attribute__((ext_vector_type(2)));
typedef float f32x4 __attribute__((ext_vector_type(4)));
#define RLX_AGENT __ATOMIC_RELAXED, __HIP_MEMORY_SCOPE_AGENT

__device__ __forceinline__ unsigned f2bf(float f) { unsigned u = __builtin_bit_cast(unsigned, f); return (u + 0x7fffu + ((u >> 16) & 1u)) >> 16; }
__device__ __forceinline__ unsigned pk2(float lo, float hi) { return f2bf(lo) | (f2bf(hi) << 16); }
__device__ __forceinline__ float bflo(unsigned u) { return __builtin_bit_cast(float, u << 16); }
__device__ __forceinline__ float bfhi(unsigned u) { return __builtin_bit_cast(float, u & 0xffff0000u); }
__device__ __forceinline__ float bf2f(bf16 h) { return __builtin_bit_cast(float, ((unsigned)h) << 16); }
__device__ __forceinline__ float sigmoidf_(float x) { return 1.0f / (1.0f + __expf(-x)); }
__device__ __forceinline__ float siluf_(float x) { return x / (1.0f + __expf(-x)); }
__device__ __forceinline__ float wave_sum(float v) {
#pragma unroll
    for (int o = 1; o < 64; o <<= 1) v += __shfl_xor(v, o);
    return v;
}
__device__ __forceinline__ int row_of(int b, int p) { return p < NMETA ? NREAL + p : b * SEQ + (p - NMETA); }
__device__ __forceinline__ int rowd_of(int b, int p) { return p < NMETA ? NREAL + b * NMETA + p : b * SEQ + (p - NMETA); }

struct Args {
    const float *x, *meta, *emb_g, *emb_b, *w_in, *ret_decay, *dn_conv, *dn_a_log, *dn_dt_bias, *dn_norm_g, *p_ret, *p_dn, *w_out, *ln1_g, *ln1_b,
                *peer_wq, *peer_keys, *peer_u, *peer_v, *ln2_g, *ln2_b;
    float* out; unsigned char* ws; int ph_lo, ph_hi;
};

struct Frame {
    LAS unsigned char* lds;
    int tid, lane, wave, G, gw, NGW;
};

namespace ep {
using pg8::f32x4; using pg8::Unit; using pg8::u32x4; using pg8::cvt_pk_bf16;
__device__ __forceinline__ u32x4 pack8(f32x4 a, f32x4 b) { u32x4 w; w.x = cvt_pk_bf16(a[0], a[1]); w.y = cvt_pk_bf16(a[2], a[3]); w.z = cvt_pk_bf16(b[0], b[1]); w.w = cvt_pk_bf16(b[2], b[3]); return w; }
__device__ __forceinline__ void unpack8(u32x4 w, f32x4& a, f32x4& b) { a = (f32x4){bflo(w.x), bfhi(w.x), bflo(w.y), bfhi(w.y)}; b = (f32x4){bflo(w.z), bfhi(w.z), bflo(w.w), bfhi(w.w)}; }

struct EpiRot {
    static constexpr bool PERM = true, AFTER_DRAIN = false;
    bf16* O;
    __device__ __forceinline__ void operator()(const f32x4 (&acc)[2][2][4][2], const Unit& u, int wr, int wc, int fr, int fq) const {
        const int row0 = u.pm * 256 + wr * 64 + fr, colb = wc * 32 + 8 * fq;
        if (u.pn < 8) {
            const float sc = (u.pn >= 4) ? 0.0625f : 1.0f;
            float rev[8];
#pragma unroll
            for (int e = 0; e < 8; ++e) rev[e] = exp2f(-(float)(colb + e) * (13.287712379549449f / 128.0f)) * 0.15915494309189535f;
#pragma unroll
            for (int ai = 0; ai < 2; ++ai)
#pragma unroll
                for (int m = 0; m < 4; ++m) {
                    const int r = row0 + ai * 128 + m * 16;
                    const float pos = (float)(r < NREAL ? (r & (SEQ - 1)) + NMETA : r - NREAL);
                    f32x4 o1[2], o2[2];
#pragma unroll
                    for (int n = 0; n < 2; ++n)
#pragma unroll
                        for (int e = 0; e < 4; ++e) {
                            float t = pos * rev[n * 4 + e]; t = t - floorf(t);
                            const float s = __builtin_amdgcn_sinf(t), c = __builtin_amdgcn_cosf(t);
                            const float x1 = acc[ai][0][m][n][e], x2 = acc[ai][1][m][n][e];
                            o1[n][e] = (x1 * c - x2 * s) * sc; o2[n][e] = (x1 * s + x2 * c) * sc;
                        }
                    bf16* rowp = O + (size_t)r * 4096 + u.pn * 256 + colb;
                    *(u32x4*)(rowp) = pack8(o1[0], o1[1]);
                    *(u32x4*)(rowp + 128) = pack8(o2[0], o2[1]);
                }
        } else {
#pragma unroll
            for (int ai = 0; ai < 2; ++ai)
#pragma unroll
                for (int m = 0; m < 4; ++m) {
                    bf16* rowp = O + (size_t)(row0 + ai * 128 + m * 16) * 4096 + u.pn * 256 + colb;
#pragma unroll
                    for (int bj = 0; bj < 2; ++bj) *(u32x4*)(rowp + bj * 128) = pack8(acc[ai][bj][m][0], acc[ai][bj][m][1]);
                }
        }
    }
};
struct EpiDn {
    static constexpr bool PERM = true, AFTER_DRAIN = false;
    bf16* O; float* GB; const float* a_log; const float* dt_bias;
    __device__ __forceinline__ void operator()(const f32x4 (&acc)[2][2][4][2], const Unit& u, int wr, int wc, int fr, int fq) const {
        const int row0 = u.pm * 256 + wr * 64 + fr, colb = wc * 32 + 8 * fq;
        if (u.pn < 12) {
#pragma unroll
            for (int ai = 0; ai < 2; ++ai)
#pragma unroll
                for (int m = 0; m < 4; ++m) {
                    bf16* rowp = O + (size_t)(row0 + ai * 128 + m * 16) * 3072 + u.pn * 256 + colb;
#pragma unroll
                    for (int bj = 0; bj < 2; ++bj) *(u32x4*)(rowp + bj * 128) = pack8(acc[ai][bj][m][0], acc[ai][bj][m][1]);
                }
        } else if (wc == 0) {
            float ea[8], db[8];
#pragma unroll
            for (int e = 0; e < 8; ++e) { const int c = (colb + e) & 15; ea[e] = -__expf(a_log[c]); db[e] = dt_bias[c]; }
#pragma unroll
            for (int ai = 0; ai < 2; ++ai)
#pragma unroll
                for (int m = 0; m < 4; ++m) {
                    float* rowp = GB + (size_t)(row0 + ai * 128 + m * 16) * 32 + colb;
                    f32x4 o[2];
#pragma unroll
                    for (int n = 0; n < 2; ++n)
#pragma unroll
                        for (int e = 0; e < 4; ++e) {
                            const float v = acc[ai][0][m][n][e];
                            if (colb < 16) { const float z = v + db[n * 4 + e]; const float sp = z > 20.f ? z : log1pf(__expf(z)); o[n][e] = ea[n * 4 + e] * sp; }
                            else o[n][e] = sigmoidf_(v);
                        }
                    *(f32x4*)(rowp) = o[0]; *(f32x4*)(rowp + 4) = o[1];
                }
        }
    }
};
struct EpiGates {
    static constexpr bool PERM = true, AFTER_DRAIN = false;
    bf16 *rg, *dz, *ga, *gb;
    __device__ __forceinline__ void operator()(const f32x4 (&acc)[2][2][4][2], const Unit& u, int wr, int wc, int fr, int fq) const {
        const int row0 = u.pm * 256 + wr * 64 + fr, colb = wc * 32 + 8 * fq;
        bf16* base; int ld, ct;
        if (u.pn < 8) { base = rg; ld = 2048; ct = u.pn; } else if (u.pn < 12) { base = dz; ld = 1024; ct = u.pn - 8; } else if (u.pn < 16) { base = ga; ld = 1024; ct = u.pn - 12; } else { base = gb; ld = 1024; ct = u.pn - 16; }
#pragma unroll
        for (int ai = 0; ai < 2; ++ai)
#pragma unroll
            for (int m = 0; m < 4; ++m) {
                bf16* rowp = base + (size_t)(row0 + ai * 128 + m * 16) * ld + ct * 256 + colb;
#pragma unroll
                for (int bj = 0; bj < 2; ++bj) *(u32x4*)(rowp + bj * 128) = pack8(acc[ai][bj][m][0], acc[ai][bj][m][1]);
            }
    }
};
template <bool ADD> struct EpiMerge {
    static constexpr bool PERM = true, AFTER_DRAIN = false;
    const bf16* gate; const bf16* prev; bf16* O;
    __device__ __forceinline__ void operator()(const f32x4 (&acc)[2][2][4][2], const Unit& u, int wr, int wc, int fr, int fq) const {
        const int row0 = u.pm * 256 + wr * 64 + fr, colb = u.pn * 256 + wc * 32 + 8 * fq;
#pragma unroll
        for (int ai = 0; ai < 2; ++ai)
#pragma unroll
            for (int m = 0; m < 4; ++m) {
                const size_t off = (size_t)(row0 + ai * 128 + m * 16) * 1024 + colb;
#pragma unroll
                for (int bj = 0; bj < 2; ++bj) {
                    f32x4 g0, g1; unpack8(*(const u32x4*)(gate + off + bj * 128), g0, g1);
                    f32x4 o0, o1;
#pragma unroll
                    for (int e = 0; e < 4; ++e) { o0[e] = sigmoidf_(g0[e]) * acc[ai][bj][m][0][e]; o1[e] = sigmoidf_(g1[e]) * acc[ai][bj][m][1][e]; }
                    if (ADD) { f32x4 p0, p1; unpack8(*(const u32x4*)(prev + off + bj * 128), p0, p1); o0 += p0; o1 += p1; }
                    *(u32x4*)(O + off + bj * 128) = pack8(o0, o1);
                }
            }
    }
};
struct EpiRes {
    static constexpr bool PERM = true, AFTER_DRAIN = false;
    const bf16* H; float* O;
    __device__ __forceinline__ void operator()(const f32x4 (&acc)[2][2][4][2], const Unit& u, int wr, int wc, int fr, int fq) const {
        const int row0 = u.pm * 256 + wr * 64 + fr, colb = u.pn * 256 + wc * 32 + 8 * fq;
#pragma unroll
        for (int ai = 0; ai < 2; ++ai)
#pragma unroll
            for (int m = 0; m < 4; ++m) {
                const size_t off = (size_t)(row0 + ai * 128 + m * 16) * 1024 + colb;
#pragma unroll
                for (int bj = 0; bj < 2; ++bj) {
                    f32x4 h0, h1; unpack8(*(const u32x4*)(H + off + bj * 128), h0, h1);
                    *(f32x4*)(O + off + bj * 128) = h0 * DN_ALPHA + acc[ai][bj][m][0];
                    *(f32x4*)(O + off + bj * 128 + 4) = h1 * DN_ALPHA + acc[ai][bj][m][1];
                }
            }
    }
};
struct EpiF32 {
    static constexpr bool PERM = true, AFTER_DRAIN = false;
    float* O; int ld;
    __device__ __forceinline__ void operator()(const f32x4 (&acc)[2][2][4][2], const Unit& u, int wr, int wc, int fr, int fq) const {
        const int row0 = u.pm * 256 + wr * 64 + fr, colb = u.pn * 256 + wc * 32 + 8 * fq;
#pragma unroll
        for (int ai = 0; ai < 2; ++ai)
#pragma unroll
            for (int m = 0; m < 4; ++m) {
                float* rowp = O + (size_t)(row0 + ai * 128 + m * 16) * ld + colb;
#pragma unroll
                for (int bj = 0; bj < 2; ++bj) { *(f32x4*)(rowp + bj * 128) = acc[ai][bj][m][0]; *(f32x4*)(rowp + bj * 128 + 4) = acc[ai][bj][m][1]; }
            }
    }
};
}

__device__ __forceinline__ void transpose_item(const float* W, int ldsrc, int K, bf16* WT, int k0, int srcn0, int dstn0, LAS float* scr, int lane) {
    if (srcn0 >= 0) {
#pragma unroll 8
        for (int i = 0; i < 32; ++i) { const int kk = 2 * i + (lane >> 5); scr[kk * 33 + (lane & 31)] = W[(size_t)(k0 + kk) * ldsrc + srcn0 + (lane & 31)]; }
    } else {
#pragma unroll 8
        for (int i = 0; i < 32; ++i) { const int kk = 2 * i + (lane >> 5); scr[kk * 33 + (lane & 31)] = 0.f; }
    }
    asm volatile("s_waitcnt lgkmcnt(0)" ::: "memory");
    const int c = lane & 7;
#pragma unroll
    for (int j = 0; j < 4; ++j) { const int n = (lane >> 3) + 8 * j; const LAS float* s = scr + (8 * c) * 33 + n;
        v4u o; o.x = pk2(s[0 * 33], s[1 * 33]); o.y = pk2(s[2 * 33], s[3 * 33]); o.z = pk2(s[4 * 33], s[5 * 33]); o.w = pk2(s[6 * 33], s[7 * 33]);
        *(v4u*)(WT + (size_t)(dstn0 + n) * K + k0 + 8 * c) = o; }
    asm volatile("s_waitcnt lgkmcnt(0)" ::: "memory");
}
__device__ __forceinline__ int wt_src_col(int n0) {
    if (n0 < 4096) return n0;
    if (n0 < 7168) return n0 - 4096 + 6144;
    if (n0 < 7200) return n0 - 7168 + 10240;
    if (n0 < 7424) return -1;
    if (n0 < 9472) return n0 - 7424 + 4096;
    if (n0 < 10496) return n0 - 9472 + 9216;
    if (n0 < 11520) return n0 - 10496 + 10272;
    return n0 - 11520 + 11296;
}
__device__ __forceinline__ void ln_row_affine_bf16(const float* xrow, const float* g, const float* bb, bf16* orow, int lane) {
    const f32x4* xr = (const f32x4*)xrow + lane;
    f32x4 v[4]; float s = 0.f;
#pragma unroll
    for (int j = 0; j < 4; ++j) { v[j] = xr[64 * j]; s += (v[j][0] + v[j][1]) + (v[j][2] + v[j][3]); }
    const float mean = wave_sum(s) * (1.f / D); float s2 = 0.f;
#pragma unroll
    for (int j = 0; j < 4; ++j) { v[j] = v[j] - mean; s2 += (v[j][0] * v[j][0] + v[j][1] * v[j][1]) + (v[j][2] * v[j][2] + v[j][3] * v[j][3]); }
    const float rstd = 1.f / sqrtf(wave_sum(s2) * (1.f / D) + LN_EPS);
    v2u* o8 = (v2u*)orow + lane;
#pragma unroll
    for (int j = 0; j < 4; ++j) { const f32x4 gg = ((const f32x4*)g)[lane + 64 * j], b4 = ((const f32x4*)bb)[lane + 64 * j]; const f32x4 y = v[j] * rstd * gg + b4;
        v2u w; w.x = pk2(y[0], y[1]); w.y = pk2(y[2], y[3]); o8[64 * j] = w; }
}

__device__ __forceinline__ void p0_prologue(const Args& a, Frame& F) {
    LAS float* scr = (LAS float*)(F.lds + F.wave * 16384);
    bf16* HB = (bf16*)(a.ws + WS_HB); bf16* WT = (bf16*)(a.ws + WS_WT);
    constexpr int NB = WT_ROWS / 32, NITEMS = NB * (D / 64);
    for (int it = F.gw; it < NITEMS; it += F.NGW) { const int nb = it % NB, kb = it / NB; transpose_item(a.w_in, IN_W, D, WT, 64 * kb, wt_src_col(32 * nb), 32 * nb, scr, F.lane); }
    for (int r = F.gw; r < MROWS; r += F.NGW) {
        bf16* orow = HB + (size_t)r * D;
        if (r < NREAL) ln_row_affine_bf16(a.x + (size_t)r * D, a.emb_g, a.emb_b, orow, F.lane);
        else if (r < NREAL + NMETA) ln_row_affine_bf16(a.meta + (size_t)(r - NREAL) * D, a.emb_g, a.emb_b, orow, F.lane);
        else { v2u z; z.x = 0u; z.y = 0u; v2u* o8 = (v2u*)orow + F.lane;
#pragma unroll
            for (int j = 0; j < 4; ++j) o8[64 * j] = z; }
    }
}

__device__ __forceinline__ void p2_scan_ret_simple(const Args& a, Frame& F) {
    const bf16* QKV = (const bf16*)(a.ws + AR_QKVR); bf16* OR = (bf16*)a.out;
    constexpr int TG = 8;
    LAS bf16* qt = (LAS bf16*)F.lds; LAS bf16* kt = qt + TG * 256; LAS bf16* vt = kt + TG * 256;
    const int col = 16 * F.wave + (F.lane >> 2), qtr = F.lane & 3;
    for (int u = blockIdx.x; u < BATCH * RH * 4; u += F.G) {
        const int b = u >> 4, h = (u >> 2) & 3, dvb = u & 3;
        for (int pass = 0; pass < 2; ++pass) {
            const int dir = 1 - pass;
            const float gamma = sigmoidf_(a.ret_decay[dir * RH + h]);
            float S[64];
#pragma unroll
            for (int j = 0; j < 64; ++j) S[j] = 0.f;
            const int ntok = dir ? SEQ : LTOT;
            for (int t0 = 0; t0 < ntok; t0 += TG) {
                __syncthreads();
                for (int c = F.tid; c < TG * 80; c += NTHREADS) {
                    const int i = c / 80, w = c % 80; const int t = t0 + i, p = dir ? (LTOT - 1 - t) : t; const size_t rb = (size_t)row_of(b, p) * 4096;
                    if (w < 32) *(LAS v4u*)(qt + i * 256 + w * 8) = *(const v4u*)(QKV + rb + h * 256 + w * 8);
                    else if (w < 64) *(LAS v4u*)(kt + i * 256 + (w - 32) * 8) = *(const v4u*)(QKV + rb + 1024 + h * 256 + (w - 32) * 8);
                    else *(LAS v4u*)(vt + i * 128 + (w - 64) * 8) = *(const v4u*)(QKV + rb + 2048 + h * 512 + dvb * 128 + (w - 64) * 8);
                }
                __syncthreads();
                for (int i = 0; i < TG; ++i) {
                    const float v = bf2f(vt[i * 128 + col]);
                    float o = 0.f;
#pragma unroll
                    for (int j8 = 0; j8 < 8; ++j8) {
                        const v4u kw = *(const LAS v4u*)(kt + i * 256 + qtr * 64 + j8 * 8), qw = *(const LAS v4u*)(qt + i * 256 + qtr * 64 + j8 * 8);
                        const float kk[8] = {bflo(kw.x), bfhi(kw.x), bflo(kw.y), bfhi(kw.y), bflo(kw.z), bfhi(kw.z), bflo(kw.w), bfhi(kw.w)};
                        const float qq[8] = {bflo(qw.x), bfhi(qw.x), bflo(qw.y), bfhi(qw.y), bflo(qw.z), bfhi(qw.z), bflo(qw.w), bfhi(qw.w)};
#pragma unroll
                        for (int e = 0; e < 8; ++e) {
                            float s = S[j8 * 8 + e] * gamma;
                            if (dir == 0) { s += kk[e] * v; o += qq[e] * s; } else { o += qq[e] * s; s += kk[e] * v; }
                            S[j8 * 8 + e] = s;
                        }
                    }
                    o += __shfl_xor(o, 1); o += __shfl_xor(o, 2);
                    const float o2 = __shfl_down(o, 4);
                    const int t = t0 + i, p = dir ? (LTOT - 1 - t) : t;
                    if ((F.lane & 7) == 0 && p >= NMETA) {
                        unsigned* dst = (unsigned*)(OR + (size_t)(b * SEQ + p - NMETA) * 2048 + h * 512 + dvb * 128 + col);
                        float r0 = o, r1 = o2;
                        if (pass == 1) { const unsigned old = __hip_atomic_load(dst, RLX_AGENT); r0 += bflo(old); r1 += bfhi(old); }
                        *dst = pk2(r0, r1);
                    }
                }
            }
        }
    }
}

__device__ __forceinline__ void p4_conv(const Args& a, Frame& F) {
    const bf16* RAW = (const bf16*)(a.ws + AR_RAWD); bf16* QD = (bf16*)(a.ws + AR_QKVD);
    for (int it = F.gw; it < NROWS_D * 24; it += F.NGW) {
        const int rd = it / 24, slab = it % 24;
        int b, p; if (rd < NREAL) { b = rd >> 11; p = (rd & (SEQ - 1)) + NMETA; } else { b = (rd - NREAL) >> 4; p = (rd - NREAL) & 15; }
        const int ch = slab * 128 + 2 * F.lane;
        float y0 = 0.f, y1 = 0.f;
#pragma unroll
        for (int j = 0; j < 5; ++j) { const int pp = p + j - 2;
            if (pp >= 0 && pp < LTOT) { const unsigned w = *(const unsigned*)(RAW + (size_t)row_of(b, pp) * 3072 + ch); const float2 cw = *(const float2*)(a.dn_conv + j * 3072 + ch);
                y0 += cw.x * bflo(w); y1 += cw.y * bfhi(w); } }
        y0 = siluf_(y0); y1 = siluf_(y1);
        if (slab < 16) { const float ss = wave_sum(y0 * y0 + y1 * y1); float sc = 1.0f / sqrtf(ss + RMS_EPS); if (slab < 8) sc *= 0.08838834764831845f; y0 *= sc; y1 *= sc; }
        *(unsigned*)(QD + (size_t)rd * 3072 + ch) = pk2(y0, y1);
    }
}

__device__ __forceinline__ void p5_scan_dn_simple(const Args& a, Frame& F) {
    const bf16* QD = (const bf16*)(a.ws + AR_QKVD); const float* GB = (const float*)(a.ws + AR_GBETA); bf16* OD = (bf16*)(a.ws + AR_OD);
    constexpr int TG = 8;
    LAS bf16* qt = (LAS bf16*)F.lds; LAS bf16* kt = qt + TG * 128; LAS bf16* vt = kt + TG * 128; LAS float* gt = (LAS float*)(vt + TG * 64); LAS float* bt = gt + TG;
    const int cl = 8 * F.wave + (F.lane >> 3), sub = F.lane & 7;
    for (int u = blockIdx.x; u < BATCH * DH * 2; u += F.G) {
        const int b = u >> 4, h = (u >> 1) & 7, dvh = u & 1;
        for (int pass = 0; pass < 2; ++pass) {
            const int dir = 1 - pass;
            float S[16];
#pragma unroll
            for (int j = 0; j < 16; ++j) S[j] = 0.f;
            const int ntok = dir ? SEQ : LTOT;
            for (int t0 = 0; t0 < ntok; t0 += TG) {
                __syncthreads();
                for (int c = F.tid; c < TG * 40; c += NTHREADS) {
                    const int i = c / 40, w = c % 40; const int t = t0 + i, p = dir ? (LTOT - 1 - t) : t; const size_t rb = (size_t)rowd_of(b, p) * 3072;
                    if (w < 16) *(LAS v4u*)(qt + i * 128 + w * 8) = *(const v4u*)(QD + rb + h * 128 + w * 8);
                    else if (w < 32) *(LAS v4u*)(kt + i * 128 + (w - 16) * 8) = *(const v4u*)(QD + rb + 1024 + h * 128 + (w - 16) * 8);
                    else *(LAS v4u*)(vt + i * 64 + (w - 32) * 8) = *(const v4u*)(QD + rb + 2048 + h * 128 + dvh * 64 + (w - 32) * 8);
                }
                if (F.tid < TG) { const int t = t0 + F.tid, p = dir ? (LTOT - 1 - t) : t; const size_t rg = (size_t)row_of(b, p) * 32;
                    gt[F.tid] = GB[rg + dir * 8 + h]; bt[F.tid] = GB[rg + 16 + dir * 8 + h]; }
                __syncthreads();
                for (int i = 0; i < TG; ++i) {
                    const float v = bf2f(vt[i * 64 + cl]);
                    const float ag = __expf(gt[i]), beta = bt[i];
                    const v4u kw0 = *(const LAS v4u*)(kt + i * 128 + sub * 16), kw1 = *(const LAS v4u*)(kt + i * 128 + sub * 16 + 8);
                    const v4u qw0 = *(const LAS v4u*)(qt + i * 128 + sub * 16), qw1 = *(const LAS v4u*)(qt + i * 128 + sub * 16 + 8);
                    const float kk[16] = {bflo(kw0.x), bfhi(kw0.x), bflo(kw0.y), bfhi(kw0.y), bflo(kw0.z), bfhi(kw0.z), bflo(kw0.w), bfhi(kw0.w),
                                          bflo(kw1.x), bfhi(kw1.x), bflo(kw1.y), bfhi(kw1.y), bflo(kw1.z), bfhi(kw1.z), bflo(kw1.w), bfhi(kw1.w)};
                    const float qq[16] = {bflo(qw0.x), bfhi(qw0.x), bflo(qw0.y), bfhi(qw0.y), bflo(qw0.z), bfhi(qw0.z), bflo(qw0.w), bfhi(qw0.w),
                                          bflo(qw1.x), bfhi(qw1.x), bflo(qw1.y), bfhi(qw1.y), bflo(qw1.z), bfhi(qw1.z), bflo(qw1.w), bfhi(qw1.w)};
                    float r = 0.f;
#pragma unroll
                    for (int j = 0; j < 16; ++j) r += S[j] * kk[j];
                    r += __shfl_xor(r, 1); r += __shfl_xor(r, 2); r += __shfl_xor(r, 4);
                    const float vn = beta * (v - ag * r);
                    float o = 0.f;
#pragma unroll
                    for (int j = 0; j < 16; ++j) { S[j] = ag * S[j] + kk[j] * vn; o += S[j] * qq[j]; }
                    o += __shfl_xor(o, 1); o += __shfl_xor(o, 2); o += __shfl_xor(o, 4);
                    const float o2 = __shfl_down(o, 8);
                    const int t = t0 + i, p = dir ? (LTOT - 1 - t) : t;
                    if ((F.lane & 15) == 0 && p >= NMETA) {
                        unsigned* dst = (unsigned*)(OD + (size_t)(b * SEQ + p - NMETA) * 1024 + h * 128 + dvh * 64 + cl);
                        float r0 = o, r1 = o2;
                        if (pass == 1) { const unsigned old = __hip_atomic_load(dst, RLX_AGENT); r0 += bflo(old); r1 += bfhi(old); }
                        *dst = pk2(r0, r1);
                    }
                }
            }
        }
    }
}

__device__ __forceinline__ void p6_small_weights(const Args& a, Frame& F) {
    LAS float* scr = (LAS float*)(F.lds + F.wave * 16384);
    bf16* PRT = (bf16*)(a.ws + AR_PRETT); bf16* PDT = (bf16*)(a.ws + AR_PDNT); bf16* WOT = (bf16*)(a.ws + AR_WOUTT); bf16* W2T = (bf16*)(a.ws + AR_W2T);
    constexpr int I_PR = (2048 / 64) * (1024 / 32), I_PD = (1024 / 64) * (1024 / 32), I_WO = I_PD;
    for (int it = F.gw; it < I_PR + I_PD + I_WO; it += F.NGW) {
        int r = it;
        if (r < I_PR) { transpose_item(a.p_ret, 1024, 2048, PRT, 64 * (r / 32), 32 * (r % 32), 32 * (r % 32), scr, F.lane); continue; } r -= I_PR;
        if (r < I_PD) { transpose_item(a.p_dn, 1024, 1024, PDT, 64 * (r / 32), 32 * (r % 32), 32 * (r % 32), scr, F.lane); continue; } r -= I_PD;
        transpose_item(a.w_out, 1024, 1024, WOT, 64 * (r / 32), 32 * (r % 32), 32 * (r % 32), scr, F.lane);
    }
    const int gt = blockIdx.x * NTHREADS + F.tid, NGT = F.G * NTHREADS;
    for (int idx = gt; idx < 2048 * 1024; idx += NGT) {
        const int np = idx >> 10, k = idx & 1023, hp = np >> 7;
        const f32x4* wq = (const f32x4*)(a.peer_wq + (size_t)k * 2048 + hp * 128); const f32x4* ky = (const f32x4*)(a.peer_keys + (size_t)np * 128);
        float s = 0.f;
#pragma unroll 8
        for (int d = 0; d < 32; ++d) { const f32x4 x = wq[d], y = ky[d]; s += (x[0] * y[0] + x[1] * y[1]) + (x[2] * y[2] + x[3] * y[3]); }
        W2T[idx] = (bf16)f2bf(s);
    }
}

__device__ __forceinline__ void p7_gate_norm(const Args& a, Frame& F) {
    bf16* OR = (bf16*)a.out; bf16* OD = (bf16*)(a.ws + AR_OD); const bf16* GRG = (const bf16*)(a.ws + AR_GRG); const bf16* GDZ = (const bf16*)(a.ws + AR_GDZ);
    for (int it = F.gw; it < NREAL * 5; it += F.NGW) {
        const int r = it / 5, part = it % 5;
        if (part < 4) {
            const size_t off = (size_t)r * 2048 + part * 512 + F.lane * 8;
            f32x4 v0, v1, g0, g1; ep::unpack8(*(const v4u*)(OR + off), v0, v1); ep::unpack8(*(const v4u*)(GRG + off), g0, g1);
            float s = (v0[0] + v0[1]) + (v0[2] + v0[3]) + (v1[0] + v1[1]) + (v1[2] + v1[3]);
            const float mean = wave_sum(s) * (1.f / 512.f);
            v0 = v0 - mean; v1 = v1 - mean;
            float s2 = (v0[0] * v0[0] + v0[1] * v0[1]) + (v0[2] * v0[2] + v0[3] * v0[3]) + (v1[0] * v1[0] + v1[1] * v1[1]) + (v1[2] * v1[2] + v1[3] * v1[3]);
            const float rstd = 1.f / sqrtf(wave_sum(s2) * (1.f / 512.f) + LN_EPS);
#pragma unroll
            for (int e = 0; e < 4; ++e) { v0[e] = v0[e] * rstd * siluf_(g0[e]); v1[e] = v1[e] * rstd * siluf_(g1[e]); }
            *(v4u*)(OR + off) = ep::pack8(v0, v1);
        } else {
#pragma unroll
            for (int hh = 0; hh < 2; ++hh) {
                const size_t off = (size_t)r * 1024 + hh * 512 + F.lane * 8;
                f32x4 v0, v1, g0, g1; ep::unpack8(*(const v4u*)(OD + off), v0, v1); ep::unpack8(*(const v4u*)(GDZ + off), g0, g1);
                float s2 = (v0[0] * v0[0] + v0[1] * v0[1]) + (v0[2] * v0[2] + v0[3] * v0[3]) + (v1[0] * v1[0] + v1[1] * v1[1]) + (v1[2] * v1[2] + v1[3] * v1[3]);
                s2 += __shfl_xor(s2, 1); s2 += __shfl_xor(s2, 2); s2 += __shfl_xor(s2, 4); s2 += __shfl_xor(s2, 8);
                const float rs = 1.f / sqrtf(s2 * (1.f / 128.f) + RMS_EPS);
                const int c = (F.lane & 15) * 8;
                const f32x4 n0 = *(const f32x4*)(a.dn_norm_g + c), n1 = *(const f32x4*)(a.dn_norm_g + c + 4);
#pragma unroll
                for (int e = 0; e < 4; ++e) { v0[e] = v0[e] * rs * n0[e] * siluf_(g0[e]); v1[e] = v1[e] * rs * n1[e] * siluf_(g1[e]); }
                *(v4u*)(OD + off) = ep::pack8(v0, v1);
            }
        }
    }
}

__device__ __forceinline__ void p11_ln1_tables(const Args& a, Frame& F) {
    const float* PRE = (const float*)(a.ws + AR_PRE); bf16* H1 = (bf16*)(a.ws + AR_H1);
    for (int r = F.gw; r < NREAL; r += F.NGW) ln_row_affine_bf16(PRE + (size_t)r * D, a.ln1_g, a.ln1_b, H1 + (size_t)r * D, F.lane);
    bf16* UB = (bf16*)(a.ws + WS_UB); bf16* VB = (bf16*)(a.ws + AR_VB);
    const size_t gt = (size_t)blockIdx.x * NTHREADS + F.tid, NGT = (size_t)F.G * NTHREADS, n8 = (size_t)NEXP * D / 8;
    for (size_t i = gt; i < 2 * n8; i += NGT) {
        const bool second = i >= n8; const size_t j = second ? i - n8 : i;
        const f32x4* src = (const f32x4*)((second ? a.peer_v : a.peer_u) + j * 8);
        const f32x4 x = src[0], y = src[1];
        v4u w; w.x = pk2(x[0], x[1]); w.y = pk2(x[2], x[3]); w.z = pk2(y[0], y[1]); w.w = pk2(y[2], y[3]);
        *(v4u*)((second ? VB : UB) + j * 8) = w;
    }
}

__device__ __forceinline__ unsigned ord_key(float v) { const unsigned u = __builtin_bit_cast(unsigned, v); return (u & 0x80000000u) ? ~u : (u | 0x80000000u); }
__device__ __forceinline__ float ord_val(unsigned k) { const unsigned u = (k & 0x80000000u) ? (k & 0x7fffffffu) : ~k; return __builtin_bit_cast(float, u); }
__device__ __forceinline__ unsigned grp16_max(unsigned m) {
    m = max(m, (unsigned)__shfl_xor((int)m, 1)); m = max(m, (unsigned)__shfl_xor((int)m, 2)); m = max(m, (unsigned)__shfl_xor((int)m, 4)); m = max(m, (unsigned)__shfl_xor((int)m, 8)); return m;
}
__device__ __forceinline__ void p13_topk(const Args& a, Frame& F) {
    const float* SC = (const float*)(a.ws + AR_SCORES); int* EXP = (int*)(a.ws + WS_EXP); float* GATE = (float*)(a.ws + WS_GATE);
    LAS float* tops = (LAS float*)(F.lds + F.wave * 2048); LAS int* topi = (LAS int*)(F.lds + F.wave * 2048 + 1024);
    const int q4 = F.lane >> 4, li = F.lane & 15;
    for (int tok = F.gw; tok < NREAL; tok += F.NGW) {
        const float* srow = SC + (size_t)tok * 2048;
#pragma unroll 1
        for (int it = 0; it < 4; ++it) {
            const int grp = it * 4 + q4;
            const f32x4 x0 = *(const f32x4*)(srow + grp * 128 + li * 8), x1 = *(const f32x4*)(srow + grp * 128 + li * 8 + 4);
            unsigned key[8];
#pragma unroll
            for (int j = 0; j < 8; ++j) { const float v = j < 4 ? x0[j] : x1[j - 4]; key[j] = (ord_key(v) & ~127u) | (unsigned)(127 - (li * 8 + j)); }
            unsigned mine = 0u;
#pragma unroll 1
            for (int rnd = 0; rnd < 16; ++rnd) {
                unsigned m = key[0];
#pragma unroll
                for (int j = 1; j < 8; ++j) m = max(m, key[j]);
                m = grp16_max(m);
#pragma unroll
                for (int j = 0; j < 8; ++j) key[j] = (key[j] == m) ? 0u : key[j];
                mine = (li == rnd) ? m : mine;
            }
            tops[grp * 16 + li] = ord_val((mine & ~127u) | 64u); topi[grp * 16 + li] = 127 - (int)(mine & 127u);
        }
        asm volatile("s_waitcnt lgkmcnt(0)" ::: "memory");
#pragma unroll 1
        for (int it = 0; it < 2; ++it) {
            const int hh = it * 4 + q4;
            const float s1 = tops[(2 * hh) * 16 + li];
            unsigned key[16];
#pragma unroll
            for (int j = 0; j < 16; ++j) { const float s2 = tops[(2 * hh + 1) * 16 + j]; key[j] = (ord_key(s1 + s2) & ~255u) | (unsigned)(255 - (li * 16 + j)); }
            unsigned mine = 0u;
#pragma unroll 1
            for (int rnd = 0; rnd < 16; ++rnd) {
                unsigned m = key[0];
#pragma unroll
                for (int j = 1; j < 16; ++j) m = max(m, key[j]);
                m = grp16_max(m);
#pragma unroll
                for (int j = 0; j < 16; ++j) key[j] = (key[j] == m) ? 0u : key[j];
                mine = (li == rnd) ? m : mine;
            }
            const int flat = 255 - (int)(mine & 255u);
            const float best = ord_val((mine & ~255u) | 128u);
            const int i1 = topi[(2 * hh) * 16 + (flat >> 4)], i2 = topi[(2 * hh + 1) * 16 + (flat & 15)];
            const float bmax = __shfl(best, F.lane & 48);
            const float e = __expf(best - bmax);
            float se = e; se += __shfl_xor(se, 1); se += __shfl_xor(se, 2); se += __shfl_xor(se, 4); se += __shfl_xor(se, 8);
            EXP[(size_t)tok * 128 + hh * 16 + li] = i1 * 128 + i2;
            GATE[(size_t)tok * 128 + hh * 16 + li] = e / se;
        }
        asm volatile("s_waitcnt lgkmcnt(0)" ::: "memory");
    }
}

__device__ __forceinline__ float gelu_exact(float x) { return 0.5f * x * (1.0f + erff(x * 0.70710678118654752f)); }
__device__ __forceinline__ void p14_gather(const Args& a, Frame& F) {
    const bf16* H1 = (const bf16*)(a.ws + AR_H1); const int* EXP = (const int*)(a.ws + WS_EXP); const float* GATE = (const float*)(a.ws + WS_GATE);
    const bf16* UB = (const bf16*)(a.ws + WS_UB); const bf16* VB = (const bf16*)(a.ws + AR_VB);
    const int lane = F.lane;
    for (int tok = F.gw; tok < NREAL; tok += F.NGW) {
        float x[16], y[16];
        { const v4u w0 = *(const v4u*)(H1 + (size_t)tok * D + lane * 8), w1 = *(const v4u*)(H1 + (size_t)tok * D + 512 + lane * 8);
          const unsigned ww[8] = {w0.x, w0.y, w0.z, w0.w, w1.x, w1.y, w1.z, w1.w};
#pragma unroll
          for (int j = 0; j < 8; ++j) { x[2 * j] = bflo(ww[j]); x[2 * j + 1] = bfhi(ww[j]); y[2 * j] = 0.f; y[2 * j + 1] = 0.f; } }
        const int e0 = EXP[(size_t)tok * 128 + lane], e1 = EXP[(size_t)tok * 128 + 64 + lane];
        const float g0 = GATE[(size_t)tok * 128 + lane], g1 = GATE[(size_t)tok * 128 + 64 + lane];
#pragma unroll 1
        for (int bt = 0; bt < 16; ++bt) {
            float d[8]; int eid[8];
#pragma unroll
            for (int k = 0; k < 8; ++k) {
                const int slot = bt * 8 + k;
                eid[k] = __builtin_amdgcn_readlane(slot < 64 ? e0 : e1, slot & 63);
                const bf16* ur = UB + (size_t)eid[k] * D;
                const v4u w0 = *(const v4u*)(ur + lane * 8), w1 = *(const v4u*)(ur + 512 + lane * 8);
                const unsigned ww[8] = {w0.x, w0.y, w0.z, w0.w, w1.x, w1.y, w1.z, w1.w};
                float s = 0.f;
#pragma unroll
                for (int j = 0; j < 8; ++j) s += x[2 * j] * bflo(ww[j]) + x[2 * j + 1] * bfhi(ww[j]);
                d[k] = s;
            }
#pragma unroll
            for (int k = 0; k < 8; ++k) d[k] = wave_sum(d[k]);
#pragma unroll
            for (int k = 0; k < 8; ++k) {
                const int slot = bt * 8 + k;
                const float g = __builtin_bit_cast(float, __builtin_amdgcn_readlane(__builtin_bit_cast(int, slot < 64 ? g0 : g1), slot & 63));
                const float wgt = g * gelu_exact(d[k]);
                const bf16* vr = VB + (size_t)eid[k] * D;
                const v4u w0 = *(const v4u*)(vr + lane * 8), w1 = *(const v4u*)(vr + 512 + lane * 8);
                const unsigned ww[8] = {w0.x, w0.y, w0.z, w0.w, w1.x, w1.y, w1.z, w1.w};
#pragma unroll
                for (int j = 0; j < 8; ++j) { y[2 * j] += wgt * bflo(ww[j]); y[2 * j + 1] += wgt * bfhi(ww[j]); }
            }
        }
        float s = 0.f;
#pragma unroll
        for (int j = 0; j < 16; ++j) { y[j] = DN_ALPHA * x[j] + y[j]; s += y[j]; }
        const float mean = wave_sum(s) * (1.f / D); float s2 = 0.f;
#pragma unroll
        for (int j = 0; j < 16; ++j) { y[j] -= mean; s2 += y[j] * y[j]; }
        const float rstd = 1.f / sqrtf(wave_sum(s2) * (1.f / D) + LN_EPS);
#pragma unroll
        for (int c = 0; c < 2; ++c)
#pragma unroll
            for (int q = 0; q < 2; ++q) {
                const int col = c * 512 + lane * 8 + q * 4;
                const f32x4 gg = *(const f32x4*)(a.ln2_g + col), bb = *(const f32x4*)(a.ln2_b + col);
                f32x4 o;
#pragma unroll
                for (int e = 0; e < 4; ++e) o[e] = y[c * 8 + q * 4 + e] * rstd * gg[e] + bb[e];
                *(f32x4*)(a.out + (size_t)tok * D + col) = o;
            }
    }
}

constexpr int NPHASES = 15;
__global__ void __launch_bounds__(NTHREADS, 2) fwd_kernel(Args args) {
    extern __shared__ __attribute__((aligned(16))) unsigned char lds_raw[];
    Frame F;
    F.lds = (LAS unsigned char*)lds_raw;
    F.tid = threadIdx.x; F.lane = F.tid & 63; F.wave = __builtin_amdgcn_readfirstlane(F.tid >> 6);
    F.G = gridDim.x; F.gw = blockIdx.x * NWAVES + F.wave; F.NGW = F.G * NWAVES;
    volatile LAS unsigned* MISC = (volatile LAS unsigned*)(F.lds + MISC_OFF);
    for (int u = F.tid; u < (LDS_BYTES - RING_BYTES) / 4; u += NTHREADS) ((LAS unsigned*)(F.lds + RING_BYTES))[u] = 0u;
    __syncthreads();
    unsigned* ctl = (unsigned*)(args.ws + WS_CTL);
    const int lo = args.ph_lo, hi = args.ph_hi;
    XcdBarrier bar; bar.bar = ctl + CW_BAR; bar.x = 0; bar.st = nullptr;
    if (hi - lo > 1) bar = xcd_barrier_post(ctl + CW_BAR, MISC + 8);
#define IN(k) (lo <= (k) && (k) < hi)
#define SEAM(k) do { if (IN(k) && IN((k) + 1)) xcd_barrier(bar); } while (0)
    unsigned char* ws = args.ws;
    bf16* HB = (bf16*)(ws + WS_HB); bf16* WT = (bf16*)(ws + WS_WT);

    if (IN(0)) { p0_prologue(args, F); } SEAM(0);
    if (IN(1)) {
        pg8::Gemm g{HB, WT + (size_t)WT_A0 * D, MROWS, WT_A_N, D}; pg8::StaticOrder S; S.init(MROWS, WT_A_N, F.G, (int)blockIdx.x);
        ep::EpiRot E{(bf16*)(ws + AR_QKVR)};
        pg8::gemm_phase<ep::EpiRot, pg8::StaticOrder, true, true>(F.lds, g, S, E);
    } SEAM(1);
    if (IN(2)) { p2_scan_ret_simple(args, F); } SEAM(2);
    if (IN(3)) {
        pg8::Gemm g{HB, WT + (size_t)WT_B0 * D, MROWS, WT_B_N, D}; pg8::StaticOrder S; S.init(MROWS, WT_B_N, F.G, (int)blockIdx.x);
        ep::EpiDn E{(bf16*)(ws + AR_RAWD), (float*)(ws + AR_GBETA), args.dn_a_log, args.dn_dt_bias};
        pg8::gemm_phase<ep::EpiDn, pg8::StaticOrder, true, true>(F.lds, g, S, E);
    } SEAM(3);
    if (IN(4)) { p4_conv(args, F); } SEAM(4);
    if (IN(5)) { p5_scan_dn_simple(args, F); } SEAM(5);
    if (IN(6)) {
        p6_small_weights(args, F);
        __syncthreads();
        pg8::Gemm g{HB, WT + (size_t)WT_C0 * D, NREAL, WT_C_N, D}; pg8::StaticOrder S; S.init(NREAL, WT_C_N, F.G, (int)blockIdx.x);
        ep::EpiGates E{(bf16*)(ws + AR_GRG), (bf16*)(ws + AR_GDZ), (bf16*)(ws + AR_GGA), (bf16*)(ws + AR_GGB)};
        pg8::gemm_phase<ep::EpiGates, pg8::StaticOrder, true, true>(F.lds, g, S, E);
    } SEAM(6);
    if (IN(7)) { p7_gate_norm(args, F); } SEAM(7);
    if (IN(8)) {
        pg8::Gemm g{(const bf16*)args.out, (const bf16*)(ws + AR_PRETT), NREAL, 1024, 2048}; pg8::StaticOrder S; S.init(NREAL, 1024, F.G, (int)blockIdx.x);
        ep::EpiMerge<false> E{(const bf16*)(ws + AR_GGA), nullptr, (bf16*)(ws + AR_M1)};
        pg8::gemm_phase<ep::EpiMerge<false>, pg8::StaticOrder, true, true>(F.lds, g, S, E);
    } SEAM(8);
    if (IN(9)) {
        pg8::Gemm g{(const bf16*)(ws + AR_OD), (const bf16*)(ws + AR_PDNT), NREAL, 1024, 1024}; pg8::StaticOrder S; S.init(NREAL, 1024, F.G, (int)blockIdx.x);
        ep::EpiMerge<true> E{(const bf16*)(ws + AR_GGB), (const bf16*)(ws + AR_M1), (bf16*)(ws + AR_MERGED)};
        pg8::gemm_phase<ep::EpiMerge<true>, pg8::StaticOrder, true, true>(F.lds, g, S, E);
    } SEAM(9);
    if (IN(10)) {
        pg8::Gemm g{(const bf16*)(ws + AR_MERGED), (const bf16*)(ws + AR_WOUTT), NREAL, 1024, 1024}; pg8::StaticOrder S; S.init(NREAL, 1024, F.G, (int)blockIdx.x);
        ep::EpiRes E{HB, (float*)(ws + AR_PRE)};
        pg8::gemm_phase<ep::EpiRes, pg8::StaticOrder, true, true>(F.lds, g, S, E);
    } SEAM(10);
    if (IN(11)) { p11_ln1_tables(args, F); } SEAM(11);
    if (IN(12)) {
        pg8::Gemm g{(const bf16*)(ws + AR_H1), (const bf16*)(ws + AR_W2T), NREAL, 2048, 1024}; pg8::StaticOrder S; S.init(NREAL, 2048, F.G, (int)blockIdx.x);
        ep::EpiF32 E{(float*)(ws + AR_SCORES), 2048};
        pg8::gemm_phase<ep::EpiF32, pg8::StaticOrder, true, true>(F.lds, g, S, E);
    } SEAM(12);
    if (IN(13)) { p13_topk(args, F); } SEAM(13);
    if (IN(14)) { p14_gather(args, F); }
#undef IN
#undef SEAM
}

#ifndef N_LAUNCH_MODE
#define N_LAUNCH_MODE 1
#endif
extern "C" void kernel_launch(void* const* d_in, const int* in_sizes, int n_in, void* d_out, int out_size, void* d_ws, size_t ws_size, hipStream_t stream) {
    static int grid = 0;
    if (grid == 0) {
        if (n_in != 21 || out_size != NREAL * D || ws_size < WS_END) { fprintf(stderr, "kernel_launch: unexpected shapes (n_in %d, out %d, ws %zu)\n", n_in, out_size, ws_size); grid = -1; return; }
        int dev = 0, cus = 0;
        if (hipGetDevice(&dev) != hipSuccess || hipDeviceGetAttribute(&cus, hipDeviceAttributeMultiprocessorCount, dev) != hipSuccess) { grid = -1; return; }
        if (hipFuncSetAttribute((const void*)fwd_kernel, hipFuncAttributeMaxDynamicSharedMemorySize, LDS_BYTES) != hipSuccess) { grid = -1; return; }
        int per_cu = 0;
        (void)hipOccupancyMaxActiveBlocksPerMultiprocessor(&per_cu, (const void*)fwd_kernel, NTHREADS, LDS_BYTES);
        (void)hipGetLastError();
        grid = cus;
    }
    if (grid < 0) return;
    (void)hipMemsetAsync((char*)d_ws + WS_CTL, 0, CTL_ZERO_BYTES, stream);
    Args a{};
    const float** fp = (const float**)&a;
    for (int i = 0; i < 21; ++i) fp[i] = (const float*)d_in[i];
    a.out = (float*)d_out; a.ws = (unsigned char*)d_ws;
    if (N_LAUNCH_MODE == 1) {
        a.ph_lo = 0; a.ph_hi = NPHASES;
        hipLaunchKernelGGL(fwd_kernel, dim3(grid), dim3(NTHREADS), LDS_BYTES, stream, a);
    } else {
        for (int p = 0; p < NPHASES; ++p) { a.ph_lo = p; a.ph_hi = p + 1; hipLaunchKernelGGL(fwd_kernel, dim3(grid), dim3(NTHREADS), LDS_BYTES, stream, a); }
    }
}
```

```cpp
#include <hip/hip_runtime.h>
#include <cstdio>
#include <cstdint>
namespace pg8 {
#define PG8_LAS __attribute__((address_space(3)))
typedef unsigned short bf16_t;
typedef short bf16x8 __attribute__((ext_vector_type(8)));
typedef float f32x4 __attribute__((ext_vector_type(4)));
typedef unsigned u32x4 __attribute__((ext_vector_type(4)));
constexpr int BM = 256, BK = 64, HALF = 128, HTB = HALF * BK * 2  , STAGE_BYTES = 8 * HTB, NXCD = 8, WGM = 8;

__host__ __device__ __forceinline__ int lds_byte(int r, int c) { const int st = (r >> 4) * 2 + (c >> 5), rr = r & 15, cc = c & 31, ob = rr * 64 + cc * 2; return st * 1024 + (ob ^ (((ob >> 9) & 1) << 5)); }
__host__ __device__ __forceinline__ void stage_rc(int b, int& R, int& C) { const int st = b / 1024, sb = b % 1024, swz = sb ^ (((sb >> 9) & 1) << 5); R = (st >> 1) * 16 + swz / 64; C = (st & 1) * 32 + (swz % 64) / 2; }
__host__ __device__ __forceinline__ int perm32(int rho) { const int n = rho >> 4, i = rho & 15; return 8 * (i >> 2) + 4 * n + (i & 3); }

struct Unit { int pm, pn; };
struct Gemm { const bf16_t* A; const bf16_t* Bt; int M, N, K; };

struct StaticOrder {
    int nM, nN, nwg, G, c;
    __host__ __device__ void init(int M, int N, int G_, int c_) { nM = M / BM; nN = N / BM; nwg = nM * nN; G = G_; c = c_; }
    __host__ __device__ bool next(int i, Unit& u) const {
        const long L = (long)i * G + c; if (L >= nwg) return false;
        int wgid = (int)L; { const int q = nwg / NXCD, r = nwg % NXCD, xcd = wgid % NXCD, off = wgid / NXCD; wgid = (xcd < r ? xcd * (q + 1) : r * (q + 1) + (xcd - r) * q) + off; }
        const int nig = WGM * nN, gid = wgid / nig, fm = gid * WGM, gsz = (nM - fm) < WGM ? (nM - fm) : WGM;
        u.pm = fm + ((wgid % nig) % gsz); u.pn = (wgid % nig) / gsz; return true;
    }
    __device__ __forceinline__ void a_ready(const Unit&) const {}
    __device__ __forceinline__ void done(const Unit&) const {}
};
__device__ __forceinline__ unsigned cvt_pk_bf16(float lo, float hi) { unsigned r; asm volatile("v_cvt_pk_bf16_f32 %0, %1, %2" : "=v"(r) : "v"(lo), "v"(hi)); return r; }
template <class Epi, class Sched, bool ALIGN_EPI = false, bool SP2 = false>
__device__ __forceinline__ void gemm_phase(PG8_LAS unsigned char* lds, const Gemm g, const Sched& S, const Epi& E) {
    const int tid = threadIdx.x, wid = __builtin_amdgcn_readfirstlane(tid >> 6), lane = tid & 63, wr = wid >> 2, wc = wid & 3, fr = lane & 15, fq = lane >> 4;
    const int K = g.K, nt = K / BK;
    unsigned voffA[2], voffB[2];
#pragma unroll
    for (int i = 0; i < 2; ++i) { int R, C; stage_rc(tid * 16 + i * 8192, R, C); const int Rb = Epi::PERM ? ((R & ~31) + perm32(R & 31)) : R;
        voffA[i] = (unsigned)(R * K + C) * 2u; voffB[i] = (unsigned)(Rb * K + C) * 2u; }
    const size_t kstep = (size_t)(BK * 2);
    const size_t hstep = (size_t)HALF * K * 2;
    const size_t tstep = 2 * hstep;
    const unsigned ldsw = (unsigned)wid * 1024u;
    const int aoff = lds_byte(wr * 64 + fr, fq * 8), boff = lds_byte(wc * 32 + fr, fq * 8);
#define PG8_SA(b, h) (((b) * 2 + (h)) * HTB)
#define PG8_SB(b, h) ((4 + (b) * 2 + (h)) * HTB)
#define PG8_STAGE(bufoff, gbase, voff) do { _Pragma("unroll") for (int _i = 0; _i < 2; ++_i) \
        __builtin_amdgcn_global_load_lds((const unsigned*)((const char*)(gbase) + (voff)[_i]), (PG8_LAS unsigned*)(lds + (bufoff) + ldsw + _i * 8192), 16, 0, 0); } while (0)
#define PG8_LDA(dst, b, h) do { _Pragma("unroll") for (int m = 0; m < 4; ++m) _Pragma("unroll") for (int k = 0; k < 2; ++k) dst[m][k] = *(const PG8_LAS bf16x8*)(lds + PG8_SA(b, h) + aoff + m * 2048 + k * 1024); } while (0)
#define PG8_LDB(dst, b, h) do { _Pragma("unroll") for (int n = 0; n < 2; ++n) _Pragma("unroll") for (int k = 0; k < 2; ++k) dst[n][k] = *(const PG8_LAS bf16x8*)(lds + PG8_SB(b, h) + boff + n * 2048 + k * 1024); } while (0)
#define PG8_MMA(ai, bj, At, Bt) do { __builtin_amdgcn_s_setprio(1); _Pragma("unroll") for (int m = 0; m < 4; ++m) _Pragma("unroll") for (int n = 0; n < 2; ++n) _Pragma("unroll") for (int k = 0; k < 2; ++k) \
        acc[ai][bj][m][n] = __builtin_amdgcn_mfma_f32_16x16x32_bf16(Bt[n][k], At[m][k], acc[ai][bj][m][n], 0, 0, 0); __builtin_amdgcn_s_setprio(0); } while (0)
#define PG8_WAIT_V(n) asm volatile("s_waitcnt vmcnt(" #n ")" ::: "memory")
#define PG8_WAIT_L(n) asm volatile("s_waitcnt lgkmcnt(" #n ")" ::: "memory")
#define PG8_BAR __builtin_amdgcn_s_barrier()
#define PG8_SCHED __builtin_amdgcn_sched_barrier(0)
    Unit cur, nxt; int ui = 0;
    if (!S.next(0, cur)) return;
    f32x4 acc[2][2][4][2];
#pragma unroll
    for (int a = 0; a < 2; ++a)
#pragma unroll
        for (int b = 0; b < 2; ++b)
#pragma unroll
            for (int m = 0; m < 4; ++m)
#pragma unroll
                for (int n = 0; n < 2; ++n) acc[a][b][m][n] = (f32x4){0.f, 0.f, 0.f, 0.f};
    bf16x8 At[4][2], B0[2][2], B1[2][2];
    const char* cA = (const char*)g.A + (size_t)cur.pm * tstep; const char* cB = (const char*)g.Bt + (size_t)cur.pn * tstep;
    S.a_ready(cur);
    if constexpr (SP2) {
        PG8_STAGE(PG8_SB(0, 0), cB, voffB); PG8_STAGE(PG8_SB(0, 1), cB + hstep, voffB); PG8_STAGE(PG8_SA(0, 0), cA, voffA); PG8_STAGE(PG8_SA(0, 1), cA + hstep, voffA);
        if (wr == 1) PG8_BAR;
        PG8_WAIT_V(2); PG8_BAR;
        PG8_STAGE(PG8_SB(1, 0), cB + kstep, voffB); PG8_STAGE(PG8_SA(1, 0), cA + kstep, voffA); PG8_STAGE(PG8_SB(1, 1), cB + hstep + kstep, voffB);
        PG8_WAIT_V(6); PG8_BAR;
    } else {
        PG8_STAGE(PG8_SB(0, 0), cB, voffB); PG8_STAGE(PG8_SA(0, 0), cA, voffA); PG8_STAGE(PG8_SB(0, 1), cB + hstep, voffB); PG8_STAGE(PG8_SA(0, 1), cA + hstep, voffA);
        if (wr == 1) PG8_BAR;
        PG8_WAIT_V(4); PG8_BAR;
        PG8_STAGE(PG8_SB(1, 0), cB + kstep, voffB); PG8_STAGE(PG8_SA(1, 0), cA + kstep, voffA); PG8_STAGE(PG8_SB(1, 1), cB + hstep + kstep, voffB);
        PG8_WAIT_V(6); PG8_BAR;
    }
    for (;;) {
        const bool has_next = S.next(ui + 1, nxt);
        const char* nA = has_next ? (const char*)g.A + (size_t)nxt.pm * tstep : cA; const char* nB = has_next ? (const char*)g.Bt + (size_t)nxt.pn * tstep : cB;
        for (int t = 0; t < nt; t += 2) {
            const bool last = (t == nt - 2);
            const char* a1 = cA + (size_t)(t + 1) * kstep;
            const char* a2 = last ? nA : cA + (size_t)(t + 2) * kstep; const char* b2 = last ? nB : cB + (size_t)(t + 2) * kstep;
            const char* a3 = a2 + kstep; const char* b3 = b2 + kstep;
            if (last && has_next) S.a_ready(nxt);
            if constexpr (SP2) {
            PG8_LDB(B0, 0, 0); PG8_LDB(B1, 0, 1); PG8_SCHED; PG8_LDA(At, 0, 0); PG8_STAGE(PG8_SA(1, 1), a1 + hstep, voffA);
            PG8_WAIT_V(8); PG8_WAIT_L(0); PG8_BAR; PG8_MMA(0, 0, At, B0); PG8_MMA(0, 1, At, B1); PG8_BAR; PG8_SCHED;
            PG8_LDA(At, 0, 1); PG8_STAGE(PG8_SB(0, 0), b2, voffB); PG8_STAGE(PG8_SB(0, 1), b2 + hstep, voffB); PG8_STAGE(PG8_SA(0, 0), a2, voffA);
            PG8_WAIT_V(8); PG8_WAIT_L(0); PG8_BAR; PG8_MMA(1, 0, At, B0); PG8_MMA(1, 1, At, B1); PG8_BAR; PG8_SCHED;
            PG8_LDB(B0, 1, 0); PG8_LDB(B1, 1, 1); PG8_SCHED; PG8_LDA(At, 1, 0); PG8_STAGE(PG8_SA(0, 1), a2 + hstep, voffA);
            PG8_WAIT_V(8); PG8_WAIT_L(0); PG8_BAR; PG8_MMA(0, 0, At, B0); PG8_MMA(0, 1, At, B1); PG8_BAR; PG8_SCHED;
            PG8_LDA(At, 1, 1); PG8_STAGE(PG8_SB(1, 0), b3, voffB); PG8_STAGE(PG8_SB(1, 1), b3 + hstep, voffB); PG8_STAGE(PG8_SA(1, 0), a3, voffA);
            PG8_WAIT_V(8); PG8_WAIT_L(0); PG8_BAR; PG8_MMA(1, 0, At, B0); PG8_MMA(1, 1, At, B1); PG8_BAR; PG8_SCHED;
            } else {
            PG8_LDB(B0, 0, 0); PG8_SCHED; PG8_LDA(At, 0, 0); PG8_STAGE(PG8_SA(1, 1), a1 + hstep, voffA);
            PG8_WAIT_L(8); PG8_BAR; PG8_WAIT_L(0); PG8_MMA(0, 0, At, B0); PG8_BAR; PG8_SCHED;
            PG8_LDB(B1, 0, 1); PG8_STAGE(PG8_SB(0, 0), b2, voffB);
            PG8_BAR; PG8_WAIT_L(0); PG8_MMA(0, 1, At, B1); PG8_BAR;
            PG8_LDA(At, 0, 1); PG8_STAGE(PG8_SA(0, 0), a2, voffA);
            PG8_BAR; PG8_WAIT_L(0); PG8_MMA(1, 0, At, B0); PG8_BAR; PG8_SCHED;
            PG8_STAGE(PG8_SB(0, 1), b2 + hstep, voffB);
            PG8_WAIT_V(6); PG8_BAR; PG8_MMA(1, 1, At, B1); PG8_BAR;
            PG8_LDB(B0, 1, 0); PG8_SCHED; PG8_LDA(At, 1, 0); PG8_STAGE(PG8_SA(0, 1), a2 + hstep, voffA);
            PG8_WAIT_L(8); PG8_BAR; PG8_WAIT_L(0); PG8_MMA(0, 0, At, B0); PG8_BAR; PG8_SCHED;
            PG8_LDB(B1, 1, 1); PG8_STAGE(PG8_SB(1, 0), b3, voffB);
            PG8_BAR; PG8_WAIT_L(0); PG8_MMA(0, 1, At, B1); PG8_BAR;
            PG8_LDA(At, 1, 1); PG8_STAGE(PG8_SA(1, 0), a3, voffA);
            PG8_BAR; PG8_WAIT_L(0); PG8_MMA(1, 0, At, B0); PG8_BAR; PG8_SCHED;
            PG8_STAGE(PG8_SB(1, 1), b3 + hstep, voffB);
            PG8_WAIT_V(6); PG8_BAR; PG8_MMA(1, 1, At, B1); PG8_BAR;
            }
        }
        if constexpr (ALIGN_EPI) { if (wr == 0) PG8_BAR; }
        if constexpr (!Epi::AFTER_DRAIN) { E(acc, cur, wr, wc, fr, fq); S.done(cur); }
        if (!has_next) break;
#pragma unroll
        for (int a = 0; a < 2; ++a)
#pragma unroll
            for (int b = 0; b < 2; ++b)
#pragma unroll
                for (int m = 0; m < 4; ++m)
#pragma unroll
                    for (int n = 0; n < 2; ++n) acc[a][b][m][n] = (f32x4){0.f, 0.f, 0.f, 0.f};
        cur = nxt; cA = nA; cB = nB; ++ui;
        if constexpr (ALIGN_EPI) { if (wr == 1) PG8_BAR; }
    }
    PG8_WAIT_V(0);
    if constexpr (!ALIGN_EPI) { if (wr == 0) PG8_BAR; }
    PG8_BAR;
    if constexpr (Epi::AFTER_DRAIN) { E.fused(acc, cur, wr, wc, fr, fq, lds, wid, lane); S.done(cur); }
#undef PG8_SA
#undef PG8_SB
#undef PG8_STAGE
#undef PG8_LDA
#undef PG8_LDB
#undef PG8_MMA
#undef PG8_WAIT_V
#undef PG8_WAIT_L
#undef PG8_BAR
#undef PG8_SCHED
}
}
#define XB_TMO      128
#define XB_XCNT(j)  (256  + 64 * (j))
#define XB_XSUB(j)  (1280 + 64 * (j))
#define XB_XGEN(j)  (2304 + 64 * (j))
#define XB_TOP      3328
#define XB_TOPGEN   3392
#define XCD_BAR_WORDS 3456
#define XB_SPIN_CAP (1u << 18)
#define LAS __attribute__((address_space(3)))

__device__ __forceinline__ unsigned xb_ld(unsigned* p)              { return __hip_atomic_load(p, __ATOMIC_RELAXED, __HIP_MEMORY_SCOPE_AGENT); }
__device__ __forceinline__ unsigned xb_add(unsigned* p, unsigned v) { return __hip_atomic_fetch_add(p, v, __ATOMIC_RELAXED, __HIP_MEMORY_SCOPE_AGENT); }
__device__ __forceinline__ unsigned xb_xcc_id() { return (unsigned)__builtin_amdgcn_s_getreg((3 << 11) | 20) & 0xFu; }
#define XB_SPIN(cond, bar) do { unsigned _sp = 0; while (cond) { __builtin_amdgcn_s_sleep(1); \
    if ((++_sp & 255u) == 0u) { if (xb_ld(&(bar)[XB_TMO])) break; if (_sp > XB_SPIN_CAP) { atomicAdd(&(bar)[XB_TMO], 1u); break; } } } } while (0)

struct XcdBarrier {
    unsigned* bar; unsigned x;
    volatile LAS unsigned* st;
};

__device__ __forceinline__ XcdBarrier xcd_barrier_post(unsigned* bar, volatile LAS unsigned* st) {
    XcdBarrier b; b.bar = bar; b.x = xb_xcc_id(); b.st = st;
    if (threadIdx.x == 0) (void)xb_add(&bar[XB_XCNT(b.x)], 1u);
    return b;
}
__device__ __forceinline__ void xcd_barrier_complete(unsigned* bar, unsigned x, unsigned& nloc, unsigned& nx) {
    const unsigned G = gridDim.x * gridDim.y * gridDim.z;
    unsigned sum, cnt, mine, sp = 0u;
    for (;;) {
        sum = 0u; cnt = 0u; mine = 0u;
#pragma unroll
        for (unsigned j = 0; j < 16; ++j) { const unsigned c = xb_ld(&bar[XB_XCNT(j)]); sum += c; cnt += (c > 0u) ? 1u : 0u; mine = (j == x) ? c : mine; }
        if (sum == G) break;
        __builtin_amdgcn_s_sleep(1);
        if ((++sp & 255u) == 0u) { if (xb_ld(&bar[XB_TMO])) break; if (sp > XB_SPIN_CAP) { atomicAdd(&bar[XB_TMO], 1u); break; } }
    }
    nloc = mine > 0u ? mine : 1u; nx = cnt > 0u ? cnt : 1u;
}

__device__ __forceinline__ void xcd_barrier(const XcdBarrier& b) {
    asm volatile("s_waitcnt vmcnt(0)" ::: "memory");
    __syncthreads();
    if (threadIdx.x == 0) {
        unsigned* bar = b.bar;
        __builtin_amdgcn_s_waitcnt(0);
        unsigned nloc = b.st[0], nx = b.st[1];
        if (nloc == 0u) { xcd_barrier_complete(bar, b.x, nloc, nx); b.st[0] = nloc; b.st[1] = nx; }
        const unsigned old = xb_add(&bar[XB_XSUB(b.x)], 1u);
        const unsigned gen = old / nloc;
        if (old + 1u == (gen + 1u) * nloc) {
            __builtin_amdgcn_fence(__ATOMIC_RELEASE, "agent");
            asm volatile("s_waitcnt vmcnt(0)" ::: "memory");
            const unsigned og = xb_add(&bar[XB_TOP], 1u);
            const unsigned tg = og / nx;
            if (og + 1u == (tg + 1u) * nx) xb_add(&bar[XB_TOPGEN], 1u);
            else XB_SPIN(xb_ld(&bar[XB_TOPGEN]) == tg, bar);
            __builtin_amdgcn_fence(__ATOMIC_ACQUIRE, "agent");
            xb_add(&bar[XB_XGEN(b.x)], 1u);
            asm volatile("s_waitcnt vmcnt(0)" ::: "memory");
        } else {
            XB_SPIN(xb_ld(&bar[XB_XGEN(b.x)]) == gen, bar);
            __builtin_amdgcn_fence(__ATOMIC_ACQUIRE, "agent");
            asm volatile("s_waitcnt vmcnt(0)" ::: "memory");
        }
    }
    __syncthreads();
}

constexpr int D = 1024, BATCH = 8, SEQ = 2048, NMETA = 16, LTOT = SEQ + NMETA;
constexpr int NREAL = BATCH * SEQ;
constexpr int MROWS = 16640;
constexpr int NROWS_D = NREAL + BATCH * NMETA;
constexpr int IN_W = 12320;
constexpr int RH = 4, RDK = 256, RDV = 512;
constexpr int DH = 8, DDK = 128, DDV = 128;
constexpr int NEXP = 16384, PH = 8, PK = 16;
constexpr int WT_ROWS = 12544, WT_A0 = 0, WT_A_N = 4096, WT_B0 = 4096, WT_B_N = 3328, WT_C0 = 7424, WT_C_N = 5120;
constexpr float LN_EPS = 1e-5f, RMS_EPS = 1e-6f;
constexpr float DN_ALPHA = 1.189207115f;

constexpr size_t MiB = 1u << 20;
constexpr size_t WS_CTL = 0, CTL_ZERO_BYTES = 1 * MiB;
constexpr size_t WS_HB = 1 * MiB;
constexpr size_t WS_WT = WS_HB + (size_t)MROWS * D * 2;
constexpr size_t WS_AR = 58 * MiB;
constexpr size_t WS_END = 264 * MiB;
static_assert(WS_WT + (size_t)WT_ROWS * D * 2 <= WS_AR, "map");
constexpr size_t AR_QKVR = WS_AR;
constexpr size_t AR_RAWD = WS_AR;
constexpr size_t AR_GBETA = WS_AR + 97 * MiB + 512 * 1024;
constexpr size_t AR_QKVD = WS_AR + 100 * MiB;
constexpr size_t AR_OD = WS_AR;
constexpr size_t AR_GRG = WS_AR + 32 * MiB, AR_GDZ = WS_AR + 96 * MiB, AR_GGA = WS_AR + 128 * MiB, AR_GGB = WS_AR + 160 * MiB;
constexpr size_t AR_PRETT = WS_AR + 192 * MiB, AR_PDNT = WS_AR + 196 * MiB, AR_WOUTT = WS_AR + 198 * MiB, AR_W2T = WS_AR + 200 * MiB;
constexpr size_t AR_M1 = WS_AR + 32 * MiB, AR_MERGED = WS_AR + 64 * MiB, AR_PRE = WS_AR + 96 * MiB;
constexpr size_t AR_H1 = WS_AR;
constexpr size_t WS_UB = 1 * MiB, AR_VB = WS_AR + 160 * MiB;
constexpr size_t AR_SCORES = WS_AR + 32 * MiB;
constexpr size_t WS_EXP = WS_WT, WS_GATE = WS_WT + 8 * MiB;
static_assert(AR_QKVD + (size_t)NROWS_D * 3072 * 2 <= WS_END && AR_W2T + 4 * MiB <= WS_END && AR_GBETA + (size_t)MROWS * 32 * 4 <= AR_QKVD, "map");
constexpr int CW_BAR = 4096;

constexpr int RING_BYTES = 131072, MISC_OFF = RING_BYTES + 320, LDS_BYTES = 147456;
constexpr int NWAVES = 8, NTHREADS = 512;

#define GAS __attribute__((address_space(1)))
#define LAS __attribute__((address_space(3)))
typedef unsigned short bf16;
typedef unsigned v4u __attribute__((ext_vector_type(4)));
typedef unsigned v2u __attribute__((ext_vector_type(2)));
typedef float f32x4 __attribute__((ext_vector_type(4)));
#define RLX_AGENT __ATOMIC_RELAXED, __HIP_MEMORY_SCOPE_AGENT

__device__ __forceinline__ unsigned f2bf(float f) { unsigned u = __builtin_bit_cast(unsigned, f); return (u + 0x7fffu + ((u >> 16) & 1u)) >> 16; }
__device__ __forceinline__ unsigned pk2(float lo, float hi) { return f2bf(lo) | (f2bf(hi) << 16); }
__device__ __forceinline__ float bflo(unsigned u) { return __builtin_bit_cast(float, u << 16); }
__device__ __forceinline__ float bfhi(unsigned u) { return __builtin_bit_cast(float, u & 0xffff0000u); }
__device__ __forceinline__ float bf2f(bf16 h) { return __builtin_bit_cast(float, ((unsigned)h) << 16); }
__device__ __forceinline__ float sigmoidf_(float x) { return 1.0f / (1.0f + __expf(-x)); }
__device__ __forceinline__ float siluf_(float x) { return x / (1.0f + __expf(-x)); }
__device__ __forceinline__ float wave_sum(float v) {
#pragma unroll
    for (int o = 1; o < 64; o <<= 1) v += __shfl_xor(v, o);
    return v;
}
__device__ __forceinline__ int row_of(int b, int p) { return p < NMETA ? NREAL + p : b * SEQ + (p - NMETA); }
__device__ __forceinline__ int rowd_of(int b, int p) { return p < NMETA ? NREAL + b * NMETA + p : b * SEQ + (p - NMETA); }

struct Args {
    const float *x, *meta, *emb_g, *emb_b, *w_in, *ret_decay, *dn_conv, *dn_a_log, *dn_dt_bias, *dn_norm_g, *p_ret, *p_dn, *w_out, *ln1_g, *ln1_b,
                *peer_wq, *peer_keys, *peer_u, *peer_v, *ln2_g, *ln2_b;
    float* out; unsigned char* ws; int ph_lo, ph_hi;
};

struct Frame {
    LAS unsigned char* lds;
    int tid, lane, wave, G, gw, NGW;
};

namespace ep {
using pg8::f32x4; using pg8::Unit; using pg8::u32x4; using pg8::cvt_pk_bf16;
__device__ __forceinline__ u32x4 pack8(f32x4 a, f32x4 b) { u32x4 w; w.x = cvt_pk_bf16(a[0], a[1]); w.y = cvt_pk_bf16(a[2], a[3]); w.z = cvt_pk_bf16(b[0], b[1]); w.w = cvt_pk_bf16(b[2], b[3]); return w; }
__device__ __forceinline__ void unpack8(u32x4 w, f32x4& a, f32x4& b) { a = (f32x4){bflo(w.x), bfhi(w.x), bflo(w.y), bfhi(w.y)}; b = (f32x4){bflo(w.z), bfhi(w.z), bflo(w.w), bfhi(w.w)}; }

struct EpiRot {
    static constexpr bool PERM = true, AFTER_DRAIN = false;
    bf16* O;
    __device__ __forceinline__ void operator()(const f32x4 (&acc)[2][2][4][2], const Unit& u, int wr, int wc, int fr, int fq) const {
        const int row0 = u.pm * 256 + wr * 64 + fr, colb = wc * 32 + 8 * fq;
        if (u.pn < 8) {
            const float sc = (u.pn >= 4) ? 0.0625f : 1.0f;
            float rev[8];
#pragma unroll
            for (int e = 0; e < 8; ++e) rev[e] = exp2f(-(float)(colb + e) * (13.287712379549449f / 128.0f)) * 0.15915494309189535f;
#pragma unroll
            for (int ai = 0; ai < 2; ++ai)
#pragma unroll
                for (int m = 0; m < 4; ++m) {
                    const int r = row0 + ai * 128 + m * 16;
                    const float pos = (float)(r < NREAL ? (r & (SEQ - 1)) + NMETA : r - NREAL);
                    f32x4 o1[2], o2[2];
#pragma unroll
                    for (int n = 0; n < 2; ++n)
#pragma unroll
                        for (int e = 0; e < 4; ++e) {
                            float t = pos * rev[n * 4 + e]; t = t - floorf(t);
                            const float s = __builtin_amdgcn_sinf(t), c = __builtin_amdgcn_cosf(t);
                            const float x1 = acc[ai][0][m][n][e], x2 = acc[ai][1][m][n][e];
                            o1[n][e] = (x1 * c - x2 * s) * sc; o2[n][e] = (x1 * s + x2 * c) * sc;
                        }
                    bf16* rowp = O + (size_t)r * 4096 + u.pn * 256 + colb;
                    *(u32x4*)(rowp) = pack8(o1[0], o1[1]);
                    *(u32x4*)(rowp + 128) = pack8(o2[0], o2[1]);
                }
        } else {
#pragma unroll
            for (int ai = 0; ai < 2; ++ai)
#pragma unroll
                for (int m = 0; m < 4; ++m) {
                    bf16* rowp = O + (size_t)(row0 + ai * 128 + m * 16) * 4096 + u.pn * 256 + colb;
#pragma unroll
                    for (int bj = 0; bj < 2; ++bj) *(u32x4*)(rowp + bj * 128) = pack8(acc[ai][bj][m][0], acc[ai][bj][m][1]);
                }
        }
    }
};
struct EpiDn {
    static constexpr bool PERM = true, AFTER_DRAIN = false;
    bf16* O; float* GB; const float* a_log; const float* dt_bias;
    __device__ __forceinline__ void operator()(const f32x4 (&acc)[2][2][4][2], const Unit& u, int wr, int wc, int fr, int fq) const {
        const int row0 = u.pm * 256 + wr * 64 + fr, colb = wc * 32 + 8 * fq;
        if (u.pn < 12) {
#pragma unroll
            for (int ai = 0; ai < 2; ++ai)
#pragma unroll
                for (int m = 0; m < 4; ++m) {
                    bf16* rowp = O + (size_t)(row0 + ai * 128 + m * 16) * 3072 + u.pn * 256 + colb;
#pragma unroll
                    for (int bj = 0; bj < 2; ++bj) *(u32x4*)(rowp + bj * 128) = pack8(acc[ai][bj][m][0], acc[ai][bj][m][1]);
                }
        } else if (wc == 0) {
            float ea[8], db[8];
#pragma unroll
            for (int e = 0; e < 8; ++e) { const int c = (colb + e) & 15; ea[e] = -__expf(a_log[c]); db[e] = dt_bias[c]; }
#pragma unroll
            for (int ai = 0; ai < 2; ++ai)
#pragma unroll
                for (int m = 0; m < 4; ++m) {
                    float* rowp = GB + (size_t)(row0 + ai * 128 + m * 16) * 32 + colb;
                    f32x4 o[2];
#pragma unroll
                    for (int n = 0; n < 2; ++n)
#pragma unroll
                        for (int e = 0; e < 4; ++e) {
                            const float v = acc[ai][0][m][n][e];
                            if (colb < 16) { const float z = v + db[n * 4 + e]; const float sp = z > 20.f ? z : log1pf(__expf(z)); o[n][e] = ea[n * 4 + e] * sp; }
                            else o[n][e] = sigmoidf_(v);
                        }
                    *(f32x4*)(rowp) = o[0]; *(f32x4*)(rowp + 4) = o[1];
                }
        }
    }
};
struct EpiGates {
    static constexpr bool PERM = true, AFTER_DRAIN = false;
    bf16 *rg, *dz, *ga, *gb;
    __device__ __forceinline__ void operator()(const f32x4 (&acc)[2][2][4][2], const Unit& u, int wr, int wc, int fr, int fq) const {
        const int row0 = u.pm * 256 + wr * 64 + fr, colb = wc * 32 + 8 * fq;
        bf16* base; int ld, ct;
        if (u.pn < 8) { base = rg; ld = 2048; ct = u.pn; } else if (u.pn < 12) { base = dz; ld = 1024; ct = u.pn - 8; } else if (u.pn < 16) { base = ga; ld = 1024; ct = u.pn - 12; } else { base = gb; ld = 1024; ct = u.pn - 16; }
#pragma unroll
        for (int ai = 0; ai < 2; ++ai)
#pragma unroll
            for (int m = 0; m < 4; ++m) {
                bf16* rowp = base + (size_t)(row0 + ai * 128 + m * 16) * ld + ct * 256 + colb;
#pragma unroll
                for (int bj = 0; bj < 2; ++bj) *(u32x4*)(rowp + bj * 128) = pack8(acc[ai][bj][m][0], acc[ai][bj][m][1]);
            }
    }
};
template <bool ADD> struct EpiMerge {
    static constexpr bool PERM = true, AFTER_DRAIN = false;
    const bf16* gate; const bf16* prev; bf16* O;
    __device__ __forceinline__ void operator()(const f32x4 (&acc)[2][2][4][2], const Unit& u, int wr, int wc, int fr, int fq) const {
        const int row0 = u.pm * 256 + wr * 64 + fr, colb = u.pn * 256 + wc * 32 + 8 * fq;
#pragma unroll
        for (int ai = 0; ai < 2; ++ai)
#pragma unroll
            for (int m = 0; m < 4; ++m) {
                const size_t off = (size_t)(row0 + ai * 128 + m * 16) * 1024 + colb;
#pragma unroll
                for (int bj = 0; bj < 2; ++bj) {
                    f32x4 g0, g1; unpack8(*(const u32x4*)(gate + off + bj * 128), g0, g1);
                    f32x4 o0, o1;
#pragma unroll
                    for (int e = 0; e < 4; ++e) { o0[e] = sigmoidf_(g0[e]) * acc[ai][bj][m][0][e]; o1[e] = sigmoidf_(g1[e]) * acc[ai][bj][m][1][e]; }
                    if (ADD) { f32x4 p0, p1; unpack8(*(const u32x4*)(prev + off + bj * 128), p0, p1); o0 += p0; o1 += p1; }
                    *(u32x4*)(O + off + bj * 128) = pack8(o0, o1);
                }
            }
    }
};
struct EpiRes {
    static constexpr bool PERM = true, AFTER_DRAIN = false;
    const bf16* H; float* O;
    __device__ __forceinline__ void operator()(const f32x4 (&acc)[2][2][4][2], const Unit& u, int wr, int wc, int fr, int fq) const {
        const int row0 = u.pm * 256 + wr * 64 + fr, colb = u.pn * 256 + wc * 32 + 8 * fq;
#pragma unroll
        for (int ai = 0; ai < 2; ++ai)
#pragma unroll
            for (int m = 0; m < 4; ++m) {
                const size_t off = (size_t)(row0 + ai * 128 + m * 16) * 1024 + colb;
#pragma unroll
                for (int bj = 0; bj < 2; ++bj) {
                    f32x4 h0, h1; unpack8(*(const u32x4*)(H + off + bj * 128), h0, h1);
                    *(f32x4*)(O + off + bj * 128) = h0 * DN_ALPHA + acc[ai][bj][m][0];
                    *(f32x4*)(O + off + bj * 128 + 4) = h1 * DN_ALPHA + acc[ai][bj][m][1];
                }
            }
    }
};
struct EpiF32 {
    static constexpr bool PERM = true, AFTER_DRAIN = false;
    float* O; int ld;
    __device__ __forceinline__ void operator()(const f32x4 (&acc)[2][2][4][2], const Unit& u, int wr, int wc, int fr, int fq) const {
        const int row0 = u.pm * 256 + wr * 64 + fr, colb = u.pn * 256 + wc * 32 + 8 * fq;
#pragma unroll
        for (int ai = 0; ai < 2; ++ai)
#pragma unroll
            for (int m = 0; m < 4; ++m) {
                float* rowp = O + (size_t)(row0 + ai * 128 + m * 16) * ld + colb;
#pragma unroll
                for (int bj = 0; bj < 2; ++bj) { *(f32x4*)(rowp + bj * 128) = acc[ai][bj][m][0]; *(f32x4*)(rowp + bj * 128 + 4) = acc[ai][bj][m][1]; }
            }
    }
};
}

__device__ __forceinline__ void transpose_item(const float* W, int ldsrc, int K, bf16* WT, int k0, int srcn0, int dstn0, LAS float* scr, int lane) {
    if (srcn0 >= 0) {
#pragma unroll 8
        for (int i = 0; i < 32; ++i) { const int kk = 2 * i + (lane >> 5); scr[kk * 33 + (lane & 31)] = W[(size_t)(k0 + kk) * ldsrc + srcn0 + (lane & 31)]; }
    } else {
#pragma unroll 8
        for (int i = 0; i < 32; ++i) { const int kk = 2 * i + (lane >> 5); scr[kk * 33 + (lane & 31)] = 0.f; }
    }
    asm volatile("s_waitcnt lgkmcnt(0)" ::: "memory");
    const int c = lane & 7;
#pragma unroll
    for (int j = 0; j < 4; ++j) { const int n = (lane >> 3) + 8 * j; const LAS float* s = scr + (8 * c) * 33 + n;
        v4u o; o.x = pk2(s[0 * 33], s[1 * 33]); o.y = pk2(s[2 * 33], s[3 * 33]); o.z = pk2(s[4 * 33], s[5 * 33]); o.w = pk2(s[6 * 33], s[7 * 33]);
        *(v4u*)(WT + (size_t)(dstn0 + n) * K + k0 + 8 * c) = o; }
    asm volatile("s_waitcnt lgkmcnt(0)" ::: "memory");
}
__device__ __forceinline__ int wt_src_col(int n0) {
    if (n0 < 4096) return n0;
    if (n0 < 7168) return n0 - 4096 + 6144;
    if (n0 < 7200) return n0 - 7168 + 10240;
    if (n0 < 7424) return -1;
    if (n0 < 9472) return n0 - 7424 + 4096;
    if (n0 < 10496) return n0 - 9472 + 9216;
    if (n0 < 11520) return n0 - 10496 + 10272;
    return n0 - 11520 + 11296;
}
__device__ __forceinline__ void ln_row_affine_bf16(const float* xrow, const float* g, const float* bb, bf16* orow, int lane) {
    const f32x4* xr = (const f32x4*)xrow + lane;
    f32x4 v[4]; float s = 0.f;
#pragma unroll
    for (int j = 0; j < 4; ++j) { v[j] = xr[64 * j]; s += (v[j][0] + v[j][1]) + (v[j][2] + v[j][3]); }
    const float mean = wave_sum(s) * (1.f / D); float s2 = 0.f;
#pragma unroll
    for (int j = 0; j < 4; ++j) { v[j] = v[j] - mean; s2 += (v[j][0] * v[j][0] + v[j][1] * v[j][1]) + (v[j][2] * v[j][2] + v[j][3] * v[j][3]); }
    const float rstd = 1.f / sqrtf(wave_sum(s2) * (1.f / D) + LN_EPS);
    v2u* o8 = (v2u*)orow + lane;
#pragma unroll
    for (int j = 0; j < 4; ++j) { const f32x4 gg = ((const f32x4*)g)[lane + 64 * j], b4 = ((const f32x4*)bb)[lane + 64 * j]; const f32x4 y = v[j] * rstd * gg + b4;
        v2u w; w.x = pk2(y[0], y[1]); w.y = pk2(y[2], y[3]); o8[64 * j] = w; }
}

__device__ __forceinline__ void p0_prologue(const Args& a, Frame& F) {
    LAS float* scr = (LAS float*)(F.lds + F.wave * 16384);
    bf16* HB = (bf16*)(a.ws + WS_HB); bf16* WT = (bf16*)(a.ws + WS_WT);
    constexpr int NB = WT_ROWS / 32, NITEMS = NB * (D / 64);
    for (int it = F.gw; it < NITEMS; it += F.NGW) { const int nb = it % NB, kb = it / NB; transpose_item(a.w_in, IN_W, D, WT, 64 * kb, wt_src_col(32 * nb), 32 * nb, scr, F.lane); }
    for (int r = F.gw; r < MROWS; r += F.NGW) {
        bf16* orow = HB + (size_t)r * D;
        if (r < NREAL) ln_row_affine_bf16(a.x + (size_t)r * D, a.emb_g, a.emb_b, orow, F.lane);
        else if (r < NREAL + NMETA) ln_row_affine_bf16(a.meta + (size_t)(r - NREAL) * D, a.emb_g, a.emb_b, orow, F.lane);
        else { v2u z; z.x = 0u; z.y = 0u; v2u* o8 = (v2u*)orow + F.lane;
#pragma unroll
            for (int j = 0; j < 4; ++j) o8[64 * j] = z; }
    }
}

__device__ __forceinline__ void p2_scan_ret_simple(const Args& a, Frame& F) {
    const bf16* QKV = (const bf16*)(a.ws + AR_QKVR); bf16* OR = (bf16*)a.out;
    constexpr int TG = 8;
    LAS bf16* qt = (LAS bf16*)F.lds; LAS bf16* kt = qt + TG * 256; LAS bf16* vt = kt + TG * 256;
    const int col = 16 * F.wave + (F.lane >> 2), qtr = F.lane & 3;
    for (int u = blockIdx.x; u < BATCH * RH * 4; u += F.G) {
        const int b = u >> 4, h = (u >> 2) & 3, dvb = u & 3;
        for (int pass = 0; pass < 2; ++pass) {
            const int dir = 1 - pass;
            const float gamma = sigmoidf_(a.ret_decay[dir * RH + h]);
            float S[64];
#pragma unroll
            for (int j = 0; j < 64; ++j) S[j] = 0.f;
            const int ntok = dir ? SEQ : LTOT;
            for (int t0 = 0; t0 < ntok; t0 += TG) {
                __syncthreads();
                for (int c = F.tid; c < TG * 80; c += NTHREADS) {
                    const int i = c / 80, w = c % 80; const int t = t0 + i, p = dir ? (LTOT - 1 - t) : t; const size_t rb = (size_t)row_of(b, p) * 4096;
                    if (w < 32) *(LAS v4u*)(qt + i * 256 + w * 8) = *(const v4u*)(QKV + rb + h * 256 + w * 8);
                    else if (w < 64) *(LAS v4u*)(kt + i * 256 + (w - 32) * 8) = *(const v4u*)(QKV + rb + 1024 + h * 256 + (w - 32) * 8);
                    else *(LAS v4u*)(vt + i * 128 + (w - 64) * 8) = *(const v4u*)(QKV + rb + 2048 + h * 512 + dvb * 128 + (w - 64) * 8);
                }
                __syncthreads();
                for (int i = 0; i < TG; ++i) {
                    const float v = bf2f(vt[i * 128 + col]);
                    float o = 0.f;
#pragma unroll
                    for (int j8 = 0; j8 < 8; ++j8) {
                        const v4u kw = *(const LAS v4u*)(kt + i * 256 + qtr * 64 + j8 * 8), qw = *(const LAS v4u*)(qt + i * 256 + qtr * 64 + j8 * 8);
                        const float kk[8] = {bflo(kw.x), bfhi(kw.x), bflo(kw.y), bfhi(kw.y), bflo(kw.z), bfhi(kw.z), bflo(kw.w), bfhi(kw.w)};
                        const float qq[8] = {bflo(qw.x), bfhi(qw.x), bflo(qw.y), bfhi(qw.y), bflo(qw.z), bfhi(qw.z), bflo(qw.w), bfhi(qw.w)};
#pragma unroll
                        for (int e = 0; e < 8; ++e) {
                            float s = S[j8 * 8 + e] * gamma;
                            if (dir == 0) { s += kk[e] * v; o += qq[e] * s; } else { o += qq[e] * s; s += kk[e] * v; }
                            S[j8 * 8 + e] = s;
                        }
                    }
                    o += __shfl_xor(o, 1); o += __shfl_xor(o, 2);
                    const float o2 = __shfl_down(o, 4);
                    const int t = t0 + i, p = dir ? (LTOT - 1 - t) : t;
                    if ((F.lane & 7) == 0 && p >= NMETA) {
                        unsigned* dst = (unsigned*)(OR + (size_t)(b * SEQ + p - NMETA) * 2048 + h * 512 + dvb * 128 + col);
                        float r0 = o, r1 = o2;
                        if (pass == 1) { const unsigned old = __hip_atomic_load(dst, RLX_AGENT); r0 += bflo(old); r1 += bfhi(old); }
                        *dst = pk2(r0, r1);
                    }
                }
            }
        }
    }
}

__device__ __forceinline__ void p4_conv(const Args& a, Frame& F) {
    const bf16* RAW = (const bf16*)(a.ws + AR_RAWD); bf16* QD = (bf16*)(a.ws + AR_QKVD);
    for (int it = F.gw; it < NROWS_D * 24; it += F.NGW) {
        const int rd = it / 24, slab = it % 24;
        int b, p; if (rd < NREAL) { b = rd >> 11; p = (rd & (SEQ - 1)) + NMETA; } else { b = (rd - NREAL) >> 4; p = (rd - NREAL) & 15; }
        const int ch = slab * 128 + 2 * F.lane;
        float y0 = 0.f, y1 = 0.f;
#pragma unroll
        for (int j = 0; j < 5; ++j) { const int pp = p + j - 2;
            if (pp >= 0 && pp < LTOT) { const unsigned w = *(const unsigned*)(RAW + (size_t)row_of(b, pp) * 3072 + ch); const float2 cw = *(const float2*)(a.dn_conv + j * 3072 + ch);
                y0 += cw.x * bflo(w); y1 += cw.y * bfhi(w); } }
        y0 = siluf_(y0); y1 = siluf_(y1);
        if (slab < 16) { const float ss = wave_sum(y0 * y0 + y1 * y1); float sc = 1.0f / sqrtf(ss + RMS_EPS); if (slab < 8) sc *= 0.08838834764831845f; y0 *= sc; y1 *= sc; }
        *(unsigned*)(QD + (size_t)rd * 3072 + ch) = pk2(y0, y1);
    }
}

__device__ __forceinline__ void p5_scan_dn_simple(const Args& a, Frame& F) {
    const bf16* QD = (const bf16*)(a.ws + AR_QKVD); const float* GB = (const float*)(a.ws + AR_GBETA); bf16* OD = (bf16*)(a.ws + AR_OD);
    constexpr int TG = 8;
    LAS bf16* qt = (LAS bf16*)F.lds; LAS bf16* kt = qt + TG * 128; LAS bf16* vt = kt + TG * 128; LAS float* gt = (LAS float*)(vt + TG * 64); LAS float* bt = gt + TG;
    const int cl = 8 * F.wave + (F.lane >> 3), sub = F.lane & 7;
    for (int u = blockIdx.x; u < BATCH * DH * 2; u += F.G) {
        const int b = u >> 4, h = (u >> 1) & 7, dvh = u & 1;
        for (int pass = 0; pass < 2; ++pass) {
            const int dir = 1 - pass;
            float S[16];
#pragma unroll
            for (int j = 0; j < 16; ++j) S[j] = 0.f;
            const int ntok = dir ? SEQ : LTOT;
            for (int t0 = 0; t0 < ntok; t0 += TG) {
                __syncthreads();
                for (int c = F.tid; c < TG * 40; c += NTHREADS) {
                    const int i = c / 40, w = c % 40; const int t = t0 + i, p = dir ? (LTOT - 1 - t) : t; const size_t rb = (size_t)rowd_of(b, p) * 3072;
                    if (w < 16) *(LAS v4u*)(qt + i * 128 + w * 8) = *(const v4u*)(QD + rb + h * 128 + w * 8);
                    else if (w < 32) *(LAS v4u*)(kt + i * 128 + (w - 16) * 8) = *(const v4u*)(QD + rb + 1024 + h * 128 + (w - 16) * 8);
                    else *(LAS v4u*)(vt + i * 64 + (w - 32) * 8) = *(const v4u*)(QD + rb + 2048 + h * 128 + dvh * 64 + (w - 32) * 8);
                }
                if (F.tid < TG) { const int t = t0 + F.tid, p = dir ? (LTOT - 1 - t) : t; const size_t rg = (size_t)row_of(b, p) * 32;
                    gt[F.tid] = GB[rg + dir * 8 + h]; bt[F.tid] = GB[rg + 16 + dir * 8 + h]; }
                __syncthreads();
                for (int i = 0; i < TG; ++i) {
                    const float v = bf2f(vt[i * 64 + cl]);
                    const float ag = __expf(gt[i]), beta = bt[i];
                    const v4u kw0 = *(const LAS v4u*)(kt + i * 128 + sub * 16), kw1 = *(const LAS v4u*)(kt + i * 128 + sub * 16 + 8);
                    const v4u qw0 = *(const LAS v4u*)(qt + i * 128 + sub * 16), qw1 = *(const LAS v4u*)(qt + i * 128 + sub * 16 + 8);
                    const float kk[16] = {bflo(kw0.x), bfhi(kw0.x), bflo(kw0.y), bfhi(kw0.y), bflo(kw0.z), bfhi(kw0.z), bflo(kw0.w), bfhi(kw0.w),
                                          bflo(kw1.x), bfhi(kw1.x), bflo(kw1.y), bfhi(kw1.y), bflo(kw1.z), bfhi(kw1.z), bflo(kw1.w), bfhi(kw1.w)};
                    const float qq[16] = {bflo(qw0.x), bfhi(qw0.x), bflo(qw0.y), bfhi(qw0.y), bflo(qw0.z), bfhi(qw0.z), bflo(qw0.w), bfhi(qw0.w),
                                          bflo(qw1.x), bfhi(qw1.x), bflo(qw1.y), bfhi(qw1.y), bflo(qw1.z), bfhi(qw1.z), bflo(qw1.w), bfhi(qw1.w)};
                    float r = 0.f;
#pragma unroll
                    for (int j = 0; j < 16; ++j) r += S[j] * kk[j];
                    r += __shfl_xor(r, 1); r += __shfl_xor(r, 2); r += __shfl_xor(r, 4);
                    const float vn = beta * (v - ag * r);
                    float o = 0.f;
#pragma unroll
                    for (int j = 0; j < 16; ++j) { S[j] = ag * S[j] + kk[j] * vn; o += S[j] * qq[j]; }
                    o += __shfl_xor(o, 1); o += __shfl_xor(o, 2); o += __shfl_xor(o, 4);
                    const float o2 = __shfl_down(o, 8);
                    const int t = t0 + i, p = dir ? (LTOT - 1 - t) : t;
                    if ((F.lane & 15) == 0 && p >= NMETA) {
                        unsigned* dst = (unsigned*)(OD + (size_t)(b * SEQ + p - NMETA) * 1024 + h * 128 + dvh * 64 + cl);
                        float r0 = o, r1 = o2;
                        if (pass == 1) { const unsigned old = __hip_atomic_load(dst, RLX_AGENT); r0 += bflo(old); r1 += bfhi(old); }
                        *dst = pk2(r0, r1);
                    }
                }
            }
        }
    }
}

__device__ __forceinline__ void p6_small_weights(const Args& a, Frame& F) {
    LAS float* scr = (LAS float*)(F.lds + F.wave * 16384);
    bf16* PRT = (bf16*)(a.ws + AR_PRETT); bf16* PDT = (bf16*)(a.ws + AR_PDNT); bf16* WOT = (bf16*)(a.ws + AR_WOUTT); bf16* W2T = (bf16*)(a.ws + AR_W2T);
    constexpr int I_PR = (2048 / 64) * (1024 / 32), I_PD = (1024 / 64) * (1024 / 32), I_WO = I_PD;
    for (int it = F.gw; it < I_PR + I_PD + I_WO; it += F.NGW) {
        int r = it;
        if (r < I_PR) { transpose_item(a.p_ret, 1024, 2048, PRT, 64 * (r / 32), 32 * (r % 32), 32 * (r % 32), scr, F.lane); continue; } r -= I_PR;
        if (r < I_PD) { transpose_item(a.p_dn, 1024, 1024, PDT, 64 * (r / 32), 32 * (r % 32), 32 * (r % 32), scr, F.lane); continue; } r -= I_PD;
        transpose_item(a.w_out, 1024, 1024, WOT, 64 * (r / 32), 32 * (r % 32), 32 * (r % 32), scr, F.lane);
    }
    const int gt = blockIdx.x * NTHREADS + F.tid, NGT = F.G * NTHREADS;
    for (int idx = gt; idx < 2048 * 1024; idx += NGT) {
        const int np = idx >> 10, k = idx & 1023, hp = np >> 7;
        const f32x4* wq = (const f32x4*)(a.peer_wq + (size_t)k * 2048 + hp * 128); const f32x4* ky = (const f32x4*)(a.peer_keys + (size_t)np * 128);
        float s = 0.f;
#pragma unroll 8
        for (int d = 0; d < 32; ++d) { const f32x4 x = wq[d], y = ky[d]; s += (x[0] * y[0] + x[1] * y[1]) + (x[2] * y[2] + x[3] * y[3]); }
        W2T[idx] = (bf16)f2bf(s);
    }
}

__device__ __forceinline__ void p7_gate_norm(const Args& a, Frame& F) {
    bf16* OR = (bf16*)a.out; bf16* OD = (bf16*)(a.ws + AR_OD); const bf16* GRG = (const bf16*)(a.ws + AR_GRG); const bf16* GDZ = (const bf16*)(a.ws + AR_GDZ);
    for (int it = F.gw; it < NREAL * 5; it += F.NGW) {
        const int r = it / 5, part = it % 5;
        if (part < 4) {
            const size_t off = (size_t)r * 2048 + part * 512 + F.lane * 8;
            f32x4 v0, v1, g0, g1; ep::unpack8(*(const v4u*)(OR + off), v0, v1); ep::unpack8(*(const v4u*)(GRG + off), g0, g1);
            float s = (v0[0] + v0[1]) + (v0[2] + v0[3]) + (v1[0] + v1[1]) + (v1[2] + v1[3]);
            const float mean = wave_sum(s) * (1.f / 512.f);
            v0 = v0 - mean; v1 = v1 - mean;
            float s2 = (v0[0] * v0[0] + v0[1] * v0[1]) + (v0[2] * v0[2] + v0[3] * v0[3]) + (v1[0] * v1[0] + v1[1] * v1[1]) + (v1[2] * v1[2] + v1[3] * v1[3]);
            const float rstd = 1.f / sqrtf(wave_sum(s2) * (1.f / 512.f) + LN_EPS);
#pragma unroll
            for (int e = 0; e < 4; ++e) { v0[e] = v0[e] * rstd * siluf_(g0[e]); v1[e] = v1[e] * rstd * siluf_(g1[e]); }
            *(v4u*)(OR + off) = ep::pack8(v0, v1);
        } else {
#pragma unroll
            for (int hh = 0; hh < 2; ++hh) {
                const size_t off = (size_t)r * 1024 + hh * 512 + F.lane * 8;
                f32x4 v0, v1, g0, g1; ep::unpack8(*(const v4u*)(OD + off), v0, v1); ep::unpack8(*(const v4u*)(GDZ + off), g0, g1);
                float s2 = (v0[0] * v0[0] + v0[1] * v0[1]) + (v0[2] * v0[2] + v0[3] * v0[3]) + (v1[0] * v1[0] + v1[1] * v1[1]) + (v1[2] * v1[2] + v1[3] * v1[3]);
                s2 += __shfl_xor(s2, 1); s2 += __shfl_xor(s2, 2); s2 += __shfl_xor(s2, 4); s2 += __shfl_xor(s2, 8);
                const float rs = 1.f / sqrtf(s2 * (1.f / 128.f) + RMS_EPS);
                const int c = (F.lane & 15) * 8;
                const f32x4 n0 = *(const f32x4*)(a.dn_norm_g + c), n1 = *(const f32x4*)(a.dn_norm_g + c + 4);
#pragma unroll
                for (int e = 0; e < 4; ++e) { v0[e] = v0[e] * rs * n0[e] * siluf_(g0[e]); v1[e] = v1[e] * rs * n1[e] * siluf_(g1[e]); }
                *(v4u*)(OD + off) = ep::pack8(v0, v1);
            }
        }
    }
}

__device__ __forceinline__ void p11_ln1_tables(const Args& a, Frame& F) {
    const float* PRE = (const float*)(a.ws + AR_PRE); bf16* H1 = (bf16*)(a.ws + AR_H1);
    for (int r = F.gw; r < NREAL; r += F.NGW) ln_row_affine_bf16(PRE + (size_t)r * D, a.ln1_g, a.ln1_b, H1 + (size_t)r * D, F.lane);
    bf16* UB = (bf16*)(a.ws + WS_UB); bf16* VB = (bf16*)(a.ws + AR_VB);
    const size_t gt = (size_t)blockIdx.x * NTHREADS + F.tid, NGT = (size_t)F.G * NTHREADS, n8 = (size_t)NEXP * D / 8;
    for (size_t i = gt; i < 2 * n8; i += NGT) {
        const bool second = i >= n8; const size_t j = second ? i - n8 : i;
        const f32x4* src = (const f32x4*)((second ? a.peer_v : a.peer_u) + j * 8);
        const f32x4 x = src[0], y = src[1];
        v4u w; w.x = pk2(x[0], x[1]); w.y = pk2(x[2], x[3]); w.z = pk2(y[0], y[1]); w.w = pk2(y[2], y[3]);
        *(v4u*)((second ? VB : UB) + j * 8) = w;
    }
}

__device__ __forceinline__ unsigned ord_key(float v) { const unsigned u = __builtin_bit_cast(unsigned, v); return (u & 0x80000000u) ? ~u : (u | 0x80000000u); }
__device__ __forceinline__ float ord_val(unsigned k) { const unsigned u = (k & 0x80000000u) ? (k & 0x7fffffffu) : ~k; return __builtin_bit_cast(float, u); }
__device__ __forceinline__ unsigned grp16_max(unsigned m) {
    m = max(m, (unsigned)__shfl_xor((int)m, 1)); m = max(m, (unsigned)__shfl_xor((int)m, 2)); m = max(m, (unsigned)__shfl_xor((int)m, 4)); m = max(m, (unsigned)__shfl_xor((int)m, 8)); return m;
}
__device__ __forceinline__ void p13_topk(const Args& a, Frame& F) {
    const float* SC = (const float*)(a.ws + AR_SCORES); int* EXP = (int*)(a.ws + WS_EXP); float* GATE = (float*)(a.ws + WS_GATE);
    LAS float* tops = (LAS float*)(F.lds + F.wave * 2048); LAS int* topi = (LAS int*)(F.lds + F.wave * 2048 + 1024);
    const int q4 = F.lane >> 4, li = F.lane & 15;
    for (int tok = F.gw; tok < NREAL; tok += F.NGW) {
        const float* srow = SC + (size_t)tok * 2048;
#pragma unroll 1
        for (int it = 0; it < 4; ++it) {
            const int grp = it * 4 + q4;
            const f32x4 x0 = *(const f32x4*)(srow + grp * 128 + li * 8), x1 = *(const f32x4*)(srow + grp * 128 + li * 8 + 4);
            unsigned key[8];
#pragma unroll
            for (int j = 0; j < 8; ++j) { const float v = j < 4 ? x0[j] : x1[j - 4]; key[j] = (ord_key(v) & ~127u) | (unsigned)(127 - (li * 8 + j)); }
            unsigned mine = 0u;
#pragma unroll 1
            for (int rnd = 0; rnd < 16; ++rnd) {
                unsigned m = key[0];
#pragma unroll
                for (int j = 1; j < 8; ++j) m = max(m, key[j]);
                m = grp16_max(m);
#pragma unroll
                for (int j = 0; j < 8; ++j) key[j] = (key[j] == m) ? 0u : key[j];
                mine = (li == rnd) ? m : mine;
            }
            tops[grp * 16 + li] = ord_val((mine & ~127u) | 64u); topi[grp * 16 + li] = 127 - (int)(mine & 127u);
        }
        asm volatile("s_waitcnt lgkmcnt(0)" ::: "memory");
#pragma unroll 1
        for (int it = 0; it < 2; ++it) {
            const int hh = it * 4 + q4;
            const float s1 = tops[(2 * hh) * 16 + li];
            unsigned key[16];
#pragma unroll
            for (int j = 0; j < 16; ++j) { const float s2 = tops[(2 * hh + 1) * 16 + j]; key[j] = (ord_key(s1 + s2) & ~255u) | (unsigned)(255 - (li * 16 + j)); }
            unsigned mine = 0u;
#pragma unroll 1
            for (int rnd = 0; rnd < 16; ++rnd) {
                unsigned m = key[0];
#pragma unroll
                for (int j = 1; j < 16; ++j) m = max(m, key[j]);
                m = grp16_max(m);
#pragma unroll
                for (int j = 0; j < 16; ++j) key[j] = (key[j] == m) ? 0u : key[j];
                mine = (li == rnd) ? m : mine;
            }
            const int flat = 255 - (int)(mine & 255u);
            const float best = ord_val((mine & ~255u) | 128u);
            const int i1 = topi[(2 * hh) * 16 + (flat >> 4)], i2 = topi[(2 * hh + 1) * 16 + (flat & 15)];
            const float bmax = __shfl(best, F.lane & 48);
            const float e = __expf(best - bmax);
            float se = e; se += __shfl_xor(se, 1); se += __shfl_xor(se, 2); se += __shfl_xor(se, 4); se += __shfl_xor(se, 8);
            EXP[(size_t)tok * 128 + hh * 16 + li] = i1 * 128 + i2;
            GATE[(size_t)tok * 128 + hh * 16 + li] = e / se;
        }
        asm volatile("s_waitcnt lgkmcnt(0)" ::: "memory");
    }
}

__device__ __forceinline__ float gelu_exact(float x) { return 0.5f * x * (1.0f + erff(x * 0.70710678118654752f)); }
__device__ __forceinline__ void p14_gather(const Args& a, Frame& F) {
    const bf16* H1 = (const bf16*)(a.ws + AR_H1); const int* EXP = (const int*)(a.ws + WS_EXP); const float* GATE = (const float*)(a.ws + WS_GATE);
    const bf16* UB = (const bf16*)(a.ws + WS_UB); const bf16* VB = (const bf16*)(a.ws + AR_VB);
    const int lane = F.lane;
    for (int tok = F.gw; tok < NREAL; tok += F.NGW) {
        float x[16], y[16];
        { const v4u w0 = *(const v4u*)(H1 + (size_t)tok * D + lane * 8), w1 = *(const v4u*)(H1 + (size_t)tok * D + 512 + lane * 8);
          const unsigned ww[8] = {w0.x, w0.y, w0.z, w0.w, w1.x, w1.y, w1.z, w1.w};
#pragma unroll
          for (int j = 0; j < 8; ++j) { x[2 * j] = bflo(ww[j]); x[2 * j + 1] = bfhi(ww[j]); y[2 * j] = 0.f; y[2 * j + 1] = 0.f; } }
        const int e0 = EXP[(size_t)tok * 128 + lane], e1 = EXP[(size_t)tok * 128 + 64 + lane];
        const float g0 = GATE[(size_t)tok * 128 + lane], g1 = GATE[(size_t)tok * 128 + 64 + lane];
#pragma unroll 1
        for (int bt = 0; bt < 16; ++bt) {
            float d[8]; int eid[8];
#pragma unroll
            for (int k = 0; k < 8; ++k) {
                const int slot = bt * 8 + k;
                eid[k] = __builtin_amdgcn_readlane(slot < 64 ? e0 : e1, slot & 63);
                const bf16* ur = UB + (size_t)eid[k] * D;
                const v4u w0 = *(const v4u*)(ur + lane * 8), w1 = *(const v4u*)(ur + 512 + lane * 8);
                const unsigned ww[8] = {w0.x, w0.y, w0.z, w0.w, w1.x, w1.y, w1.z, w1.w};
                float s = 0.f;
#pragma unroll
                for (int j = 0; j < 8; ++j) s += x[2 * j] * bflo(ww[j]) + x[2 * j + 1] * bfhi(ww[j]);
                d[k] = s;
            }
#pragma unroll
            for (int k = 0; k < 8; ++k) d[k] = wave_sum(d[k]);
#pragma unroll
            for (int k = 0; k < 8; ++k) {
                const int slot = bt * 8 + k;
                const float g = __builtin_bit_cast(float, __builtin_amdgcn_readlane(__builtin_bit_cast(int, slot < 64 ? g0 : g1), slot & 63));
                const float wgt = g * gelu_exact(d[k]);
                const bf16* vr = VB + (size_t)eid[k] * D;
                const v4u w0 = *(const v4u*)(vr + lane * 8), w1 = *(const v4u*)(vr + 512 + lane * 8);
                const unsigned ww[8] = {w0.x, w0.y, w0.z, w0.w, w1.x, w1.y, w1.z, w1.w};
#pragma unroll
                for (int j = 0; j < 8; ++j) { y[2 * j] += wgt * bflo(ww[j]); y[2 * j + 1] += wgt * bfhi(ww[j]); }
            }
        }
        float s = 0.f;
#pragma unroll
        for (int j = 0; j < 16; ++j) { y[j] = DN_ALPHA * x[j] + y[j]; s += y[j]; }
        const float mean = wave_sum(s) * (1.f / D); float s2 = 0.f;
#pragma unroll
        for (int j = 0; j < 16; ++j) { y[j] -= mean; s2 += y[j] * y[j]; }
        const float rstd = 1.f / sqrtf(wave_sum(s2) * (1.f / D) + LN_EPS);
#pragma unroll
        for (int c = 0; c < 2; ++c)
#pragma unroll
            for (int q = 0; q < 2; ++q) {
                const int col = c * 512 + lane * 8 + q * 4;
                const f32x4 gg = *(const f32x4*)(a.ln2_g + col), bb = *(const f32x4*)(a.ln2_b + col);
                f32x4 o;
#pragma unroll
                for (int e = 0; e < 4; ++e) o[e] = y[c * 8 + q * 4 + e] * rstd * gg[e] + bb[e];
                *(f32x4*)(a.out + (size_t)tok * D + col) = o;
            }
    }
}

typedef short s16x4 __attribute__((ext_vector_type(4)));
typedef short bfx8 __attribute__((ext_vector_type(8)));
constexpr int R2_QS = 544, R2_VS = 144, R2_PS = 80;
constexpr int R2_Q = 0, R2_K = 32 * R2_QS, R2_V = 2 * 32 * R2_QS, R2_P = R2_V + 32 * R2_VS, R2_GRP = R2_P + 32 * R2_PS;
__device__ __forceinline__ bfx8 tr16_frag(const LAS unsigned char* p0, const LAS unsigned char* p1) {
    const s16x4 a = __builtin_amdgcn_ds_read_tr16_b64_v4i16((LAS s16x4*)p0), b = __builtin_amdgcn_ds_read_tr16_b64_v4i16((LAS s16x4*)p1);
    return (bfx8){a[0], a[1], a[2], a[3], b[0], b[1], b[2], b[3]};
}
__device__ __forceinline__ bfx8 ld2x8(const LAS unsigned char* p0, const LAS unsigned char* p1) {
    const v2u a = *(const LAS v2u*)p0, b = *(const LAS v2u*)p1; const v4u w = {a.x, a.y, b.x, b.y}; return __builtin_bit_cast(bfx8, w);
}
__device__ __forceinline__ bfx8 pack_acc2(f32x4 a, f32x4 b, float sc) {
    const v4u w = {pk2(a[0] * sc, a[1] * sc), pk2(a[2] * sc, a[3] * sc), pk2(b[0] * sc, b[1] * sc), pk2(b[2] * sc, b[3] * sc)}; return __builtin_bit_cast(bfx8, w);
}
#define MFMA16(a, b, c) __builtin_amdgcn_mfma_f32_16x16x32_bf16((a), (b), (c), 0, 0, 0)

__device__ __forceinline__ void p2_scan_ret(const Args& a, Frame& F) {
    const bf16* QKV = (const bf16*)(a.ws + AR_QKVR); bf16* OR = (bf16*)a.out;
    const int grp = F.wave >> 2, wq = F.wave & 3, tg = F.tid & 255, lane = F.lane, g = lane >> 4, l15 = lane & 15, q4 = (lane & 15) >> 2, p4 = lane & 3;
    LAS unsigned char* L = F.lds + grp * R2_GRP;
    constexpr int NSTEP = 65;
    for (int u = blockIdx.x; u < BATCH * RH * 8; u += F.G) {
        const int b = u >> 5, h = (u >> 3) & 3, dvs = u & 7;
        const float xl = a.ret_decay[grp * RH + h];
        const float lg2 = -log2f(1.0f + __expf(-xl));
        const float gC = exp2f(32.f * lg2);
        f32x4 S[16];
#pragma unroll
        for (int d = 0; d < 16; ++d) S[d] = (f32x4){0.f, 0.f, 0.f, 0.f};
        v4u rq[4], rk[4], rv;
        const float vscale = exp2f((float)(31 - (tg >> 3)) * lg2);
        const float rs0 = exp2f((float)(l15 - 31) * lg2), rs1 = exp2f((float)(l15 + 16 - 31) * lg2);
#define R2_ROW(st, i, row)    \
        do { if (grp == 0) { if ((st) == 0) row = (i) >= 16 ? NREAL + (i) - 16 : -1; else row = b * SEQ + 32 * ((st) - 1) + (i); } \
             else { if ((st) == 0) row = -1; else row = b * SEQ + 32 * (64 - (st)) + 31 - (i); } } while (0)
#define R2_LOADS(st) do { \
        _Pragma("unroll") for (int i_ = 0; i_ < 4; ++i_) { const int cid = tg + 256 * i_, ti = cid >> 5, c16 = cid & 31; int row; R2_ROW(st, ti, row); \
            if (row >= 0) { const bf16* src = QKV + (size_t)row * 4096 + h * 256 + c16 * 8; rq[i_] = *(const v4u*)src; rk[i_] = *(const v4u*)(src + 1024); } \
            else { rq[i_] = (v4u){0u, 0u, 0u, 0u}; rk[i_] = (v4u){0u, 0u, 0u, 0u}; } } \
        { const int ti = tg >> 3, c16 = tg & 7; int row; R2_ROW(st, ti, row); \
            if (row >= 0) rv = *(const v4u*)(QKV + (size_t)row * 4096 + 2048 + h * 512 + dvs * 64 + c16 * 8); else rv = (v4u){0u, 0u, 0u, 0u}; } } while (0)
        R2_LOADS(0);
#pragma unroll 1
        for (int st = 0; st < NSTEP; ++st) {
#pragma unroll
            for (int i_ = 0; i_ < 4; ++i_) { const int cid = tg + 256 * i_, ti = cid >> 5, c16 = cid & 31;
                *(LAS v4u*)(L + R2_Q + ti * R2_QS + c16 * 16) = rq[i_]; *(LAS v4u*)(L + R2_K + ti * R2_QS + c16 * 16) = rk[i_]; }
            { const int ti = tg >> 3, c16 = tg & 7; v4u w;
                w.x = pk2(bflo(rv.x) * vscale, bfhi(rv.x) * vscale); w.y = pk2(bflo(rv.y) * vscale, bfhi(rv.y) * vscale);
                w.z = pk2(bflo(rv.z) * vscale, bfhi(rv.z) * vscale); w.w = pk2(bflo(rv.w) * vscale, bfhi(rv.w) * vscale);
                *(LAS v4u*)(L + R2_V + ti * R2_VS + c16 * 16) = w; }
            __syncthreads();
            if (st + 1 < NSTEP) { R2_LOADS(st + 1); }
            {
                const int mi = wq >> 1, ni = wq & 1;
                f32x4 pacc = (f32x4){0.f, 0.f, 0.f, 0.f};
                const LAS unsigned char* qa = L + R2_Q + (16 * mi + l15) * R2_QS + g * 16; const LAS unsigned char* kb = L + R2_K + (16 * ni + l15) * R2_QS + g * 16;
#pragma unroll
                for (int s = 0; s < 8; ++s) pacc = MFMA16(*(const LAS bfx8*)(qa + s * 64), *(const LAS bfx8*)(kb + s * 64), pacc);
                const int j = 16 * ni + l15;
#pragma unroll
                for (int r = 0; r < 4; ++r) { const int i = 16 * mi + 4 * g + r; const bool keep = grp == 0 ? (j <= i) : (j < i);
                    *(LAS bf16*)(L + R2_P + i * R2_PS + j * 2) = (bf16)f2bf(keep ? pacc[r] : 0.f); }
            }
            __syncthreads();
            const bfx8 vdf = tr16_frag(L + R2_V + (8 * g + q4) * R2_VS + (16 * wq + 4 * p4) * 2, L + R2_V + (8 * g + 4 + q4) * R2_VS + (16 * wq + 4 * p4) * 2);
            f32x4 oT[2] = {(f32x4){0.f, 0.f, 0.f, 0.f}, (f32x4){0.f, 0.f, 0.f, 0.f}};
#pragma unroll
            for (int s = 0; s < 8; ++s) {
                const bfx8 sf = pack_acc2(S[2 * s], S[2 * s + 1], gC);
#pragma unroll
                for (int mt = 0; mt < 2; ++mt) { const LAS unsigned char* qp = L + R2_Q + (16 * mt + l15) * R2_QS + (32 * s + 4 * g) * 2;
                    oT[mt] = MFMA16(sf, ld2x8(qp, qp + 32), oT[mt]); }
            }
#pragma unroll
            for (int mt = 0; mt < 2; ++mt) oT[mt] = MFMA16(vdf, *(const LAS bfx8*)(L + R2_P + (16 * mt + l15) * R2_PS + g * 16), oT[mt]);
#pragma unroll
            for (int d = 0; d < 16; ++d) {
                const bfx8 kf = tr16_frag(L + R2_K + (8 * g + q4) * R2_QS + (16 * d + 4 * p4) * 2, L + R2_K + (8 * g + 4 + q4) * R2_QS + (16 * d + 4 * p4) * 2);
                S[d] = MFMA16(kf, vdf, S[d] * gC);
            }
            const bool active = (st >= 1);
            if (active) {
#pragma unroll
                for (int mt = 0; mt < 2; ++mt) {
                    int row; R2_ROW(st, 16 * mt + l15, row);
                    unsigned long long* dst = (unsigned long long*)(OR + (size_t)row * 2048 + h * 512 + dvs * 64 + 16 * wq + 4 * g);
                    const float rs = mt ? rs1 : rs0;
                    float o0 = oT[mt][0] * rs, o1 = oT[mt][1] * rs, o2 = oT[mt][2] * rs, o3 = oT[mt][3] * rs;
                    if (st >= 33) { const unsigned long long old = __hip_atomic_load(dst, RLX_AGENT); const unsigned lo = (unsigned)old, hi = (unsigned)(old >> 32);
                        o0 += bflo(lo); o1 += bfhi(lo); o2 += bflo(hi); o3 += bfhi(hi); }
                    *dst = (unsigned long long)pk2(o0, o1) | ((unsigned long long)pk2(o2, o3) << 32);
                }
            }
            if (st == 32) asm volatile("s_waitcnt vmcnt(0)" ::: "memory");
            __syncthreads();
        }
#undef R2_ROW
#undef R2_LOADS
    }
}

constexpr int NPHASES = 15;
__global__ void __launch_bounds__(NTHREADS, 2) fwd_kernel(Args args) {
    extern __shared__ __attribute__((aligned(16))) unsigned char lds_raw[];
    Frame F;
    F.lds = (LAS unsigned char*)lds_raw;
    F.tid = threadIdx.x; F.lane = F.tid & 63; F.wave = __builtin_amdgcn_readfirstlane(F.tid >> 6);
    F.G = gridDim.x; F.gw = blockIdx.x * NWAVES + F.wave; F.NGW = F.G * NWAVES;
    volatile LAS unsigned* MISC = (volatile LAS unsigned*)(F.lds + MISC_OFF);
    for (int u = F.tid; u < (LDS_BYTES - RING_BYTES) / 4; u += NTHREADS) ((LAS unsigned*)(F.lds + RING_BYTES))[u] = 0u;
    __syncthreads();
    unsigned* ctl = (unsigned*)(args.ws + WS_CTL);
    const int lo = args.ph_lo, hi = args.ph_hi;
    XcdBarrier bar; bar.bar = ctl + CW_BAR; bar.x = 0; bar.st = nullptr;
    if (hi - lo > 1) bar = xcd_barrier_post(ctl + CW_BAR, MISC + 8);
#define IN(k) (lo <= (k) && (k) < hi)
#define SEAM(k) do { if (IN(k) && IN((k) + 1)) xcd_barrier(bar); } while (0)
    unsigned char* ws = args.ws;
    bf16* HB = (bf16*)(ws + WS_HB); bf16* WT = (bf16*)(ws + WS_WT);

    if (IN(0)) { p0_prologue(args, F); } SEAM(0);
    if (IN(1)) {
        pg8::Gemm g{HB, WT + (size_t)WT_A0 * D, MROWS, WT_A_N, D}; pg8::StaticOrder S; S.init(MROWS, WT_A_N, F.G, (int)blockIdx.x);
        ep::EpiRot E{(bf16*)(ws + AR_QKVR)};
        pg8::gemm_phase<ep::EpiRot, pg8::StaticOrder, true, true>(F.lds, g, S, E);
    } SEAM(1);
    if (IN(2)) { p2_scan_ret(args, F); } SEAM(2);
    if (IN(3)) {
        pg8::Gemm g{HB, WT + (size_t)WT_B0 * D, MROWS, WT_B_N, D}; pg8::StaticOrder S; S.init(MROWS, WT_B_N, F.G, (int)blockIdx.x);
        ep::EpiDn E{(bf16*)(ws + AR_RAWD), (float*)(ws + AR_GBETA), args.dn_a_log, args.dn_dt_bias};
        pg8::gemm_phase<ep::EpiDn, pg8::StaticOrder, true, true>(F.lds, g, S, E);
    } SEAM(3);
    if (IN(4)) { p4_conv(args, F); } SEAM(4);
    if (IN(5)) { p5_scan_dn_simple(args, F); } SEAM(5);
    if (IN(6)) {
        p6_small_weights(args, F);
        __syncthreads();
        pg8::Gemm g{HB, WT + (size_t)WT_C0 * D, NREAL, WT_C_N, D}; pg8::StaticOrder S; S.init(NREAL, WT_C_N, F.G, (int)blockIdx.x);
        ep::EpiGates E{(bf16*)(ws + AR_GRG), (bf16*)(ws + AR_GDZ), (bf16*)(ws + AR_GGA), (bf16*)(ws + AR_GGB)};
        pg8::gemm_phase<ep::EpiGates, pg8::StaticOrder, true, true>(F.lds, g, S, E);
    } SEAM(6);
    if (IN(7)) { p7_gate_norm(args, F); } SEAM(7);
    if (IN(8)) {
        pg8::Gemm g{(const bf16*)args.out, (const bf16*)(ws + AR_PRETT), NREAL, 1024, 2048}; pg8::StaticOrder S; S.init(NREAL, 1024, F.G, (int)blockIdx.x);
        ep::EpiMerge<false> E{(const bf16*)(ws + AR_GGA), nullptr, (bf16*)(ws + AR_M1)};
        pg8::gemm_phase<ep::EpiMerge<false>, pg8::StaticOrder, true, true>(F.lds, g, S, E);
    } SEAM(8);
    if (IN(9)) {
        pg8::Gemm g{(const bf16*)(ws + AR_OD), (const bf16*)(ws + AR_PDNT), NREAL, 1024, 1024}; pg8::StaticOrder S; S.init(NREAL, 1024, F.G, (int)blockIdx.x);
        ep::EpiMerge<true> E{(const bf16*)(ws + AR_GGB), (const bf16*)(ws + AR_M1), (bf16*)(ws + AR_MERGED)};
        pg8::gemm_phase<ep::EpiMerge<true>, pg8::StaticOrder, true, true>(F.lds, g, S, E);
    } SEAM(9);
    if (IN(10)) {
        pg8::Gemm g{(const bf16*)(ws + AR_MERGED), (const bf16*)(ws + AR_WOUTT), NREAL, 1024, 1024}; pg8::StaticOrder S; S.init(NREAL, 1024, F.G, (int)blockIdx.x);
        ep::EpiRes E{HB, (float*)(ws + AR_PRE)};
        pg8::gemm_phase<ep::EpiRes, pg8::StaticOrder, true, true>(F.lds, g, S, E);
    } SEAM(10);
    if (IN(11)) { p11_ln1_tables(args, F); } SEAM(11);
    if (IN(12)) {
        pg8::Gemm g{(const bf16*)(ws + AR_H1), (const bf16*)(ws + AR_W2T), NREAL, 2048, 1024}; pg8::StaticOrder S; S.init(NREAL, 2048, F.G, (int)blockIdx.x);
        ep::EpiF32 E{(float*)(ws + AR_SCORES), 2048};
        pg8::gemm_phase<ep::EpiF32, pg8::StaticOrder, true, true>(F.lds, g, S, E);
    } SEAM(12);
    if (IN(13)) { p13_topk(args, F); } SEAM(13);
    if (IN(14)) { p14_gather(args, F); }
#undef IN
#undef SEAM
}

#ifndef N_LAUNCH_MODE
#define N_LAUNCH_MODE 1
#endif
extern "C" void kernel_launch(void* const* d_in, const int* in_sizes, int n_in, void* d_out, int out_size, void* d_ws, size_t ws_size, hipStream_t stream) {
    static int grid = 0;
    if (grid == 0) {
        if (n_in != 21 || out_size != NREAL * D || ws_size < WS_END) { fprintf(stderr, "kernel_launch: unexpected shapes (n_in %d, out %d, ws %zu)\n", n_in, out_size, ws_size); grid = -1; return; }
        int dev = 0, cus = 0;
        if (hipGetDevice(&dev) != hipSuccess || hipDeviceGetAttribute(&cus, hipDeviceAttributeMultiprocessorCount, dev) != hipSuccess) { grid = -1; return; }
        if (hipFuncSetAttribute((const void*)fwd_kernel, hipFuncAttributeMaxDynamicSharedMemorySize, LDS_BYTES) != hipSuccess) { grid = -1; return; }
        int per_cu = 0;
        (void)hipOccupancyMaxActiveBlocksPerMultiprocessor(&per_cu, (const void*)fwd_kernel, NTHREADS, LDS_BYTES);
        (void)hipGetLastError();
        grid = cus;
    }
    if (grid < 0) return;
    (void)hipMemsetAsync((char*)d_ws + WS_CTL, 0, CTL_ZERO_BYTES, stream);
    Args a{};
    const float** fp = (const float**)&a;
    for (int i = 0; i < 21; ++i) fp[i] = (const float*)d_in[i];
    a.out = (float*)d_out; a.ws = (unsigned char*)d_ws;
    if (N_LAUNCH_MODE == 1) {
        a.ph_lo = 0; a.ph_hi = NPHASES;
        hipLaunchKernelGGL(fwd_kernel, dim3(grid), dim3(NTHREADS), LDS_BYTES, stream, a);
    } else {
        for (int p = 0; p < NPHASES; ++p) { a.ph_lo = p; a.ph_hi = p + 1; hipLaunchKernelGGL(fwd_kernel, dim3(grid), dim3(NTHREADS), LDS_BYTES, stream, a); }
    }
}
```

```cpp
#include <hip/hip_runtime.h>
#include <cstdio>
#include <cstdint>
namespace pg8 {
#define PG8_LAS __attribute__((address_space(3)))
typedef unsigned short bf16_t;
typedef short bf16x8 __attribute__((ext_vector_type(8)));
typedef float f32x4 __attribute__((ext_vector_type(4)));
typedef unsigned u32x4 __attribute__((ext_vector_type(4)));
constexpr int BM = 256, BK = 64, HALF = 128, HTB = HALF * BK * 2  , STAGE_BYTES = 8 * HTB, NXCD = 8, WGM = 8;

__host__ __device__ __forceinline__ int lds_byte(int r, int c) { const int st = (r >> 4) * 2 + (c >> 5), rr = r & 15, cc = c & 31, ob = rr * 64 + cc * 2; return st * 1024 + (ob ^ (((ob >> 9) & 1) << 5)); }
__host__ __device__ __forceinline__ void stage_rc(int b, int& R, int& C) { const int st = b / 1024, sb = b % 1024, swz = sb ^ (((sb >> 9) & 1) << 5); R = (st >> 1) * 16 + swz / 64; C = (st & 1) * 32 + (swz % 64) / 2; }
__host__ __device__ __forceinline__ int perm32(int rho) { const int n = rho >> 4, i = rho & 15; return 8 * (i >> 2) + 4 * n + (i & 3); }

struct Unit { int pm, pn; };
struct Gemm { const bf16_t* A; const bf16_t* Bt; int M, N, K; };

struct StaticOrder {
    int nM, nN, nwg, G, c;
    __host__ __device__ void init(int M, int N, int G_, int c_) { nM = M / BM; nN = N / BM; nwg = nM * nN; G = G_; c = c_; }
    __host__ __device__ bool next(int i, Unit& u) const {
        const long L = (long)i * G + c; if (L >= nwg) return false;
        int wgid = (int)L; { const int q = nwg / NXCD, r = nwg % NXCD, xcd = wgid % NXCD, off = wgid / NXCD; wgid = (xcd < r ? xcd * (q + 1) : r * (q + 1) + (xcd - r) * q) + off; }
        const int nig = WGM * nN, gid = wgid / nig, fm = gid * WGM, gsz = (nM - fm) < WGM ? (nM - fm) : WGM;
        u.pm = fm + ((wgid % nig) % gsz); u.pn = (wgid % nig) / gsz; return true;
    }
    __device__ __forceinline__ void a_ready(const Unit&) const {}
    __device__ __forceinline__ void done(const Unit&) const {}
};
__device__ __forceinline__ unsigned cvt_pk_bf16(float lo, float hi) { unsigned r; asm volatile("v_cvt_pk_bf16_f32 %0, %1, %2" : "=v"(r) : "v"(lo), "v"(hi)); return r; }
template <class Epi, class Sched, bool ALIGN_EPI = false, bool SP2 = false>
__device__ __forceinline__ void gemm_phase(PG8_LAS unsigned char* lds, const Gemm g, const Sched& S, const Epi& E) {
    const int tid = threadIdx.x, wid = __builtin_amdgcn_readfirstlane(tid >> 6), lane = tid & 63, wr = wid >> 2, wc = wid & 3, fr = lane & 15, fq = lane >> 4;
    const int K = g.K, nt = K / BK;
    unsigned voffA[2], voffB[2];
#pragma unroll
    for (int i = 0; i < 2; ++i) { int R, C; stage_rc(tid * 16 + i * 8192, R, C); const int Rb = Epi::PERM ? ((R & ~31) + perm32(R & 31)) : R;
        voffA[i] = (unsigned)(R * K + C) * 2u; voffB[i] = (unsigned)(Rb * K + C) * 2u; }
    const size_t kstep = (size_t)(BK * 2);
    const size_t hstep = (size_t)HALF * K * 2;
    const size_t tstep = 2 * hstep;
    const unsigned ldsw = (unsigned)wid * 1024u;
    const int aoff = lds_byte(wr * 64 + fr, fq * 8), boff = lds_byte(wc * 32 + fr, fq * 8);
#define PG8_SA(b, h) (((b) * 2 + (h)) * HTB)
#define PG8_SB(b, h) ((4 + (b) * 2 + (h)) * HTB)
#define PG8_STAGE(bufoff, gbase, voff) do { _Pragma("unroll") for (int _i = 0; _i < 2; ++_i) \
        __builtin_amdgcn_global_load_lds((const unsigned*)((const char*)(gbase) + (voff)[_i]), (PG8_LAS unsigned*)(lds + (bufoff) + ldsw + _i * 8192), 16, 0, 0); } while (0)
#define PG8_LDA(dst, b, h) do { _Pragma("unroll") for (int m = 0; m < 4; ++m) _Pragma("unroll") for (int k = 0; k < 2; ++k) dst[m][k] = *(const PG8_LAS bf16x8*)(lds + PG8_SA(b, h) + aoff + m * 2048 + k * 1024); } while (0)
#define PG8_LDB(dst, b, h) do { _Pragma("unroll") for (int n = 0; n < 2; ++n) _Pragma("unroll") for (int k = 0; k < 2; ++k) dst[n][k] = *(const PG8_LAS bf16x8*)(lds + PG8_SB(b, h) + boff + n * 2048 + k * 1024); } while (0)
#define PG8_MMA(ai, bj, At, Bt) do { __builtin_amdgcn_s_setprio(1); _Pragma("unroll") for (int m = 0; m < 4; ++m) _Pragma("unroll") for (int n = 0; n < 2; ++n) _Pragma("unroll") for (int k = 0; k < 2; ++k) \
        acc[ai][bj][m][n] = __builtin_amdgcn_mfma_f32_16x16x32_bf16(Bt[n][k], At[m][k], acc[ai][bj][m][n], 0, 0, 0); __builtin_amdgcn_s_setprio(0); } while (0)
#define PG8_WAIT_V(n) asm volatile("s_waitcnt vmcnt(" #n ")" ::: "memory")
#define PG8_WAIT_L(n) asm volatile("s_waitcnt lgkmcnt(" #n ")" ::: "memory")
#define PG8_BAR __builtin_amdgcn_s_barrier()
#define PG8_SCHED __builtin_amdgcn_sched_barrier(0)
    Unit cur, nxt; int ui = 0;
    if (!S.next(0, cur)) return;
    f32x4 acc[2][2][4][2];
#pragma unroll
    for (int a = 0; a < 2; ++a)
#pragma unroll
        for (int b = 0; b < 2; ++b)
#pragma unroll
            for (int m = 0; m < 4; ++m)
#pragma unroll
                for (int n = 0; n < 2; ++n) acc[a][b][m][n] = (f32x4){0.f, 0.f, 0.f, 0.f};
    bf16x8 At[4][2], B0[2][2], B1[2][2];
    const char* cA = (const char*)g.A + (size_t)cur.pm * tstep; const char* cB = (const char*)g.Bt + (size_t)cur.pn * tstep;
    S.a_ready(cur);
    if constexpr (SP2) {
        PG8_STAGE(PG8_SB(0, 0), cB, voffB); PG8_STAGE(PG8_SB(0, 1), cB + hstep, voffB); PG8_STAGE(PG8_SA(0, 0), cA, voffA); PG8_STAGE(PG8_SA(0, 1), cA + hstep, voffA);
        if (wr == 1) PG8_BAR;
        PG8_WAIT_V(2); PG8_BAR;
        PG8_STAGE(PG8_SB(1, 0), cB + kstep, voffB); PG8_STAGE(PG8_SA(1, 0), cA + kstep, voffA); PG8_STAGE(PG8_SB(1, 1), cB + hstep + kstep, voffB);
        PG8_WAIT_V(6); PG8_BAR;
    } else {
        PG8_STAGE(PG8_SB(0, 0), cB, voffB); PG8_STAGE(PG8_SA(0, 0), cA, voffA); PG8_STAGE(PG8_SB(0, 1), cB + hstep, voffB); PG8_STAGE(PG8_SA(0, 1), cA + hstep, voffA);
        if (wr == 1) PG8_BAR;
        PG8_WAIT_V(4); PG8_BAR;
        PG8_STAGE(PG8_SB(1, 0), cB + kstep, voffB); PG8_STAGE(PG8_SA(1, 0), cA + kstep, voffA); PG8_STAGE(PG8_SB(1, 1), cB + hstep + kstep, voffB);
        PG8_WAIT_V(6); PG8_BAR;
    }
    for (;;) {
        const bool has_next = S.next(ui + 1, nxt);
        const char* nA = has_next ? (const char*)g.A + (size_t)nxt.pm * tstep : cA; const char* nB = has_next ? (const char*)g.Bt + (size_t)nxt.pn * tstep : cB;
        for (int t = 0; t < nt; t += 2) {
            const bool last = (t == nt - 2);
            const char* a1 = cA + (size_t)(t + 1) * kstep;
            const char* a2 = last ? nA : cA + (size_t)(t + 2) * kstep; const char* b2 = last ? nB : cB + (size_t)(t + 2) * kstep;
            const char* a3 = a2 + kstep; const char* b3 = b2 + kstep;
            if (last && has_next) S.a_ready(nxt);
            if constexpr (SP2) {
            PG8_LDB(B0, 0, 0); PG8_LDB(B1, 0, 1); PG8_SCHED; PG8_LDA(At, 0, 0); PG8_STAGE(PG8_SA(1, 1), a1 + hstep, voffA);
            PG8_WAIT_V(8); PG8_WAIT_L(0); PG8_BAR; PG8_MMA(0, 0, At, B0); PG8_MMA(0, 1, At, B1); PG8_BAR; PG8_SCHED;
            PG8_LDA(At, 0, 1); PG8_STAGE(PG8_SB(0, 0), b2, voffB); PG8_STAGE(PG8_SB(0, 1), b2 + hstep, voffB); PG8_STAGE(PG8_SA(0, 0), a2, voffA);
            PG8_WAIT_V(8); PG8_WAIT_L(0); PG8_BAR; PG8_MMA(1, 0, At, B0); PG8_MMA(1, 1, At, B1); PG8_BAR; PG8_SCHED;
            PG8_LDB(B0, 1, 0); PG8_LDB(B1, 1, 1); PG8_SCHED; PG8_LDA(At, 1, 0); PG8_STAGE(PG8_SA(0, 1), a2 + hstep, voffA);
            PG8_WAIT_V(8); PG8_WAIT_L(0); PG8_BAR; PG8_MMA(0, 0, At, B0); PG8_MMA(0, 1, At, B1); PG8_BAR; PG8_SCHED;
            PG8_LDA(At, 1, 1); PG8_STAGE(PG8_SB(1, 0), b3, voffB); PG8_STAGE(PG8_SB(1, 1), b3 + hstep, voffB); PG8_STAGE(PG8_SA(1, 0), a3, voffA);
            PG8_WAIT_V(8); PG8_WAIT_L(0); PG8_BAR; PG8_MMA(1, 0, At, B0); PG8_MMA(1, 1, At, B1); PG8_BAR; PG8_SCHED;
            } else {
            PG8_LDB(B0, 0, 0); PG8_SCHED; PG8_LDA(At, 0, 0); PG8_STAGE(PG8_SA(1, 1), a1 + hstep, voffA);
            PG8_WAIT_L(8); PG8_BAR; PG8_WAIT_L(0); PG8_MMA(0, 0, At, B0); PG8_BAR; PG8_SCHED;
            PG8_LDB(B1, 0, 1); PG8_STAGE(PG8_SB(0, 0), b2, voffB);
            PG8_BAR; PG8_WAIT_L(0); PG8_MMA(0, 1, At, B1); PG8_BAR;
            PG8_LDA(At, 0, 1); PG8_STAGE(PG8_SA(0, 0), a2, voffA);
            PG8_BAR; PG8_WAIT_L(0); PG8_MMA(1, 0, At, B0); PG8_BAR; PG8_SCHED;
            PG8_STAGE(PG8_SB(0, 1), b2 + hstep, voffB);
            PG8_WAIT_V(6); PG8_BAR; PG8_MMA(1, 1, At, B1); PG8_BAR;
            PG8_LDB(B0, 1, 0); PG8_SCHED; PG8_LDA(At, 1, 0); PG8_STAGE(PG8_SA(0, 1), a2 + hstep, voffA);
            PG8_WAIT_L(8); PG8_BAR; PG8_WAIT_L(0); PG8_MMA(0, 0, At, B0); PG8_BAR; PG8_SCHED;
            PG8_LDB(B1, 1, 1); PG8_STAGE(PG8_SB(1, 0), b3, voffB);
            PG8_BAR; PG8_WAIT_L(0); PG8_MMA(0, 1, At, B1); PG8_BAR;
            PG8_LDA(At, 1, 1); PG8_STAGE(PG8_SA(1, 0), a3, voffA);
            PG8_BAR; PG8_WAIT_L(0); PG8_MMA(1, 0, At, B0); PG8_BAR; PG8_SCHED;
            PG8_STAGE(PG8_SB(1, 1), b3 + hstep, voffB);
            PG8_WAIT_V(6); PG8_BAR; PG8_MMA(1, 1, At, B1); PG8_BAR;
            }
        }
        if constexpr (ALIGN_EPI) { if (wr == 0) PG8_BAR; }
        if constexpr (!Epi::AFTER_DRAIN) { E(acc, cur, wr, wc, fr, fq); S.done(cur); }
        if (!has_next) break;
#pragma unroll
        for (int a = 0; a < 2; ++a)
#pragma unroll
            for (int b = 0; b < 2; ++b)
#pragma unroll
                for (int m = 0; m < 4; ++m)
#pragma unroll
                    for (int n = 0; n < 2; ++n) acc[a][b][m][n] = (f32x4){0.f, 0.f, 0.f, 0.f};
        cur = nxt; cA = nA; cB = nB; ++ui;
        if constexpr (ALIGN_EPI) { if (wr == 1) PG8_BAR; }
    }
    PG8_WAIT_V(0);
    if constexpr (!ALIGN_EPI) { if (wr == 0) PG8_BAR; }
    PG8_BAR;
    if constexpr (Epi::AFTER_DRAIN) { E.fused(acc, cur, wr, wc, fr, fq, lds, wid, lane); S.done(cur); }
#undef PG8_SA
#undef PG8_SB
#undef PG8_STAGE
#undef PG8_LDA
#undef PG8_LDB
#undef PG8_MMA
#undef PG8_WAIT_V
#undef PG8_WAIT_L
#undef PG8_BAR
#undef PG8_SCHED
}
}
#define XB_TMO      128
#define XB_XCNT(j)  (256  + 64 * (j))
#define XB_XSUB(j)  (1280 + 64 * (j))
#define XB_XGEN(j)  (2304 + 64 * (j))
#define XB_TOP      3328
#define XB_TOPGEN   3392
#define XCD_BAR_WORDS 3456
#define XB_SPIN_CAP (1u << 18)
#define LAS __attribute__((address_space(3)))

__device__ __forceinline__ unsigned xb_ld(unsigned* p)              { return __hip_atomic_load(p, __ATOMIC_RELAXED, __HIP_MEMORY_SCOPE_AGENT); }
__device__ __forceinline__ unsigned xb_add(unsigned* p, unsigned v) { return __hip_atomic_fetch_add(p, v, __ATOMIC_RELAXED, __HIP_MEMORY_SCOPE_AGENT); }
__device__ __forceinline__ unsigned xb_xcc_id() { return (unsigned)__builtin_amdgcn_s_getreg((3 << 11) | 20) & 0xFu; }
#define XB_SPIN(cond, bar) do { unsigned _sp = 0; while (cond) { __builtin_amdgcn_s_sleep(1); \
    if ((++_sp & 255u) == 0u) { if (xb_ld(&(bar)[XB_TMO])) break; if (_sp > XB_SPIN_CAP) { atomicAdd(&(bar)[XB_TMO], 1u); break; } } } } while (0)

struct XcdBarrier {
    unsigned* bar; unsigned x;
    volatile LAS unsigned* st;
};

__device__ __forceinline__ XcdBarrier xcd_barrier_post(unsigned* bar, volatile LAS unsigned* st) {
    XcdBarrier b; b.bar = bar; b.x = xb_xcc_id(); b.st = st;
    if (threadIdx.x == 0) (void)xb_add(&bar[XB_XCNT(b.x)], 1u);
    return b;
}
__device__ __forceinline__ void xcd_barrier_complete(unsigned* bar, unsigned x, unsigned& nloc, unsigned& nx) {
    const unsigned G = gridDim.x * gridDim.y * gridDim.z;
    unsigned sum, cnt, mine, sp = 0u;
    for (;;) {
        sum = 0u; cnt = 0u; mine = 0u;
#pragma unroll
        for (unsigned j = 0; j < 16; ++j) { const unsigned c = xb_ld(&bar[XB_XCNT(j)]); sum += c; cnt += (c > 0u) ? 1u : 0u; mine = (j == x) ? c : mine; }
        if (sum == G) break;
        __builtin_amdgcn_s_sleep(1);
        if ((++sp & 255u) == 0u) { if (xb_ld(&bar[XB_TMO])) break; if (sp > XB_SPIN_CAP) { atomicAdd(&bar[XB_TMO], 1u); break; } }
    }
    nloc = mine > 0u ? mine : 1u; nx = cnt > 0u ? cnt : 1u;
}

__device__ __forceinline__ void xcd_barrier(const XcdBarrier& b) {
    asm volatile("s_waitcnt vmcnt(0)" ::: "memory");
    __syncthreads();
    if (threadIdx.x == 0) {
        unsigned* bar = b.bar;
        __builtin_amdgcn_s_waitcnt(0);
        unsigned nloc = b.st[0], nx = b.st[1];
        if (nloc == 0u) { xcd_barrier_complete(bar, b.x, nloc, nx); b.st[0] = nloc; b.st[1] = nx; }
        const unsigned old = xb_add(&bar[XB_XSUB(b.x)], 1u);
        const unsigned gen = old / nloc;
        if (old + 1u == (gen + 1u) * nloc) {
            __builtin_amdgcn_fence(__ATOMIC_RELEASE, "agent");
            asm volatile("s_waitcnt vmcnt(0)" ::: "memory");
            const unsigned og = xb_add(&bar[XB_TOP], 1u);
            const unsigned tg = og / nx;
            if (og + 1u == (tg + 1u) * nx) xb_add(&bar[XB_TOPGEN], 1u);
            else XB_SPIN(xb_ld(&bar[XB_TOPGEN]) == tg, bar);
            __builtin_amdgcn_fence(__ATOMIC_ACQUIRE, "agent");
            xb_add(&bar[XB_XGEN(b.x)], 1u);
            asm volatile("s_waitcnt vmcnt(0)" ::: "memory");
        } else {
            XB_SPIN(xb_ld(&bar[XB_XGEN(b.x)]) == gen, bar);
            __builtin_amdgcn_fence(__ATOMIC_ACQUIRE, "agent");
            asm volatile("s_waitcnt vmcnt(0)" ::: "memory");
        }
    }
    __syncthreads();
}

constexpr int D = 1024, BATCH = 8, SEQ = 2048, NMETA = 16, LTOT = SEQ + NMETA;
constexpr int NREAL = BATCH * SEQ;
constexpr int MROWS = 16640;
constexpr int NROWS_D = NREAL + BATCH * NMETA;
constexpr int IN_W = 12320;
constexpr int RH = 4, RDK = 256, RDV = 512;
constexpr int DH = 8, DDK = 128, DDV = 128;
constexpr int NEXP = 16384, PH = 8, PK = 16;
constexpr int WT_ROWS = 12544, WT_A0 = 0, WT_A_N = 4096, WT_B0 = 4096, WT_B_N = 3328, WT_C0 = 7424, WT_C_N = 5120;
constexpr float LN_EPS = 1e-5f, RMS_EPS = 1e-6f;
constexpr float DN_ALPHA = 1.189207115f;

constexpr size_t MiB = 1u << 20;
constexpr size_t WS_CTL = 0, CTL_ZERO_BYTES = 1 * MiB;
constexpr size_t WS_HB = 1 * MiB;
constexpr size_t WS_WT = WS_HB + (size_t)MROWS * D * 2;
constexpr size_t WS_AR = 58 * MiB;
constexpr size_t WS_END = 264 * MiB;
static_assert(WS_WT + (size_t)WT_ROWS * D * 2 <= WS_AR, "map");
constexpr size_t AR_QKVR = WS_AR;
constexpr size_t AR_RAWD = WS_AR;
constexpr size_t AR_GBETA = WS_AR + 97 * MiB + 512 * 1024;
constexpr size_t AR_QKVD = WS_AR + 100 * MiB;
constexpr size_t AR_OD = WS_AR;
constexpr size_t AR_GRG = WS_AR + 32 * MiB, AR_GDZ = WS_AR + 96 * MiB, AR_GGA = WS_AR + 128 * MiB, AR_GGB = WS_AR + 160 * MiB;
constexpr size_t AR_PRETT = WS_AR + 192 * MiB, AR_PDNT = WS_AR + 196 * MiB, AR_WOUTT = WS_AR + 198 * MiB, AR_W2T = WS_AR + 200 * MiB;
constexpr size_t AR_M1 = WS_AR + 32 * MiB, AR_MERGED = WS_AR + 64 * MiB, AR_PRE = WS_AR + 96 * MiB;
constexpr size_t AR_H1 = WS_AR;
constexpr size_t WS_UB = 1 * MiB, AR_VB = WS_AR + 160 * MiB;
constexpr size_t AR_SCORES = WS_AR + 32 * MiB;
constexpr size_t WS_EXP = WS_WT, WS_GATE = WS_WT + 8 * MiB;
static_assert(AR_QKVD + (size_t)NROWS_D * 3072 * 2 <= WS_END && AR_W2T + 4 * MiB <= WS_END && AR_GBETA + (size_t)MROWS * 32 * 4 <= AR_QKVD, "map");
constexpr int CW_BAR = 4096;

constexpr int RING_BYTES = 131072, MISC_OFF = RING_BYTES + 320, LDS_BYTES = 147456;
constexpr int NWAVES = 8, NTHREADS = 512;

#define GAS __attribute__((address_space(1)))
#define LAS __attribute__((address_space(3)))
typedef unsigned short bf16;
typedef unsigned v4u __attribute__((ext_vector_type(4)));
typedef unsigned v2u __attribute__((ext_vector_type(2)));
typedef float f32x4 __attribute__((ext_vector_type(4)));
#define RLX_AGENT __ATOMIC_RELAXED, __HIP_MEMORY_SCOPE_AGENT

__device__ __forceinline__ unsigned f2bf(float f) { unsigned u = __builtin_bit_cast(unsigned, f); return (u + 0x7fffu + ((u >> 16) & 1u)) >> 16; }
__device__ __forceinline__ unsigned pk2(float lo, float hi) { return f2bf(lo) | (f2bf(hi) << 16); }
__device__ __forceinline__ float bflo(unsigned u) { return __builtin_bit_cast(float, u << 16); }
__device__ __forceinline__ float bfhi(unsigned u) { return __builtin_bit_cast(float, u & 0xffff0000u); }
__device__ __forceinline__ float bf2f(bf16 h) { return __builtin_bit_cast(float, ((unsigned)h) << 16); }
__device__ __forceinline__ float sigmoidf_(float x) { return 1.0f / (1.0f + __expf(-x)); }
__device__ __forceinline__ float siluf_(float x) { return x / (1.0f + __expf(-x)); }
__device__ __forceinline__ float wave_sum(float v) {
#pragma unroll
    for (int o = 1; o < 64; o <<= 1) v += __shfl_xor(v, o);
    return v;
}
__device__ __forceinline__ int row_of(int b, int p) { return p < NMETA ? NREAL + p : b * SEQ + (p - NMETA); }
__device__ __forceinline__ int rowd_of(int b, int p) { return p < NMETA ? NREAL + b * NMETA + p : b * SEQ + (p - NMETA); }

struct Args {
    const float *x, *meta, *emb_g, *emb_b, *w_in, *ret_decay, *dn_conv, *dn_a_log, *dn_dt_bias, *dn_norm_g, *p_ret, *p_dn, *w_out, *ln1_g, *ln1_b,
                *peer_wq, *peer_keys, *peer_u, *peer_v, *ln2_g, *ln2_b;
    float* out; unsigned char* ws; int ph_lo, ph_hi;
};

struct Frame {
    LAS unsigned char* lds;
    int tid, lane, wave, G, gw, NGW;
};

namespace ep {
using pg8::f32x4; using pg8::Unit; using pg8::u32x4; using pg8::cvt_pk_bf16;
__device__ __forceinline__ u32x4 pack8(f32x4 a, f32x4 b) { u32x4 w; w.x = cvt_pk_bf16(a[0], a[1]); w.y = cvt_pk_bf16(a[2], a[3]); w.z = cvt_pk_bf16(b[0], b[1]); w.w = cvt_pk_bf16(b[2], b[3]); return w; }
__device__ __forceinline__ void unpack8(u32x4 w, f32x4& a, f32x4& b) { a = (f32x4){bflo(w.x), bfhi(w.x), bflo(w.y), bfhi(w.y)}; b = (f32x4){bflo(w.z), bfhi(w.z), bflo(w.w), bfhi(w.w)}; }

struct EpiRot {
    static constexpr bool PERM = true, AFTER_DRAIN = false;
    bf16* O;
    __device__ __forceinline__ void operator()(const f32x4 (&acc)[2][2][4][2], const Unit& u, int wr, int wc, int fr, int fq) const {
        const int row0 = u.pm * 256 + wr * 64 + fr, colb = wc * 32 + 8 * fq;
        if (u.pn < 8) {
            const float sc = (u.pn >= 4) ? 0.0625f : 1.0f;
            float rev[8];
#pragma unroll
            for (int e = 0; e < 8; ++e) rev[e] = exp2f(-(float)(colb + e) * (13.287712379549449f / 128.0f)) * 0.15915494309189535f;
#pragma unroll
            for (int ai = 0; ai < 2; ++ai)
#pragma unroll
                for (int m = 0; m < 4; ++m) {
                    const int r = row0 + ai * 128 + m * 16;
                    const float pos = (float)(r < NREAL ? (r & (SEQ - 1)) + NMETA : r - NREAL);
                    f32x4 o1[2], o2[2];
#pragma unroll
                    for (int n = 0; n < 2; ++n)
#pragma unroll
                        for (int e = 0; e < 4; ++e) {
                            float t = pos * rev[n * 4 + e]; t = t - floorf(t);
                            const float s = __builtin_amdgcn_sinf(t), c = __builtin_amdgcn_cosf(t);
                            const float x1 = acc[ai][0][m][n][e], x2 = acc[ai][1][m][n][e];
                            o1[n][e] = (x1 * c - x2 * s) * sc; o2[n][e] = (x1 * s + x2 * c) * sc;
                        }
                    bf16* rowp = O + (size_t)r * 4096 + u.pn * 256 + colb;
                    *(u32x4*)(rowp) = pack8(o1[0], o1[1]);
                    *(u32x4*)(rowp + 128) = pack8(o2[0], o2[1]);
                }
        } else {
#pragma unroll
            for (int ai = 0; ai < 2; ++ai)
#pragma unroll
                for (int m = 0; m < 4; ++m) {
                    bf16* rowp = O + (size_t)(row0 + ai * 128 + m * 16) * 4096 + u.pn * 256 + colb;
#pragma unroll
                    for (int bj = 0; bj < 2; ++bj) *(u32x4*)(rowp + bj * 128) = pack8(acc[ai][bj][m][0], acc[ai][bj][m][1]);
                }
        }
    }
};
struct EpiDn {
    static constexpr bool PERM = true, AFTER_DRAIN = false;
    bf16* O; float* GB; const float* a_log; const float* dt_bias;
    __device__ __forceinline__ void operator()(const f32x4 (&acc)[2][2][4][2], const Unit& u, int wr, int wc, int fr, int fq) const {
        const int row0 = u.pm * 256 + wr * 64 + fr, colb = wc * 32 + 8 * fq;
        if (u.pn < 12) {
#pragma unroll
            for (int ai = 0; ai < 2; ++ai)
#pragma unroll
                for (int m = 0; m < 4; ++m) {
                    bf16* rowp = O + (size_t)(row0 + ai * 128 + m * 16) * 3072 + u.pn * 256 + colb;
#pragma unroll
                    for (int bj = 0; bj < 2; ++bj) *(u32x4*)(rowp + bj * 128) = pack8(acc[ai][bj][m][0], acc[ai][bj][m][1]);
                }
        } else if (wc == 0) {
            float ea[8], db[8];
#pragma unroll
            for (int e = 0; e < 8; ++e) { const int c = (colb + e) & 15; ea[e] = -__expf(a_log[c]); db[e] = dt_bias[c]; }
#pragma unroll
            for (int ai = 0; ai < 2; ++ai)
#pragma unroll
                for (int m = 0; m < 4; ++m) {
                    float* rowp = GB + (size_t)(row0 + ai * 128 + m * 16) * 32 + colb;
                    f32x4 o[2];
#pragma unroll
                    for (int n = 0; n < 2; ++n)
#pragma unroll
                        for (int e = 0; e < 4; ++e) {
                            const float v = acc[ai][0][m][n][e];
                            if (colb < 16) { const float z = v + db[n * 4 + e]; const float sp = z > 20.f ? z : log1pf(__expf(z)); o[n][e] = ea[n * 4 + e] * sp; }
                            else o[n][e] = sigmoidf_(v);
                        }
                    *(f32x4*)(rowp) = o[0]; *(f32x4*)(rowp + 4) = o[1];
                }
        }
    }
};
struct EpiGates {
    static constexpr bool PERM = true, AFTER_DRAIN = false;
    bf16 *rg, *dz, *ga, *gb;
    __device__ __forceinline__ void operator()(const f32x4 (&acc)[2][2][4][2], const Unit& u, int wr, int wc, int fr, int fq) const {
        const int row0 = u.pm * 256 + wr * 64 + fr, colb = wc * 32 + 8 * fq;
        bf16* base; int ld, ct;
        if (u.pn < 8) { base = rg; ld = 2048; ct = u.pn; } else if (u.pn < 12) { base = dz; ld = 1024; ct = u.pn - 8; } else if (u.pn < 16) { base = ga; ld = 1024; ct = u.pn - 12; } else { base = gb; ld = 1024; ct = u.pn - 16; }
#pragma unroll
        for (int ai = 0; ai < 2; ++ai)
#pragma unroll
            for (int m = 0; m < 4; ++m) {
                bf16* rowp = base + (size_t)(row0 + ai * 128 + m * 16) * ld + ct * 256 + colb;
#pragma unroll
                for (int bj = 0; bj < 2; ++bj) *(u32x4*)(rowp + bj * 128) = pack8(acc[ai][bj][m][0], acc[ai][bj][m][1]);
            }
    }
};
template <bool ADD> struct EpiMerge {
    static constexpr bool PERM = true, AFTER_DRAIN = false;
    const bf16* gate; const bf16* prev; bf16* O;
    __device__ __forceinline__ void operator()(const f32x4 (&acc)[2][2][4][2], const Unit& u, int wr, int wc, int fr, int fq) const {
        const int row0 = u.pm * 256 + wr * 64 + fr, colb = u.pn * 256 + wc * 32 + 8 * fq;
#pragma unroll
        for (int ai = 0; ai < 2; ++ai)
#pragma unroll
            for (int m = 0; m < 4; ++m) {
                const size_t off = (size_t)(row0 + ai * 128 + m * 16) * 1024 + colb;
#pragma unroll
                for (int bj = 0; bj < 2; ++bj) {
                    f32x4 g0, g1; unpack8(*(const u32x4*)(gate + off + bj * 128), g0, g1);
                    f32x4 o0, o1;
#pragma unroll
                    for (int e = 0; e < 4; ++e) { o0[e] = sigmoidf_(g0[e]) * acc[ai][bj][m][0][e]; o1[e] = sigmoidf_(g1[e]) * acc[ai][bj][m][1][e]; }
                    if (ADD) { f32x4 p0, p1; unpack8(*(const u32x4*)(prev + off + bj * 128), p0, p1); o0 += p0; o1 += p1; }
                    *(u32x4*)(O + off + bj * 128) = pack8(o0, o1);
                }
            }
    }
};
struct EpiRes {
    static constexpr bool PERM = true, AFTER_DRAIN = false;
    const bf16* H; float* O;
    __device__ __forceinline__ void operator()(const f32x4 (&acc)[2][2][4][2], const Unit& u, int wr, int wc, int fr, int fq) const {
        const int row0 = u.pm * 256 + wr * 64 + fr, colb = u.pn * 256 + wc * 32 + 8 * fq;
#pragma unroll
        for (int ai = 0; ai < 2; ++ai)
#pragma unroll
            for (int m = 0; m < 4; ++m) {
                const size_t off = (size_t)(row0 + ai * 128 + m * 16) * 1024 + colb;
#pragma unroll
                for (int bj = 0; bj < 2; ++bj) {
                    f32x4 h0, h1; unpack8(*(const u32x4*)(H + off + bj * 128), h0, h1);
                    *(f32x4*)(O + off + bj * 128) = h0 * DN_ALPHA + acc[ai][bj][m][0];
                    *(f32x4*)(O + off + bj * 128 + 4) = h1 * DN_ALPHA + acc[ai][bj][m][1];
                }
            }
    }
};
struct EpiF32 {
    static constexpr bool PERM = true, AFTER_DRAIN = false;
    float* O; int ld;
    __device__ __forceinline__ void operator()(const f32x4 (&acc)[2][2][4][2], const Unit& u, int wr, int wc, int fr, int fq) const {
        const int row0 = u.pm * 256 + wr * 64 + fr, colb = u.pn * 256 + wc * 32 + 8 * fq;
#pragma unroll
        for (int ai = 0; ai < 2; ++ai)
#pragma unroll
            for (int m = 0; m < 4; ++m) {
                float* rowp = O + (size_t)(row0 + ai * 128 + m * 16) * ld + colb;
#pragma unroll
                for (int bj = 0; bj < 2; ++bj) { *(f32x4*)(rowp + bj * 128) = acc[ai][bj][m][0]; *(f32x4*)(rowp + bj * 128 + 4) = acc[ai][bj][m][1]; }
            }
    }
};
}

__device__ __forceinline__ void transpose_item(const float* W, int ldsrc, int K, bf16* WT, int k0, int srcn0, int dstn0, LAS float* scr, int lane) {
    if (srcn0 >= 0) {
#pragma unroll 8
        for (int i = 0; i < 32; ++i) { const int kk = 2 * i + (lane >> 5); scr[kk * 33 + (lane & 31)] = W[(size_t)(k0 + kk) * ldsrc + srcn0 + (lane & 31)]; }
    } else {
#pragma unroll 8
        for (int i = 0; i < 32; ++i) { const int kk = 2 * i + (lane >> 5); scr[kk * 33 + (lane & 31)] = 0.f; }
    }
    asm volatile("s_waitcnt lgkmcnt(0)" ::: "memory");
    const int c = lane & 7;
#pragma unroll
    for (int j = 0; j < 4; ++j) { const int n = (lane >> 3) + 8 * j; const LAS float* s = scr + (8 * c) * 33 + n;
        v4u o; o.x = pk2(s[0 * 33], s[1 * 33]); o.y = pk2(s[2 * 33], s[3 * 33]); o.z = pk2(s[4 * 33], s[5 * 33]); o.w = pk2(s[6 * 33], s[7 * 33]);
        *(v4u*)(WT + (size_t)(dstn0 + n) * K + k0 + 8 * c) = o; }
    asm volatile("s_waitcnt lgkmcnt(0)" ::: "memory");
}
__device__ __forceinline__ int wt_src_col(int n0) {
    if (n0 < 4096) return n0;
    if (n0 < 7168) return n0 - 4096 + 6144;
    if (n0 < 7200) return n0 - 7168 + 10240;
    if (n0 < 7424) return -1;
    if (n0 < 9472) return n0 - 7424 + 4096;
    if (n0 < 10496) return n0 - 9472 + 9216;
    if (n0 < 11520) return n0 - 10496 + 10272;
    return n0 - 11520 + 11296;
}
__device__ __forceinline__ void ln_row_affine_bf16(const float* xrow, const float* g, const float* bb, bf16* orow, int lane) {
    const f32x4* xr = (const f32x4*)xrow + lane;
    f32x4 v[4]; float s = 0.f;
#pragma unroll
    for (int j = 0; j < 4; ++j) { v[j] = xr[64 * j]; s += (v[j][0] + v[j][1]) + (v[j][2] + v[j][3]); }
    const float mean = wave_sum(s) * (1.f / D); float s2 = 0.f;
#pragma unroll
    for (int j = 0; j < 4; ++j) { v[j] = v[j] - mean; s2 += (v[j][0] * v[j][0] + v[j][1] * v[j][1]) + (v[j][2] * v[j][2] + v[j][3] * v[j][3]); }
    const float rstd = 1.f / sqrtf(wave_sum(s2) * (1.f / D) + LN_EPS);
    v2u* o8 = (v2u*)orow + lane;
#pragma unroll
    for (int j = 0; j < 4; ++j) { const f32x4 gg = ((const f32x4*)g)[lane + 64 * j], b4 = ((const f32x4*)bb)[lane + 64 * j]; const f32x4 y = v[j] * rstd * gg + b4;
        v2u w; w.x = pk2(y[0], y[1]); w.y = pk2(y[2], y[3]); o8[64 * j] = w; }
}

__device__ __forceinline__ void p0_prologue(const Args& a, Frame& F) {
    LAS float* scr = (LAS float*)(F.lds + F.wave * 16384);
    bf16* HB = (bf16*)(a.ws + WS_HB); bf16* WT = (bf16*)(a.ws + WS_WT);
    constexpr int NB = WT_ROWS / 32, NITEMS = NB * (D / 64);
    for (int it = F.gw; it < NITEMS; it += F.NGW) { const int nb = it % NB, kb = it / NB; transpose_item(a.w_in, IN_W, D, WT, 64 * kb, wt_src_col(32 * nb), 32 * nb, scr, F.lane); }
    for (int r = F.gw; r < MROWS; r += F.NGW) {
        bf16* orow = HB + (size_t)r * D;
        if (r < NREAL) ln_row_affine_bf16(a.x + (size_t)r * D, a.emb_g, a.emb_b, orow, F.lane);
        else if (r < NREAL + NMETA) ln_row_affine_bf16(a.meta + (size_t)(r - NREAL) * D, a.emb_g, a.emb_b, orow, F.lane);
        else { v2u z; z.x = 0u; z.y = 0u; v2u* o8 = (v2u*)orow + F.lane;
#pragma unroll
            for (int j = 0; j < 4; ++j) o8[64 * j] = z; }
    }
}

__device__ __forceinline__ void p2_scan_ret_simple(const Args& a, Frame& F) {
    const bf16* QKV = (const bf16*)(a.ws + AR_QKVR); bf16* OR = (bf16*)a.out;
    constexpr int TG = 8;
    LAS bf16* qt = (LAS bf16*)F.lds; LAS bf16* kt = qt + TG * 256; LAS bf16* vt = kt + TG * 256;
    const int col = 16 * F.wave + (F.lane >> 2), qtr = F.lane & 3;
    for (int u = blockIdx.x; u < BATCH * RH * 4; u += F.G) {
        const int b = u >> 4, h = (u >> 2) & 3, dvb = u & 3;
        for (int pass = 0; pass < 2; ++pass) {
            const int dir = 1 - pass;
            const float gamma = sigmoidf_(a.ret_decay[dir * RH + h]);
            float S[64];
#pragma unroll
            for (int j = 0; j < 64; ++j) S[j] = 0.f;
            const int ntok = dir ? SEQ : LTOT;
            for (int t0 = 0; t0 < ntok; t0 += TG) {
                __syncthreads();
                for (int c = F.tid; c < TG * 80; c += NTHREADS) {
                    const int i = c / 80, w = c % 80; const int t = t0 + i, p = dir ? (LTOT - 1 - t) : t; const size_t rb = (size_t)row_of(b, p) * 4096;
                    if (w < 32) *(LAS v4u*)(qt + i * 256 + w * 8) = *(const v4u*)(QKV + rb + h * 256 + w * 8);
                    else if (w < 64) *(LAS v4u*)(kt + i * 256 + (w - 32) * 8) = *(const v4u*)(QKV + rb + 1024 + h * 256 + (w - 32) * 8);
                    else *(LAS v4u*)(vt + i * 128 + (w - 64) * 8) = *(const v4u*)(QKV + rb + 2048 + h * 512 + dvb * 128 + (w - 64) * 8);
                }
                __syncthreads();
                for (int i = 0; i < TG; ++i) {
                    const float v = bf2f(vt[i * 128 + col]);
                    float o = 0.f;
#pragma unroll
                    for (int j8 = 0; j8 < 8; ++j8) {
                        const v4u kw = *(const LAS v4u*)(kt + i * 256 + qtr * 64 + j8 * 8), qw = *(const LAS v4u*)(qt + i * 256 + qtr * 64 + j8 * 8);
                        const float kk[8] = {bflo(kw.x), bfhi(kw.x), bflo(kw.y), bfhi(kw.y), bflo(kw.z), bfhi(kw.z), bflo(kw.w), bfhi(kw.w)};
                        const float qq[8] = {bflo(qw.x), bfhi(qw.x), bflo(qw.y), bfhi(qw.y), bflo(qw.z), bfhi(qw.z), bflo(qw.w), bfhi(qw.w)};
#pragma unroll
                        for (int e = 0; e < 8; ++e) {
                            float s = S[j8 * 8 + e] * gamma;
                            if (dir == 0) { s += kk[e] * v; o += qq[e] * s; } else { o += qq[e] * s; s += kk[e] * v; }
                            S[j8 * 8 + e] = s;
                        }
                    }
                    o += __shfl_xor(o, 1); o += __shfl_xor(o, 2);
                    const float o2 = __shfl_down(o, 4);
                    const int t = t0 + i, p = dir ? (LTOT - 1 - t) : t;
                    if ((F.lane & 7) == 0 && p >= NMETA) {
                        unsigned* dst = (unsigned*)(OR + (size_t)(b * SEQ + p - NMETA) * 2048 + h * 512 + dvb * 128 + col);
                        float r0 = o, r1 = o2;
                        if (pass == 1) { const unsigned old = __hip_atomic_load(dst, RLX_AGENT); r0 += bflo(old); r1 += bfhi(old); }
                        *dst = pk2(r0, r1);
                    }
                }
            }
        }
    }
}

__device__ __forceinline__ void p4_conv(const Args& a, Frame& F) {
    const bf16* RAW = (const bf16*)(a.ws + AR_RAWD); bf16* QD = (bf16*)(a.ws + AR_QKVD);
    for (int it = F.gw; it < NROWS_D * 24; it += F.NGW) {
        const int rd = it / 24, slab = it % 24;
        int b, p; if (rd < NREAL) { b = rd >> 11; p = (rd & (SEQ - 1)) + NMETA; } else { b = (rd - NREAL) >> 4; p = (rd - NREAL) & 15; }
        const int ch = slab * 128 + 2 * F.lane;
        float y0 = 0.f, y1 = 0.f;
#pragma unroll
        for (int j = 0; j < 5; ++j) { const int pp = p + j - 2;
            if (pp >= 0 && pp < LTOT) { const unsigned w = *(const unsigned*)(RAW + (size_t)row_of(b, pp) * 3072 + ch); const float2 cw = *(const float2*)(a.dn_conv + j * 3072 + ch);
                y0 += cw.x * bflo(w); y1 += cw.y * bfhi(w); } }
        y0 = siluf_(y0); y1 = siluf_(y1);
        if (slab < 16) { const float ss = wave_sum(y0 * y0 + y1 * y1); float sc = 1.0f / sqrtf(ss + RMS_EPS); if (slab < 8) sc *= 0.08838834764831845f; y0 *= sc; y1 *= sc; }
        *(unsigned*)(QD + (size_t)rd * 3072 + ch) = pk2(y0, y1);
    }
}

__device__ __forceinline__ void p5_scan_dn_simple(const Args& a, Frame& F) {
    const bf16* QD = (const bf16*)(a.ws + AR_QKVD); const float* GB = (const float*)(a.ws + AR_GBETA); bf16* OD = (bf16*)(a.ws + AR_OD);
    constexpr int TG = 8;
    LAS bf16* qt = (LAS bf16*)F.lds; LAS bf16* kt = qt + TG * 128; LAS bf16* vt = kt + TG * 128; LAS float* gt = (LAS float*)(vt + TG * 64); LAS float* bt = gt + TG;
    const int cl = 8 * F.wave + (F.lane >> 3), sub = F.lane & 7;
    for (int u = blockIdx.x; u < BATCH * DH * 2; u += F.G) {
        const int b = u >> 4, h = (u >> 1) & 7, dvh = u & 1;
        for (int pass = 0; pass < 2; ++pass) {
            const int dir = 1 - pass;
            float S[16];
#pragma unroll
            for (int j = 0; j < 16; ++j) S[j] = 0.f;
            const int ntok = dir ? SEQ : LTOT;
            for (int t0 = 0; t0 < ntok; t0 += TG) {
                __syncthreads();
                for (int c = F.tid; c < TG * 40; c += NTHREADS) {
                    const int i = c / 40, w = c % 40; const int t = t0 + i, p = dir ? (LTOT - 1 - t) : t; const size_t rb = (size_t)rowd_of(b, p) * 3072;
                    if (w < 16) *(LAS v4u*)(qt + i * 128 + w * 8) = *(const v4u*)(QD + rb + h * 128 + w * 8);
                    else if (w < 32) *(LAS v4u*)(kt + i * 128 + (w - 16) * 8) = *(const v4u*)(QD + rb + 1024 + h * 128 + (w - 16) * 8);
                    else *(LAS v4u*)(vt + i * 64 + (w - 32) * 8) = *(const v4u*)(QD + rb + 2048 + h * 128 + dvh * 64 + (w - 32) * 8);
                }
                if (F.tid < TG) { const int t = t0 + F.tid, p = dir ? (LTOT - 1 - t) : t; const size_t rg = (size_t)row_of(b, p) * 32;
                    gt[F.tid] = GB[rg + dir * 8 + h]; bt[F.tid] = GB[rg + 16 + dir * 8 + h]; }
                __syncthreads();
                for (int i = 0; i < TG; ++i) {
                    const float v = bf2f(vt[i * 64 + cl]);
                    const float ag = __expf(gt[i]), beta = bt[i];
                    const v4u kw0 = *(const LAS v4u*)(kt + i * 128 + sub * 16), kw1 = *(const LAS v4u*)(kt + i * 128 + sub * 16 + 8);
                    const v4u qw0 = *(const LAS v4u*)(qt + i * 128 + sub * 16), qw1 = *(const LAS v4u*)(qt + i * 128 + sub * 16 + 8);
                    const float kk[16] = {bflo(kw0.x), bfhi(kw0.x), bflo(kw0.y), bfhi(kw0.y), bflo(kw0.z), bfhi(kw0.z), bflo(kw0.w), bfhi(kw0.w),
                                          bflo(kw1.x), bfhi(kw1.x), bflo(kw1.y), bfhi(kw1.y), bflo(kw1.z), bfhi(kw1.z), bflo(kw1.w), bfhi(kw1.w)};
                    const float qq[16] = {bflo(qw0.x), bfhi(qw0.x), bflo(qw0.y), bfhi(qw0.y), bflo(qw0.z), bfhi(qw0.z), bflo(qw0.w), bfhi(qw0.w),
                                          bflo(qw1.x), bfhi(qw1.x), bflo(qw1.y), bfhi(qw1.y), bflo(qw1.z), bfhi(qw1.z), bflo(qw1.w), bfhi(qw1.w)};
                    float r = 0.f;
#pragma unroll
                    for (int j = 0; j < 16; ++j) r += S[j] * kk[j];
                    r += __shfl_xor(r, 1); r += __shfl_xor(r, 2); r += __shfl_xor(r, 4);
                    const float vn = beta * (v - ag * r);
                    float o = 0.f;
#pragma unroll
                    for (int j = 0; j < 16; ++j) { S[j] = ag * S[j] + kk[j] * vn; o += S[j] * qq[j]; }
                    o += __shfl_xor(o, 1); o += __shfl_xor(o, 2); o += __shfl_xor(o, 4);
                    const float o2 = __shfl_down(o, 8);
                    const int t = t0 + i, p = dir ? (LTOT - 1 - t) : t;
                    if ((F.lane & 15) == 0 && p >= NMETA) {
                        unsigned* dst = (unsigned*)(OD + (size_t)(b * SEQ + p - NMETA) * 1024 + h * 128 + dvh * 64 + cl);
                        float r0 = o, r1 = o2;
                        if (pass == 1) { const unsigned old = __hip_atomic_load(dst, RLX_AGENT); r0 += bflo(old); r1 += bfhi(old); }
                        *dst = pk2(r0, r1);
                    }
                }
            }
        }
    }
}

__device__ __forceinline__ void p6_small_weights(const Args& a, Frame& F) {
    LAS float* scr = (LAS float*)(F.lds + F.wave * 16384);
    bf16* PRT = (bf16*)(a.ws + AR_PRETT); bf16* PDT = (bf16*)(a.ws + AR_PDNT); bf16* WOT = (bf16*)(a.ws + AR_WOUTT); bf16* W2T = (bf16*)(a.ws + AR_W2T);
    constexpr int I_PR = (2048 / 64) * (1024 / 32), I_PD = (1024 / 64) * (1024 / 32), I_WO = I_PD;
    for (int it = F.gw; it < I_PR + I_PD + I_WO; it += F.NGW) {
        int r = it;
        if (r < I_PR) { transpose_item(a.p_ret, 1024, 2048, PRT, 64 * (r / 32), 32 * (r % 32), 32 * (r % 32), scr, F.lane); continue; } r -= I_PR;
        if (r < I_PD) { transpose_item(a.p_dn, 1024, 1024, PDT, 64 * (r / 32), 32 * (r % 32), 32 * (r % 32), scr, F.lane); continue; } r -= I_PD;
        transpose_item(a.w_out, 1024, 1024, WOT, 64 * (r / 32), 32 * (r % 32), 32 * (r % 32), scr, F.lane);
    }
    const int gt = blockIdx.x * NTHREADS + F.tid, NGT = F.G * NTHREADS;
    for (int idx = gt; idx < 2048 * 1024; idx += NGT) {
        const int np = idx >> 10, k = idx & 1023, hp = np >> 7;
        const f32x4* wq = (const f32x4*)(a.peer_wq + (size_t)k * 2048 + hp * 128); const f32x4* ky = (const f32x4*)(a.peer_keys + (size_t)np * 128);
        float s = 0.f;
#pragma unroll 8
        for (int d = 0; d < 32; ++d) { const f32x4 x = wq[d], y = ky[d]; s += (x[0] * y[0] + x[1] * y[1]) + (x[2] * y[2] + x[3] * y[3]); }
        W2T[idx] = (bf16)f2bf(s);
    }
}

__device__ __forceinline__ void p7_gate_norm(const Args& a, Frame& F) {
    bf16* OR = (bf16*)a.out; bf16* OD = (bf16*)(a.ws + AR_OD); const bf16* GRG = (const bf16*)(a.ws + AR_GRG); const bf16* GDZ = (const bf16*)(a.ws + AR_GDZ);
    for (int it = F.gw; it < NREAL * 5; it += F.NGW) {
        const int r = it / 5, part = it % 5;
        if (part < 4) {
            const size_t off = (size_t)r * 2048 + part * 512 + F.lane * 8;
            f32x4 v0, v1, g0, g1; ep::unpack8(*(const v4u*)(OR + off), v0, v1); ep::unpack8(*(const v4u*)(GRG + off), g0, g1);
            float s = (v0[0] + v0[1]) + (v0[2] + v0[3]) + (v1[0] + v1[1]) + (v1[2] + v1[3]);
            const float mean = wave_sum(s) * (1.f / 512.f);
            v0 = v0 - mean; v1 = v1 - mean;
            float s2 = (v0[0] * v0[0] + v0[1] * v0[1]) + (v0[2] * v0[2] + v0[3] * v0[3]) + (v1[0] * v1[0] + v1[1] * v1[1]) + (v1[2] * v1[2] + v1[3] * v1[3]);
            const float rstd = 1.f / sqrtf(wave_sum(s2) * (1.f / 512.f) + LN_EPS);
#pragma unroll
            for (int e = 0; e < 4; ++e) { v0[e] = v0[e] * rstd * siluf_(g0[e]); v1[e] = v1[e] * rstd * siluf_(g1[e]); }
            *(v4u*)(OR + off) = ep::pack8(v0, v1);
        } else {
#pragma unroll
            for (int hh = 0; hh < 2; ++hh) {
                const size_t off = (size_t)r * 1024 + hh * 512 + F.lane * 8;
                f32x4 v0, v1, g0, g1; ep::unpack8(*(const v4u*)(OD + off), v0, v1); ep::unpack8(*(const v4u*)(GDZ + off), g0, g1);
                float s2 = (v0[0] * v0[0] + v0[1] * v0[1]) + (v0[2] * v0[2] + v0[3] * v0[3]) + (v1[0] * v1[0] + v1[1] * v1[1]) + (v1[2] * v1[2] + v1[3] * v1[3]);
                s2 += __shfl_xor(s2, 1); s2 += __shfl_xor(s2, 2); s2 += __shfl_xor(s2, 4); s2 += __shfl_xor(s2, 8);
                const float rs = 1.f / sqrtf(s2 * (1.f / 128.f) + RMS_EPS);
                const int c = (F.lane & 15) * 8;
                const f32x4 n0 = *(const f32x4*)(a.dn_norm_g + c), n1 = *(const f32x4*)(a.dn_norm_g + c + 4);
#pragma unroll
                for (int e = 0; e < 4; ++e) { v0[e] = v0[e] * rs * n0[e] * siluf_(g0[e]); v1[e] = v1[e] * rs * n1[e] * siluf_(g1[e]); }
                *(v4u*)(OD + off) = ep::pack8(v0, v1);
            }
        }
    }
}

__device__ __forceinline__ void p11_ln1_tables(const Args& a, Frame& F) {
    const float* PRE = (const float*)(a.ws + AR_PRE); bf16* H1 = (bf16*)(a.ws + AR_H1);
    for (int r = F.gw; r < NREAL; r += F.NGW) ln_row_affine_bf16(PRE + (size_t)r * D, a.ln1_g, a.ln1_b, H1 + (size_t)r * D, F.lane);
    bf16* UB = (bf16*)(a.ws + WS_UB); bf16* VB = (bf16*)(a.ws + AR_VB);
    const size_t gt = (size_t)blockIdx.x * NTHREADS + F.tid, NGT = (size_t)F.G * NTHREADS, n8 = (size_t)NEXP * D / 8;
    for (size_t i = gt; i < 2 * n8; i += NGT) {
        const bool second = i >= n8; const size_t j = second ? i - n8 : i;
        const f32x4* src = (const f32x4*)((second ? a.peer_v : a.peer_u) + j * 8);
        const f32x4 x = src[0], y = src[1];
        v4u w; w.x = pk2(x[0], x[1]); w.y = pk2(x[2], x[3]); w.z = pk2(y[0], y[1]); w.w = pk2(y[2], y[3]);
        *(v4u*)((second ? VB : UB) + j * 8) = w;
    }
}

__device__ __forceinline__ unsigned ord_key(float v) { const unsigned u = __builtin_bit_cast(unsigned, v); return (u & 0x80000000u) ? ~u : (u | 0x80000000u); }
__device__ __forceinline__ float ord_val(unsigned k) { const unsigned u = (k & 0x80000000u) ? (k & 0x7fffffffu) : ~k; return __builtin_bit_cast(float, u); }
__device__ __forceinline__ unsigned grp16_max(unsigned m) {
    m = max(m, (unsigned)__shfl_xor((int)m, 1)); m = max(m, (unsigned)__shfl_xor((int)m, 2)); m = max(m, (unsigned)__shfl_xor((int)m, 4)); m = max(m, (unsigned)__shfl_xor((int)m, 8)); return m;
}
__device__ __forceinline__ void p13_topk(const Args& a, Frame& F) {
    const float* SC = (const float*)(a.ws + AR_SCORES); int* EXP = (int*)(a.ws + WS_EXP); float* GATE = (float*)(a.ws + WS_GATE);
    LAS float* tops = (LAS float*)(F.lds + F.wave * 2048); LAS int* topi = (LAS int*)(F.lds + F.wave * 2048 + 1024);
    const int q4 = F.lane >> 4, li = F.lane & 15;
    for (int tok = F.gw; tok < NREAL; tok += F.NGW) {
        const float* srow = SC + (size_t)tok * 2048;
#pragma unroll 1
        for (int it = 0; it < 4; ++it) {
            const int grp = it * 4 + q4;
            const f32x4 x0 = *(const f32x4*)(srow + grp * 128 + li * 8), x1 = *(const f32x4*)(srow + grp * 128 + li * 8 + 4);
            unsigned key[8];
#pragma unroll
            for (int j = 0; j < 8; ++j) { const float v = j < 4 ? x0[j] : x1[j - 4]; key[j] = (ord_key(v) & ~127u) | (unsigned)(127 - (li * 8 + j)); }
            unsigned mine = 0u;
#pragma unroll 1
            for (int rnd = 0; rnd < 16; ++rnd) {
                unsigned m = key[0];
#pragma unroll
                for (int j = 1; j < 8; ++j) m = max(m, key[j]);
                m = grp16_max(m);
#pragma unroll
                for (int j = 0; j < 8; ++j) key[j] = (key[j] == m) ? 0u : key[j];
                mine = (li == rnd) ? m : mine;
            }
            tops[grp * 16 + li] = ord_val((mine & ~127u) | 64u); topi[grp * 16 + li] = 127 - (int)(mine & 127u);
        }
        asm volatile("s_waitcnt lgkmcnt(0)" ::: "memory");
#pragma unroll 1
        for (int it = 0; it < 2; ++it) {
            const int hh = it * 4 + q4;
            const float s1 = tops[(2 * hh) * 16 + li];
            unsigned key[16];
#pragma unroll
            for (int j = 0; j < 16; ++j) { const float s2 = tops[(2 * hh + 1) * 16 + j]; key[j] = (ord_key(s1 + s2) & ~255u) | (unsigned)(255 - (li * 16 + j)); }
            unsigned mine = 0u;
#pragma unroll 1
            for (int rnd = 0; rnd < 16; ++rnd) {
                unsigned m = key[0];
#pragma unroll
                for (int j = 1; j < 16; ++j) m = max(m, key[j]);
                m = grp16_max(m);
#pragma unroll
                for (int j = 0; j < 16; ++j) key[j] = (key[j] == m) ? 0u : key[j];
                mine = (li == rnd) ? m : mine;
            }
            const int flat = 255 - (int)(mine & 255u);
            const float best = ord_val((mine & ~255u) | 128u);
            const int i1 = topi[(2 * hh) * 16 + (flat >> 4)], i2 = topi[(2 * hh + 1) * 16 + (flat & 15)];
            const float bmax = __shfl(best, F.lane & 48);
            const float e = __expf(best - bmax);
            float se = e; se += __shfl_xor(se, 1); se += __shfl_xor(se, 2); se += __shfl_xor(se, 4); se += __shfl_xor(se, 8);
            EXP[(size_t)tok * 128 + hh * 16 + li] = i1 * 128 + i2;
            GATE[(size_t)tok * 128 + hh * 16 + li] = e / se;
        }
        asm volatile("s_waitcnt lgkmcnt(0)" ::: "memory");
    }
}

__device__ __forceinline__ float gelu_exact(float x) { return 0.5f * x * (1.0f + erff(x * 0.70710678118654752f)); }
__device__ __forceinline__ void p14_gather(const Args& a, Frame& F) {
    const bf16* H1 = (const bf16*)(a.ws + AR_H1); const int* EXP = (const int*)(a.ws + WS_EXP); const float* GATE = (const float*)(a.ws + WS_GATE);
    const bf16* UB = (const bf16*)(a.ws + WS_UB); const bf16* VB = (const bf16*)(a.ws + AR_VB);
    const int lane = F.lane;
    for (int tok = F.gw; tok < NREAL; tok += F.NGW) {
        float x[16], y[16];
        { const v4u w0 = *(const v4u*)(H1 + (size_t)tok * D + lane * 8), w1 = *(const v4u*)(H1 + (size_t)tok * D + 512 + lane * 8);
          const unsigned ww[8] = {w0.x, w0.y, w0.z, w0.w, w1.x, w1.y, w1.z, w1.w};
#pragma unroll
          for (int j = 0; j < 8; ++j) { x[2 * j] = bflo(ww[j]); x[2 * j + 1] = bfhi(ww[j]); y[2 * j] = 0.f; y[2 * j + 1] = 0.f; } }
        const int e0 = EXP[(size_t)tok * 128 + lane], e1 = EXP[(size_t)tok * 128 + 64 + lane];
        const float g0 = GATE[(size_t)tok * 128 + lane], g1 = GATE[(size_t)tok * 128 + 64 + lane];
#pragma unroll 1
        for (int bt = 0; bt < 16; ++bt) {
            float d[8]; int eid[8];
#pragma unroll
            for (int k = 0; k < 8; ++k) {
                const int slot = bt * 8 + k;
                eid[k] = __builtin_amdgcn_readlane(slot < 64 ? e0 : e1, slot & 63);
                const bf16* ur = UB + (size_t)eid[k] * D;
                const v4u w0 = *(const v4u*)(ur + lane * 8), w1 = *(const v4u*)(ur + 512 + lane * 8);
                const unsigned ww[8] = {w0.x, w0.y, w0.z, w0.w, w1.x, w1.y, w1.z, w1.w};
                float s = 0.f;
#pragma unroll
                for (int j = 0; j < 8; ++j) s += x[2 * j] * bflo(ww[j]) + x[2 * j + 1] * bfhi(ww[j]);
                d[k] = s;
            }
#pragma unroll
            for (int k = 0; k < 8; ++k) d[k] = wave_sum(d[k]);
#pragma unroll
            for (int k = 0; k < 8; ++k) {
                const int slot = bt * 8 + k;
                const float g = __builtin_bit_cast(float, __builtin_amdgcn_readlane(__builtin_bit_cast(int, slot < 64 ? g0 : g1), slot & 63));
                const float wgt = g * gelu_exact(d[k]);
                const bf16* vr = VB + (size_t)eid[k] * D;
                const v4u w0 = *(const v4u*)(vr + lane * 8), w1 = *(const v4u*)(vr + 512 + lane * 8);
                const unsigned ww[8] = {w0.x, w0.y, w0.z, w0.w, w1.x, w1.y, w1.z, w1.w};
#pragma unroll
                for (int j = 0; j < 8; ++j) { y[2 * j] += wgt * bflo(ww[j]); y[2 * j + 1] += wgt * bfhi(ww[j]); }
            }
        }
        float s = 0.f;
#pragma unroll
        for (int j = 0; j < 16; ++j) { y[j] = DN_ALPHA * x[j] + y[j]; s += y[j]; }
        const float mean = wave_sum(s) * (1.f / D); float s2 = 0.f;
#pragma unroll
        for (int j = 0; j < 16; ++j) { y[j] -= mean; s2 += y[j] * y[j]; }
        const float rstd = 1.f / sqrtf(wave_sum(s2) * (1.f / D) + LN_EPS);
#pragma unroll
        for (int c = 0; c < 2; ++c)
#pragma unroll
            for (int q = 0; q < 2; ++q) {
                const int col = c * 512 + lane * 8 + q * 4;
                const f32x4 gg = *(const f32x4*)(a.ln2_g + col), bb = *(const f32x4*)(a.ln2_b + col);
                f32x4 o;
#pragma unroll
                for (int e = 0; e < 4; ++e) o[e] = y[c * 8 + q * 4 + e] * rstd * gg[e] + bb[e];
                *(f32x4*)(a.out + (size_t)tok * D + col) = o;
            }
    }
}

typedef short s16x4 __attribute__((ext_vector_type(4)));
typedef short bfx8 __attribute__((ext_vector_type(8)));
constexpr int R2_QS = 544, R2_VS = 144, R2_PS = 80;
constexpr int R2_Q = 0, R2_K = 32 * R2_QS, R2_V = 2 * 32 * R2_QS, R2_P = R2_V + 32 * R2_VS, R2_GRP = R2_P + 32 * R2_PS;
__device__ __forceinline__ bfx8 tr16_frag(const LAS unsigned char* p0, const LAS unsigned char* p1) {
    const s16x4 a = __builtin_amdgcn_ds_read_tr16_b64_v4i16((LAS s16x4*)p0), b = __builtin_amdgcn_ds_read_tr16_b64_v4i16((LAS s16x4*)p1);
    return (bfx8){a[0], a[1], a[2], a[3], b[0], b[1], b[2], b[3]};
}
__device__ __forceinline__ bfx8 ld2x8(const LAS unsigned char* p0, const LAS unsigned char* p1) {
    const v2u a = *(const LAS v2u*)p0, b = *(const LAS v2u*)p1; const v4u w = {a.x, a.y, b.x, b.y}; return __builtin_bit_cast(bfx8, w);
}
__device__ __forceinline__ bfx8 pack_acc2(f32x4 a, f32x4 b, float sc) {
    const v4u w = {pk2(a[0] * sc, a[1] * sc), pk2(a[2] * sc, a[3] * sc), pk2(b[0] * sc, b[1] * sc), pk2(b[2] * sc, b[3] * sc)}; return __builtin_bit_cast(bfx8, w);
}
#define MFMA16(a, b, c) __builtin_amdgcn_mfma_f32_16x16x32_bf16((a), (b), (c), 0, 0, 0)

__device__ __forceinline__ void p2_scan_ret(const Args& a, Frame& F) {
    const bf16* QKV = (const bf16*)(a.ws + AR_QKVR); bf16* OR = (bf16*)a.out;
    const int grp = F.wave >> 2, wq = F.wave & 3, tg = F.tid & 255, lane = F.lane, g = lane >> 4, l15 = lane & 15, q4 = (lane & 15) >> 2, p4 = lane & 3;
    LAS unsigned char* L = F.lds + grp * R2_GRP;
    constexpr int NSTEP = 65;
    for (int u = blockIdx.x; u < BATCH * RH * 8; u += F.G) {
        const int b = u >> 5, h = (u >> 3) & 3, dvs = u & 7;
        const float xl = a.ret_decay[grp * RH + h];
        const float lg2 = -log2f(1.0f + __expf(-xl));
        const float gC = exp2f(32.f * lg2);
        f32x4 S[16];
#pragma unroll
        for (int d = 0; d < 16; ++d) S[d] = (f32x4){0.f, 0.f, 0.f, 0.f};
        v4u rq[4], rk[4], rv;
        const float vscale = exp2f((float)(31 - (tg >> 3)) * lg2);
        const float rs0 = exp2f((float)(l15 - 31) * lg2), rs1 = exp2f((float)(l15 + 16 - 31) * lg2);
#define R2_ROW(st, i, row)    \
        do { if (grp == 0) { if ((st) == 0) row = (i) >= 16 ? NREAL + (i) - 16 : -1; else row = b * SEQ + 32 * ((st) - 1) + (i); } \
             else { if ((st) == 0) row = -1; else row = b * SEQ + 32 * (64 - (st)) + 31 - (i); } } while (0)
#define R2_LOADS(st) do { \
        _Pragma("unroll") for (int i_ = 0; i_ < 4; ++i_) { const int cid = tg + 256 * i_, ti = cid >> 5, c16 = cid & 31; int row; R2_ROW(st, ti, row); \
            if (row >= 0) { const bf16* src = QKV + (size_t)row * 4096 + h * 256 + c16 * 8; rq[i_] = *(const v4u*)src; rk[i_] = *(const v4u*)(src + 1024); } \
            else { rq[i_] = (v4u){0u, 0u, 0u, 0u}; rk[i_] = (v4u){0u, 0u, 0u, 0u}; } } \
        { const int ti = tg >> 3, c16 = tg & 7; int row; R2_ROW(st, ti, row); \
            if (row >= 0) rv = *(const v4u*)(QKV + (size_t)row * 4096 + 2048 + h * 512 + dvs * 64 + c16 * 8); else rv = (v4u){0u, 0u, 0u, 0u}; } } while (0)
        R2_LOADS(0);
#pragma unroll 1
        for (int st = 0; st < NSTEP; ++st) {
#pragma unroll
            for (int i_ = 0; i_ < 4; ++i_) { const int cid = tg + 256 * i_, ti = cid >> 5, c16 = cid & 31;
                *(LAS v4u*)(L + R2_Q + ti * R2_QS + c16 * 16) = rq[i_]; *(LAS v4u*)(L + R2_K + ti * R2_QS + c16 * 16) = rk[i_]; }
            { const int ti = tg >> 3, c16 = tg & 7; v4u w;
                w.x = pk2(bflo(rv.x) * vscale, bfhi(rv.x) * vscale); w.y = pk2(bflo(rv.y) * vscale, bfhi(rv.y) * vscale);
                w.z = pk2(bflo(rv.z) * vscale, bfhi(rv.z) * vscale); w.w = pk2(bflo(rv.w) * vscale, bfhi(rv.w) * vscale);
                *(LAS v4u*)(L + R2_V + ti * R2_VS + c16 * 16) = w; }
            __syncthreads();
            if (st + 1 < NSTEP) { R2_LOADS(st + 1); }
            {
                const int mi = wq >> 1, ni = wq & 1;
                f32x4 pacc = (f32x4){0.f, 0.f, 0.f, 0.f};
                const LAS unsigned char* qa = L + R2_Q + (16 * mi + l15) * R2_QS + g * 16; const LAS unsigned char* kb = L + R2_K + (16 * ni + l15) * R2_QS + g * 16;
#pragma unroll
                for (int s = 0; s < 8; ++s) pacc = MFMA16(*(const LAS bfx8*)(qa + s * 64), *(const LAS bfx8*)(kb + s * 64), pacc);
                const int j = 16 * ni + l15;
#pragma unroll
                for (int r = 0; r < 4; ++r) { const int i = 16 * mi + 4 * g + r; const bool keep = grp == 0 ? (j <= i) : (j < i);
                    *(LAS bf16*)(L + R2_P + i * R2_PS + j * 2) = (bf16)f2bf(keep ? pacc[r] : 0.f); }
            }
            __syncthreads();
            const bfx8 vdf = tr16_frag(L + R2_V + (8 * g + q4) * R2_VS + (16 * wq + 4 * p4) * 2, L + R2_V + (8 * g + 4 + q4) * R2_VS + (16 * wq + 4 * p4) * 2);
            f32x4 oT[2] = {(f32x4){0.f, 0.f, 0.f, 0.f}, (f32x4){0.f, 0.f, 0.f, 0.f}};
#pragma unroll
            for (int s = 0; s < 8; ++s) {
                const bfx8 sf = pack_acc2(S[2 * s], S[2 * s + 1], gC);
#pragma unroll
                for (int mt = 0; mt < 2; ++mt) { const LAS unsigned char* qp = L + R2_Q + (16 * mt + l15) * R2_QS + (32 * s + 4 * g) * 2;
                    oT[mt] = MFMA16(sf, ld2x8(qp, qp + 32), oT[mt]); }
            }
#pragma unroll
            for (int mt = 0; mt < 2; ++mt) oT[mt] = MFMA16(vdf, *(const LAS bfx8*)(L + R2_P + (16 * mt + l15) * R2_PS + g * 16), oT[mt]);
#pragma unroll
            for (int d = 0; d < 16; ++d) {
                const bfx8 kf = tr16_frag(L + R2_K + (8 * g + q4) * R2_QS + (16 * d + 4 * p4) * 2, L + R2_K + (8 * g + 4 + q4) * R2_QS + (16 * d + 4 * p4) * 2);
                S[d] = MFMA16(kf, vdf, S[d] * gC);
            }
            const bool active = (st >= 1);
            if (active) {
#pragma unroll
                for (int mt = 0; mt < 2; ++mt) {
                    int row; R2_ROW(st, 16 * mt + l15, row);
                    unsigned long long* dst = (unsigned long long*)(OR + (size_t)row * 2048 + h * 512 + dvs * 64 + 16 * wq + 4 * g);
                    const float rs = mt ? rs1 : rs0;
                    float o0 = oT[mt][0] * rs, o1 = oT[mt][1] * rs, o2 = oT[mt][2] * rs, o3 = oT[mt][3] * rs;
                    if (st >= 33) { const unsigned long long old = __hip_atomic_load(dst, RLX_AGENT); const unsigned lo = (unsigned)old, hi = (unsigned)(old >> 32);
                        o0 += bflo(lo); o1 += bfhi(lo); o2 += bflo(hi); o3 += bfhi(hi); }
                    *dst = (unsigned long long)pk2(o0, o1) | ((unsigned long long)pk2(o2, o3) << 32);
                }
            }
            if (st == 32) asm volatile("s_waitcnt vmcnt(0)" ::: "memory");
            __syncthreads();
        }
#undef R2_ROW
#undef R2_LOADS
    }
}

constexpr size_t AR_TBUF = WS_AR + 32 * MiB;
constexpr int DN_REC = 4608, DN_NSTEP = 65;
static_assert(AR_TBUF + (size_t)BATCH * DH * 2 * DN_NSTEP * DN_REC <= AR_GBETA, "TBUF fits the dead RAW_D region");

__device__ __forceinline__ void dn_rows(int b, int dir, int st, int i, int& rq, int& rg) {
    if (dir == 0) { if (st == 0) { if (i >= 16) { rq = NREAL + b * NMETA + (i - 16); rg = NREAL + (i - 16); } else { rq = -1; rg = -1; } }
                    else { rq = b * SEQ + 32 * (st - 1) + i; rg = rq; } }
    else { if (st == 0) { rq = -1; rg = -1; } else { rq = b * SEQ + 32 * (64 - st) + 31 - i; rg = rq; } }
}

__device__ __forceinline__ void p4b_dn_tinv(const Args& a, Frame& F) {
    const bf16* QD = (const bf16*)(a.ws + AR_QKVD); const float* GB = (const float*)(a.ws + AR_GBETA); unsigned char* TB = a.ws + AR_TBUF;
    LAS float* Am = (LAS float*)(F.lds + F.wave * 4352);
    const int lane = F.lane, g = lane >> 4, l15 = lane & 15;
    for (int idx = F.gw; idx < BATCH * DH * 2 * DN_NSTEP; idx += F.NGW) {
        const int st = idx % DN_NSTEP, bhd = idx / DN_NSTEP, dir = bhd & 1, h = (bhd >> 1) & 7, b = bhd >> 4;
        if (dir == 1 && st == 0) continue;
        float gi = 0.f, bi = 0.f;
        { int rq, rg; dn_rows(b, dir, st, lane & 31, rq, rg); if (rg >= 0) { gi = GB[(size_t)rg * 32 + dir * 8 + h]; bi = GB[(size_t)rg * 32 + 16 + dir * 8 + h]; } }
        float bc = gi;
#pragma unroll
        for (int off = 1; off < 32; off <<= 1) { const float t = __shfl_up(bc, off); if ((lane & 31) >= off) bc += t; }
        bfx8 kf[2][4];
#pragma unroll
        for (int mi = 0; mi < 2; ++mi) { int rq, rg; dn_rows(b, dir, st, 16 * mi + l15, rq, rg);
#pragma unroll
            for (int s = 0; s < 4; ++s) { if (rq >= 0) kf[mi][s] = *(const bfx8*)(QD + (size_t)rq * 3072 + 1024 + h * 128 + 32 * s + 8 * g); else kf[mi][s] = (bfx8){0, 0, 0, 0, 0, 0, 0, 0}; } }
#pragma unroll
        for (int mi = 0; mi < 2; ++mi)
#pragma unroll
            for (int ni = 0; ni < 2; ++ni) {
                f32x4 acc = (f32x4){0.f, 0.f, 0.f, 0.f};
#pragma unroll
                for (int s = 0; s < 4; ++s) acc = MFMA16(kf[mi][s], kf[ni][s], acc);
                const int j = 16 * ni + l15; const float bj = __shfl(bc, j);
#pragma unroll
                for (int r = 0; r < 4; ++r) { const int i = 16 * mi + 4 * g + r; const float bi_ = __shfl(bc, i), be = __shfl(bi, i);
                    Am[i * 33 + j] = (i > j) ? be * acc[r] * __expf(bi_ - bj) : 0.f; }
            }
        asm volatile("s_waitcnt lgkmcnt(0)" ::: "memory");
        float T[32];
        const int c = lane & 31;
#pragma unroll
        for (int i = 0; i < 32; ++i) {
            float s0 = (i == c) ? 1.f : 0.f, s1 = 0.f;
#pragma unroll
            for (int j = 0; j < i; ++j) { const float av = Am[i * 33 + j]; if (j & 1) s1 -= av * T[j]; else s0 -= av * T[j]; }
            T[i] = s0 + s1;
        }
        unsigned char* rec = TB + (size_t)idx * DN_REC;
        const float csc = bi * __expf(bc);
        if (lane < 32) {
#pragma unroll
            for (int i = 0; i < 32; ++i) { ((bf16*)rec)[i * 32 + c] = (bf16)f2bf(T[i]); ((bf16*)(rec + 2048))[i * 32 + c] = (bf16)f2bf(T[i] * csc); }
            ((float*)(rec + 4096))[c] = bc; ((float*)(rec + 4224))[c] = bi;
        }
        asm volatile("s_waitcnt lgkmcnt(0)" ::: "memory");
    }
}

constexpr int D5_QS = 288, D5_VS = 144, D5_TS = 80;
constexpr int D5_Q = 0, D5_K = 9216, D5_V = 18432, D5_T = 23040, D5_T2 = 25600, D5_A = 28160, D5_W = 30720, D5_VEC = 39936, D5_GRP = 40192;
__device__ __forceinline__ void p5_scan_dn(const Args& a, Frame& F) {
    const bf16* QD = (const bf16*)(a.ws + AR_QKVD); const unsigned char* TB = a.ws + AR_TBUF; bf16* OD = (bf16*)(a.ws + AR_OD);
    const int grp = F.wave >> 2, wq = F.wave & 3, tg = F.tid & 255, lane = F.lane, g = lane >> 4, l15 = lane & 15, q4 = (lane & 15) >> 2, p4 = lane & 3;
    LAS unsigned char* L = F.lds + grp * D5_GRP;
    const LAS float* bcv = (const LAS float*)(L + D5_VEC);
    for (int u = blockIdx.x; u < BATCH * DH * 2; u += F.G) {
        const int b = u >> 4, h = (u >> 1) & 7, dvh = u & 1;
        const unsigned char* recbase = TB + (size_t)(((b * DH + h) * 2 + grp) * DN_NSTEP) * DN_REC;
        f32x4 S[8];
#pragma unroll
        for (int d = 0; d < 8; ++d) S[d] = (f32x4){0.f, 0.f, 0.f, 0.f};
        v4u rq[2], rk[2], rv, rt, rvec; float rbeta;
#define D5_LOADS(st) do { \
        _Pragma("unroll") for (int i_ = 0; i_ < 2; ++i_) { const int cid = tg + 256 * i_, ti = cid >> 4, c16 = cid & 15; int r_, rg_; dn_rows(b, grp, (st), ti, r_, rg_); \
            if (r_ >= 0) { const bf16* src = QD + (size_t)r_ * 3072 + h * 128 + c16 * 8; rq[i_] = *(const v4u*)src; rk[i_] = *(const v4u*)(src + 1024); } \
            else { rq[i_] = (v4u){0u, 0u, 0u, 0u}; rk[i_] = (v4u){0u, 0u, 0u, 0u}; } } \
        { const int ti = tg >> 3, c16 = tg & 7; int r_, rg_; dn_rows(b, grp, (st), ti, r_, rg_); \
            if (r_ >= 0) rv = *(const v4u*)(QD + (size_t)r_ * 3072 + 2048 + h * 128 + dvh * 64 + c16 * 8); else rv = (v4u){0u, 0u, 0u, 0u}; } \
        if (grp == 0 || (st) >= 1) { const unsigned char* rec = recbase + (size_t)(st) * DN_REC; rt = *(const v4u*)(rec + tg * 16); rbeta = *(const float*)(rec + 4224 + (tg >> 3) * 4); \
            if (tg < 16) rvec = *(const v4u*)(rec + 4096 + tg * 16); } \
        else { rt = (v4u){0u, 0u, 0u, 0u}; rbeta = 0.f; rvec = (v4u){0u, 0u, 0u, 0u}; } } while (0)
        D5_LOADS(0);
#pragma unroll 1
        for (int st = 0; st < DN_NSTEP; ++st) {
#pragma unroll
            for (int i_ = 0; i_ < 2; ++i_) { const int cid = tg + 256 * i_, ti = cid >> 4, c16 = cid & 15;
                *(LAS v4u*)(L + D5_Q + ti * D5_QS + c16 * 16) = rq[i_]; *(LAS v4u*)(L + D5_K + ti * D5_QS + c16 * 16) = rk[i_]; }
            { const int ti = tg >> 3, c16 = tg & 7; v4u w;
                w.x = pk2(bflo(rv.x) * rbeta, bfhi(rv.x) * rbeta); w.y = pk2(bflo(rv.y) * rbeta, bfhi(rv.y) * rbeta);
                w.z = pk2(bflo(rv.z) * rbeta, bfhi(rv.z) * rbeta); w.w = pk2(bflo(rv.w) * rbeta, bfhi(rv.w) * rbeta);
                *(LAS v4u*)(L + D5_V + ti * D5_VS + c16 * 16) = w; }
            { const int tsel = tg >> 7, c = tg & 127; *(LAS v4u*)(L + (tsel ? D5_T2 : D5_T) + (c >> 2) * D5_TS + (c & 3) * 16) = rt; }
            if (tg < 16) *(LAS v4u*)(L + D5_VEC + tg * 16) = rvec;
            __syncthreads();
            if (st + 1 < DN_NSTEP) { D5_LOADS(st + 1); }
            {
                const int mi = wq >> 1, ni = wq & 1;
                f32x4 pacc = (f32x4){0.f, 0.f, 0.f, 0.f};
                const LAS unsigned char* qa = L + D5_Q + (16 * mi + l15) * D5_QS + g * 16; const LAS unsigned char* kb = L + D5_K + (16 * ni + l15) * D5_QS + g * 16;
#pragma unroll
                for (int s = 0; s < 4; ++s) pacc = MFMA16(*(const LAS bfx8*)(qa + s * 64), *(const LAS bfx8*)(kb + s * 64), pacc);
                const int j = 16 * ni + l15; const float bj = bcv[j];
#pragma unroll
                for (int r = 0; r < 4; ++r) { const int i = 16 * mi + 4 * g + r;
                    *(LAS bf16*)(L + D5_A + i * D5_TS + j * 2) = (bf16)f2bf((j <= i) ? pacc[r] * __expf(bcv[i] - bj) : 0.f); }
#pragma unroll
                for (int dd = 0; dd < 2; ++dd) { const int d = 2 * wq + dd;
                    const bfx8 kf = tr16_frag(L + D5_K + (8 * g + q4) * D5_QS + (16 * d + 4 * p4) * 2, L + D5_K + (8 * g + 4 + q4) * D5_QS + (16 * d + 4 * p4) * 2);
#pragma unroll
                    for (int mt = 0; mt < 2; ++mt) {
                        f32x4 wacc = MFMA16(kf, *(const LAS bfx8*)(L + D5_T2 + (16 * mt + l15) * D5_TS + g * 16), ((f32x4){0.f, 0.f, 0.f, 0.f}));
                        v2u w; w.x = pk2(-wacc[0], -wacc[1]); w.y = pk2(-wacc[2], -wacc[3]);
                        *(LAS v2u*)(L + D5_W + (16 * mt + l15) * D5_QS + (16 * d + 4 * g) * 2) = w;
                    }
                }
            }
            __syncthreads();
            const float blast = bcv[31], eL = __expf(blast);
            const bfx8 vf = tr16_frag(L + D5_V + (8 * g + q4) * D5_VS + (16 * wq + 4 * p4) * 2, L + D5_V + (8 * g + 4 + q4) * D5_VS + (16 * wq + 4 * p4) * 2);
            f32x4 vn[2], o1[2];
#pragma unroll
            for (int mt = 0; mt < 2; ++mt) { vn[mt] = MFMA16(*(const LAS bfx8*)(L + D5_T + (16 * mt + l15) * D5_TS + g * 16), vf, ((f32x4){0.f, 0.f, 0.f, 0.f})); o1[mt] = (f32x4){0.f, 0.f, 0.f, 0.f}; }
#pragma unroll
            for (int s = 0; s < 4; ++s) {
                const bfx8 sf = pack_acc2(S[2 * s], S[2 * s + 1], 1.0f);
#pragma unroll
                for (int mt = 0; mt < 2; ++mt) {
                    const LAS unsigned char* wp = L + D5_W + (16 * mt + l15) * D5_QS + (32 * s + 4 * g) * 2; const LAS unsigned char* qp = L + D5_Q + (16 * mt + l15) * D5_QS + (32 * s + 4 * g) * 2;
                    vn[mt] = MFMA16(ld2x8(wp, wp + 32), sf, vn[mt]);
                    o1[mt] = MFMA16(sf, ld2x8(qp, qp + 32), o1[mt]);
                }
            }
            const bfx8 vnf = pack_acc2(vn[0], vn[1], 1.0f);
            f32x4 vs0, vs1;
#pragma unroll
            for (int r = 0; r < 4; ++r) { vs0[r] = vn[0][r] * __expf(blast - bcv[4 * g + r]); vs1[r] = vn[1][r] * __expf(blast - bcv[16 + 4 * g + r]); }
            const bfx8 vnsf = pack_acc2(vs0, vs1, 1.0f);
            f32x4 o2[2];
#pragma unroll
            for (int mt = 0; mt < 2; ++mt) { const LAS unsigned char* ap = L + D5_A + (16 * mt + l15) * D5_TS + (4 * g) * 2; o2[mt] = MFMA16(vnf, ld2x8(ap, ap + 32), ((f32x4){0.f, 0.f, 0.f, 0.f})); }
#pragma unroll
            for (int d = 0; d < 8; ++d) {
                const bfx8 kp = tr16_frag(L + D5_K + (4 * g + q4) * D5_QS + (16 * d + 4 * p4) * 2, L + D5_K + (16 + 4 * g + q4) * D5_QS + (16 * d + 4 * p4) * 2);
                S[d] = MFMA16(kp, vnsf, S[d] * eL);
            }
            if (st >= 1) {
#pragma unroll
                for (int mt = 0; mt < 2; ++mt) {
                    const int i = 16 * mt + l15; int row, rg_; dn_rows(b, grp, st, i, row, rg_);
                    unsigned long long* dst = (unsigned long long*)(OD + (size_t)row * 1024 + h * 128 + dvh * 64 + 16 * wq + 4 * g);
                    const float ei = __expf(bcv[i]);
                    float x0 = o1[mt][0] * ei + o2[mt][0], x1 = o1[mt][1] * ei + o2[mt][1], x2 = o1[mt][2] * ei + o2[mt][2], x3 = o1[mt][3] * ei + o2[mt][3];
                    if (st >= 33) { const unsigned long long old = __hip_atomic_load(dst, RLX_AGENT); const unsigned lo = (unsigned)old, hi = (unsigned)(old >> 32);
                        x0 += bflo(lo); x1 += bfhi(lo); x2 += bflo(hi); x3 += bfhi(hi); }
                    *dst = (unsigned long long)pk2(x0, x1) | ((unsigned long long)pk2(x2, x3) << 32);
                }
            }
            if (st == 32) asm volatile("s_waitcnt vmcnt(0)" ::: "memory");
            __syncthreads();
        }
#undef D5_LOADS
    }
}

constexpr int NPHASES = 16;
__global__ void __launch_bounds__(NTHREADS, 2) fwd_kernel(Args args) {
    extern __shared__ __attribute__((aligned(16))) unsigned char lds_raw[];
    Frame F;
    F.lds = (LAS unsigned char*)lds_raw;
    F.tid = threadIdx.x; F.lane = F.tid & 63; F.wave = __builtin_amdgcn_readfirstlane(F.tid >> 6);
    F.G = gridDim.x; F.gw = blockIdx.x * NWAVES + F.wave; F.NGW = F.G * NWAVES;
    volatile LAS unsigned* MISC = (volatile LAS unsigned*)(F.lds + MISC_OFF);
    for (int u = F.tid; u < (LDS_BYTES - RING_BYTES) / 4; u += NTHREADS) ((LAS unsigned*)(F.lds + RING_BYTES))[u] = 0u;
    __syncthreads();
    unsigned* ctl = (unsigned*)(args.ws + WS_CTL);
    const int lo = args.ph_lo, hi = args.ph_hi;
    XcdBarrier bar; bar.bar = ctl + CW_BAR; bar.x = 0; bar.st = nullptr;
    if (hi - lo > 1) bar = xcd_barrier_post(ctl + CW_BAR, MISC + 8);
#define IN(k) (lo <= (k) && (k) < hi)
#define SEAM(k) do { if (IN(k) && IN((k) + 1)) xcd_barrier(bar); } while (0)
    unsigned char* ws = args.ws;
    bf16* HB = (bf16*)(ws + WS_HB); bf16* WT = (bf16*)(ws + WS_WT);

    if (IN(0)) { p0_prologue(args, F); } SEAM(0);
    if (IN(1)) {
        pg8::Gemm g{HB, WT + (size_t)WT_A0 * D, MROWS, WT_A_N, D}; pg8::StaticOrder S; S.init(MROWS, WT_A_N, F.G, (int)blockIdx.x);
        ep::EpiRot E{(bf16*)(ws + AR_QKVR)};
        pg8::gemm_phase<ep::EpiRot, pg8::StaticOrder, true, true>(F.lds, g, S, E);
    } SEAM(1);
    if (IN(2)) { p2_scan_ret(args, F); } SEAM(2);
    if (IN(3)) {
        pg8::Gemm g{HB, WT + (size_t)WT_B0 * D, MROWS, WT_B_N, D}; pg8::StaticOrder S; S.init(MROWS, WT_B_N, F.G, (int)blockIdx.x);
        ep::EpiDn E{(bf16*)(ws + AR_RAWD), (float*)(ws + AR_GBETA), args.dn_a_log, args.dn_dt_bias};
        pg8::gemm_phase<ep::EpiDn, pg8::StaticOrder, true, true>(F.lds, g, S, E);
    } SEAM(3);
    if (IN(4)) { p4_conv(args, F); } SEAM(4);
    if (IN(5)) { p4b_dn_tinv(args, F); } SEAM(5);
    if (IN(6)) { p5_scan_dn(args, F); } SEAM(6);
    if (IN(7)) {
        p6_small_weights(args, F);
        __syncthreads();
        pg8::Gemm g{HB, WT + (size_t)WT_C0 * D, NREAL, WT_C_N, D}; pg8::StaticOrder S; S.init(NREAL, WT_C_N, F.G, (int)blockIdx.x);
        ep::EpiGates E{(bf16*)(ws + AR_GRG), (bf16*)(ws + AR_GDZ), (bf16*)(ws + AR_GGA), (bf16*)(ws + AR_GGB)};
        pg8::gemm_phase<ep::EpiGates, pg8::StaticOrder, true, true>(F.lds, g, S, E);
    } SEAM(7);
    if (IN(8)) { p7_gate_norm(args, F); } SEAM(8);
    if (IN(9)) {
        pg8::Gemm g{(const bf16*)args.out, (const bf16*)(ws + AR_PRETT), NREAL, 1024, 2048}; pg8::StaticOrder S; S.init(NREAL, 1024, F.G, (int)blockIdx.x);
        ep::EpiMerge<false> E{(const bf16*)(ws + AR_GGA), nullptr, (bf16*)(ws + AR_M1)};
        pg8::gemm_phase<ep::EpiMerge<false>, pg8::StaticOrder, true, true>(F.lds, g, S, E);
    } SEAM(9);
    if (IN(10)) {
        pg8::Gemm g{(const bf16*)(ws + AR_OD), (const bf16*)(ws + AR_PDNT), NREAL, 1024, 1024}; pg8::StaticOrder S; S.init(NREAL, 1024, F.G, (int)blockIdx.x);
        ep::EpiMerge<true> E{(const bf16*)(ws + AR_GGB), (const bf16*)(ws + AR_M1), (bf16*)(ws + AR_MERGED)};
        pg8::gemm_phase<ep::EpiMerge<true>, pg8::StaticOrder, true, true>(F.lds, g, S, E);
    } SEAM(10);
    if (IN(11)) {
        pg8::Gemm g{(const bf16*)(ws + AR_MERGED), (const bf16*)(ws + AR_WOUTT), NREAL, 1024, 1024}; pg8::StaticOrder S; S.init(NREAL, 1024, F.G, (int)blockIdx.x);
        ep::EpiRes E{HB, (float*)(ws + AR_PRE)};
        pg8::gemm_phase<ep::EpiRes, pg8::StaticOrder, true, true>(F.lds, g, S, E);
    } SEAM(11);
    if (IN(12)) { p11_ln1_tables(args, F); } SEAM(12);
    if (IN(13)) {
        pg8::Gemm g{(const bf16*)(ws + AR_H1), (const bf16*)(ws + AR_W2T), NREAL, 2048, 1024}; pg8::StaticOrder S; S.init(NREAL, 2048, F.G, (int)blockIdx.x);
        ep::EpiF32 E{(float*)(ws + AR_SCORES), 2048};
        pg8::gemm_phase<ep::EpiF32, pg8::StaticOrder, true, true>(F.lds, g, S, E);
    } SEAM(13);
    if (IN(14)) { p13_topk(args, F); } SEAM(14);
    if (IN(15)) { p14_gather(args, F); }
#undef IN
#undef SEAM
}

#ifndef N_LAUNCH_MODE
#define N_LAUNCH_MODE 1
#endif
extern "C" void kernel_launch(void* const* d_in, const int* in_sizes, int n_in, void* d_out, int out_size, void* d_ws, size_t ws_size, hipStream_t stream) {
    static int grid = 0;
    if (grid == 0) {
        if (n_in != 21 || out_size != NREAL * D || ws_size < WS_END) { fprintf(stderr, "kernel_launch: unexpected shapes (n_in %d, out %d, ws %zu)\n", n_in, out_size, ws_size); grid = -1; return; }
        int dev = 0, cus = 0;
        if (hipGetDevice(&dev) != hipSuccess || hipDeviceGetAttribute(&cus, hipDeviceAttributeMultiprocessorCount, dev) != hipSuccess) { grid = -1; return; }
        if (hipFuncSetAttribute((const void*)fwd_kernel, hipFuncAttributeMaxDynamicSharedMemorySize, LDS_BYTES) != hipSuccess) { grid = -1; return; }
        int per_cu = 0;
        (void)hipOccupancyMaxActiveBlocksPerMultiprocessor(&per_cu, (const void*)fwd_kernel, NTHREADS, LDS_BYTES);
        (void)hipGetLastError();
        grid = cus;
    }
    if (grid < 0) return;
    (void)hipMemsetAsync((char*)d_ws + WS_CTL, 0, CTL_ZERO_BYTES, stream);
    Args a{};
    const float** fp = (const float**)&a;
    for (int i = 0; i < 21; ++i) fp[i] = (const float*)d_in[i];
    a.out = (float*)d_out; a.ws = (unsigned char*)d_ws;
    if (N_LAUNCH_MODE == 1) {
        a.ph_lo = 0; a.ph_hi = NPHASES;
        hipLaunchKernelGGL(fwd_kernel, dim3(grid), dim3(NTHREADS), LDS_BYTES, stream, a);
    } else {
        for (int p = 0; p < NPHASES; ++p) { a.ph_lo = p; a.ph_hi = p + 1; hipLaunchKernelGGL(fwd_kernel, dim3(grid), dim3(NTHREADS), LDS_BYTES, stream, a); }
    }
}
```

```cpp
#include <hip/hip_runtime.h>
#include <cstdio>
#include <cstdint>
namespace pg8 {
#define PG8_LAS __attribute__((address_space(3)))
typedef unsigned short bf16_t;
typedef short bf16x8 __attribute__((ext_vector_type(8)));
typedef float f32x4 __attribute__((ext_vector_type(4)));
typedef unsigned u32x4 __attribute__((ext_vector_type(4)));
constexpr int BM = 256, BK = 64, HALF = 128, HTB = HALF * BK * 2  , STAGE_BYTES = 8 * HTB, NXCD = 8, WGM = 8;

__host__ __device__ __forceinline__ int lds_byte(int r, int c) { const int st = (r >> 4) * 2 + (c >> 5), rr = r & 15, cc = c & 31, ob = rr * 64 + cc * 2; return st * 1024 + (ob ^ (((ob >> 9) & 1) << 5)); }
__host__ __device__ __forceinline__ void stage_rc(int b, int& R, int& C) { const int st = b / 1024, sb = b % 1024, swz = sb ^ (((sb >> 9) & 1) << 5); R = (st >> 1) * 16 + swz / 64; C = (st & 1) * 32 + (swz % 64) / 2; }
__host__ __device__ __forceinline__ int perm32(int rho) { const int n = rho >> 4, i = rho & 15; return 8 * (i >> 2) + 4 * n + (i & 3); }

struct Unit { int pm, pn; };
struct Gemm { const bf16_t* A; const bf16_t* Bt; int M, N, K; };

struct StaticOrder {
    int nM, nN, nwg, G, c;
    __host__ __device__ void init(int M, int N, int G_, int c_) { nM = M / BM; nN = N / BM; nwg = nM * nN; G = G_; c = c_; }
    __host__ __device__ bool next(int i, Unit& u) const {
        const long L = (long)i * G + c; if (L >= nwg) return false;
        int wgid = (int)L; { const int q = nwg / NXCD, r = nwg % NXCD, xcd = wgid % NXCD, off = wgid / NXCD; wgid = (xcd < r ? xcd * (q + 1) : r * (q + 1) + (xcd - r) * q) + off; }
        const int nig = WGM * nN, gid = wgid / nig, fm = gid * WGM, gsz = (nM - fm) < WGM ? (nM - fm) : WGM;
        u.pm = fm + ((wgid % nig) % gsz); u.pn = (wgid % nig) / gsz; return true;
    }
    __device__ __forceinline__ void a_ready(const Unit&) const {}
    __device__ __forceinline__ void done(const Unit&) const {}
};
__device__ __forceinline__ unsigned cvt_pk_bf16(float lo, float hi) { unsigned r; asm volatile("v_cvt_pk_bf16_f32 %0, %1, %2" : "=v"(r) : "v"(lo), "v"(hi)); return r; }
template <class Epi, class Sched, bool ALIGN_EPI = false, bool SP2 = false>
__device__ __forceinline__ void gemm_phase(PG8_LAS unsigned char* lds, const Gemm g, const Sched& S, const Epi& E) {
    const int tid = threadIdx.x, wid = __builtin_amdgcn_readfirstlane(tid >> 6), lane = tid & 63, wr = wid >> 2, wc = wid & 3, fr = lane & 15, fq = lane >> 4;
    const int K = g.K, nt = K / BK;
    unsigned voffA[2], voffB[2];
#pragma unroll
    for (int i = 0; i < 2; ++i) { int R, C; stage_rc(tid * 16 + i * 8192, R, C); const int Rb = Epi::PERM ? ((R & ~31) + perm32(R & 31)) : R;
        voffA[i] = (unsigned)(R * K + C) * 2u; voffB[i] = (unsigned)(Rb * K + C) * 2u; }
    const size_t kstep = (size_t)(BK * 2);
    const size_t hstep = (size_t)HALF * K * 2;
    const size_t tstep = 2 * hstep;
    const unsigned ldsw = (unsigned)wid * 1024u;
    const int aoff = lds_byte(wr * 64 + fr, fq * 8), boff = lds_byte(wc * 32 + fr, fq * 8);
#define PG8_SA(b, h) (((b) * 2 + (h)) * HTB)
#define PG8_SB(b, h) ((4 + (b) * 2 + (h)) * HTB)
#define PG8_STAGE(bufoff, gbase, voff) do { _Pragma("unroll") for (int _i = 0; _i < 2; ++_i) \
        __builtin_amdgcn_global_load_lds((const unsigned*)((const char*)(gbase) + (voff)[_i]), (PG8_LAS unsigned*)(lds + (bufoff) + ldsw + _i * 8192), 16, 0, 0); } while (0)
#define PG8_LDA(dst, b, h) do { _Pragma("unroll") for (int m = 0; m < 4; ++m) _Pragma("unroll") for (int k = 0; k < 2; ++k) dst[m][k] = *(const PG8_LAS bf16x8*)(lds + PG8_SA(b, h) + aoff + m * 2048 + k * 1024); } while (0)
#define PG8_LDB(dst, b, h) do { _Pragma("unroll") for (int n = 0; n < 2; ++n) _Pragma("unroll") for (int k = 0; k < 2; ++k) dst[n][k] = *(const PG8_LAS bf16x8*)(lds + PG8_SB(b, h) + boff + n * 2048 + k * 1024); } while (0)
#define PG8_MMA(ai, bj, At, Bt) do { __builtin_amdgcn_s_setprio(1); _Pragma("unroll") for (int m = 0; m < 4; ++m) _Pragma("unroll") for (int n = 0; n < 2; ++n) _Pragma("unroll") for (int k = 0; k < 2; ++k) \
        acc[ai][bj][m][n] = __builtin_amdgcn_mfma_f32_16x16x32_bf16(Bt[n][k], At[m][k], acc[ai][bj][m][n], 0, 0, 0); __builtin_amdgcn_s_setprio(0); } while (0)
#define PG8_WAIT_V(n) asm volatile("s_waitcnt vmcnt(" #n ")" ::: "memory")
#define PG8_WAIT_L(n) asm volatile("s_waitcnt lgkmcnt(" #n ")" ::: "memory")
#define PG8_BAR __builtin_amdgcn_s_barrier()
#define PG8_SCHED __builtin_amdgcn_sched_barrier(0)
    Unit cur, nxt; int ui = 0;
    if (!S.next(0, cur)) return;
    f32x4 acc[2][2][4][2];
#pragma unroll
    for (int a = 0; a < 2; ++a)
#pragma unroll
        for (int b = 0; b < 2; ++b)
#pragma unroll
            for (int m = 0; m < 4; ++m)
#pragma unroll
                for (int n = 0; n < 2; ++n) acc[a][b][m][n] = (f32x4){0.f, 0.f, 0.f, 0.f};
    bf16x8 At[4][2], B0[2][2], B1[2][2];
    const char* cA = (const char*)g.A + (size_t)cur.pm * tstep; const char* cB = (const char*)g.Bt + (size_t)cur.pn * tstep;
    S.a_ready(cur);
    if constexpr (SP2) {
        PG8_STAGE(PG8_SB(0, 0), cB, voffB); PG8_STAGE(PG8_SB(0, 1), cB + hstep, voffB); PG8_STAGE(PG8_SA(0, 0), cA, voffA); PG8_STAGE(PG8_SA(0, 1), cA + hstep, voffA);
        if (wr == 1) PG8_BAR;
        PG8_WAIT_V(2); PG8_BAR;
        PG8_STAGE(PG8_SB(1, 0), cB + kstep, voffB); PG8_STAGE(PG8_SA(1, 0), cA + kstep, voffA); PG8_STAGE(PG8_SB(1, 1), cB + hstep + kstep, voffB);
        PG8_WAIT_V(6); PG8_BAR;
    } else {
        PG8_STAGE(PG8_SB(0, 0), cB, voffB); PG8_STAGE(PG8_SA(0, 0), cA, voffA); PG8_STAGE(PG8_SB(0, 1), cB + hstep, voffB); PG8_STAGE(PG8_SA(0, 1), cA + hstep, voffA);
        if (wr == 1) PG8_BAR;
        PG8_WAIT_V(4); PG8_BAR;
        PG8_STAGE(PG8_SB(1, 0), cB + kstep, voffB); PG8_STAGE(PG8_SA(1, 0), cA + kstep, voffA); PG8_STAGE(PG8_SB(1, 1), cB + hstep + kstep, voffB);
        PG8_WAIT_V(6); PG8_BAR;
    }
    for (;;) {
        const bool has_next = S.next(ui + 1, nxt);
        const char* nA = has_next ? (const char*)g.A + (size_t)nxt.pm * tstep : cA; const char* nB = has_next ? (const char*)g.Bt + (size_t)nxt.pn * tstep : cB;
        for (int t = 0; t < nt; t += 2) {
            const bool last = (t == nt - 2);
            const char* a1 = cA + (size_t)(t + 1) * kstep;
            const char* a2 = last ? nA : cA + (size_t)(t + 2) * kstep; const char* b2 = last ? nB : cB + (size_t)(t + 2) * kstep;
            const char* a3 = a2 + kstep; const char* b3 = b2 + kstep;
            if (last && has_next) S.a_ready(nxt);
            if constexpr (SP2) {
            PG8_LDB(B0, 0, 0); PG8_LDB(B1, 0, 1); PG8_SCHED; PG8_LDA(At, 0, 0); PG8_STAGE(PG8_SA(1, 1), a1 + hstep, voffA);
            PG8_WAIT_V(8); PG8_WAIT_L(0); PG8_BAR; PG8_MMA(0, 0, At, B0); PG8_MMA(0, 1, At, B1); PG8_BAR; PG8_SCHED;
            PG8_LDA(At, 0, 1); PG8_STAGE(PG8_SB(0, 0), b2, voffB); PG8_STAGE(PG8_SB(0, 1), b2 + hstep, voffB); PG8_STAGE(PG8_SA(0, 0), a2, voffA);
            PG8_WAIT_V(8); PG8_WAIT_L(0); PG8_BAR; PG8_MMA(1, 0, At, B0); PG8_MMA(1, 1, At, B1); PG8_BAR; PG8_SCHED;
            PG8_LDB(B0, 1, 0); PG8_LDB(B1, 1, 1); PG8_SCHED; PG8_LDA(At, 1, 0); PG8_STAGE(PG8_SA(0, 1), a2 + hstep, voffA);
            PG8_WAIT_V(8); PG8_WAIT_L(0); PG8_BAR; PG8_MMA(0, 0, At, B0); PG8_MMA(0, 1, At, B1); PG8_BAR; PG8_SCHED;
            PG8_LDA(At, 1, 1); PG8_STAGE(PG8_SB(1, 0), b3, voffB); PG8_STAGE(PG8_SB(1, 1), b3 + hstep, voffB); PG8_STAGE(PG8_SA(1, 0), a3, voffA);
            PG8_WAIT_V(8); PG8_WAIT_L(0); PG8_BAR; PG8_MMA(1, 0, At, B0); PG8_MMA(1, 1, At, B1); PG8_BAR; PG8_SCHED;
            } else {
            PG8_LDB(B0, 0, 0); PG8_SCHED; PG8_LDA(At, 0, 0); PG8_STAGE(PG8_SA(1, 1), a1 + hstep, voffA);
            PG8_WAIT_L(8); PG8_BAR; PG8_WAIT_L(0); PG8_MMA(0, 0, At, B0); PG8_BAR; PG8_SCHED;
            PG8_LDB(B1, 0, 1); PG8_STAGE(PG8_SB(0, 0), b2, voffB);
            PG8_BAR; PG8_WAIT_L(0); PG8_MMA(0, 1, At, B1); PG8_BAR;
            PG8_LDA(At, 0, 1); PG8_STAGE(PG8_SA(0, 0), a2, voffA);
            PG8_BAR; PG8_WAIT_L(0); PG8_MMA(1, 0, At, B0); PG8_BAR; PG8_SCHED;
            PG8_STAGE(PG8_SB(0, 1), b2 + hstep, voffB);
            PG8_WAIT_V(6); PG8_BAR; PG8_MMA(1, 1, At, B1); PG8_BAR;
            PG8_LDB(B0, 1, 0); PG8_SCHED; PG8_LDA(At, 1, 0); PG8_STAGE(PG8_SA(0, 1), a2 + hstep, voffA);
            PG8_WAIT_L(8); PG8_BAR; PG8_WAIT_L(0); PG8_MMA(0, 0, At, B0); PG8_BAR; PG8_SCHED;
            PG8_LDB(B1, 1, 1); PG8_STAGE(PG8_SB(1, 0), b3, voffB);
            PG8_BAR; PG8_WAIT_L(0); PG8_MMA(0, 1, At, B1); PG8_BAR;
            PG8_LDA(At, 1, 1); PG8_STAGE(PG8_SA(1, 0), a3, voffA);
            PG8_BAR; PG8_WAIT_L(0); PG8_MMA(1, 0, At, B0); PG8_BAR; PG8_SCHED;
            PG8_STAGE(PG8_SB(1, 1), b3 + hstep, voffB);
            PG8_WAIT_V(6); PG8_BAR; PG8_MMA(1, 1, At, B1); PG8_BAR;
            }
        }
        if constexpr (ALIGN_EPI) { if (wr == 0) PG8_BAR; }
        if constexpr (!Epi::AFTER_DRAIN) { E(acc, cur, wr, wc, fr, fq); S.done(cur); }
        if (!has_next) break;
#pragma unroll
        for (int a = 0; a < 2; ++a)
#pragma unroll
            for (int b = 0; b < 2; ++b)
#pragma unroll
                for (int m = 0; m < 4; ++m)
#pragma unroll
                    for (int n = 0; n < 2; ++n) acc[a][b][m][n] = (f32x4){0.f, 0.f, 0.f, 0.f};
        cur = nxt; cA = nA; cB = nB; ++ui;
        if constexpr (ALIGN_EPI) { if (wr == 1) PG8_BAR; }
    }
    PG8_WAIT_V(0);
    if constexpr (!ALIGN_EPI) { if (wr == 0) PG8_BAR; }
    PG8_BAR;
    if constexpr (Epi::AFTER_DRAIN) { E.fused(acc, cur, wr, wc, fr, fq, lds, wid, lane); S.done(cur); }
#undef PG8_SA
#undef PG8_SB
#undef PG8_STAGE
#undef PG8_LDA
#undef PG8_LDB
#undef PG8_MMA
#undef PG8_WAIT_V
#undef PG8_WAIT_L
#undef PG8_BAR
#undef PG8_SCHED
}
}
#define XB_TMO      128
#define XB_XCNT(j)  (256  + 64 * (j))
#define XB_XSUB(j)  (1280 + 64 * (j))
#define XB_XGEN(j)  (2304 + 64 * (j))
#define XB_TOP      3328
#define XB_TOPGEN   3392
#define XCD_BAR_WORDS 3456
#define XB_SPIN_CAP (1u << 18)
#define LAS __attribute__((address_space(3)))

__device__ __forceinline__ unsigned xb_ld(unsigned* p)              { return __hip_atomic_load(p, __ATOMIC_RELAXED, __HIP_MEMORY_SCOPE_AGENT); }
__device__ __forceinline__ unsigned xb_add(unsigned* p, unsigned v) { return __hip_atomic_fetch_add(p, v, __ATOMIC_RELAXED, __HIP_MEMORY_SCOPE_AGENT); }
__device__ __forceinline__ unsigned xb_xcc_id() { return (unsigned)__builtin_amdgcn_s_getreg((3 << 11) | 20) & 0xFu; }
#define XB_SPIN(cond, bar) do { unsigned _sp = 0; while (cond) { __builtin_amdgcn_s_sleep(1); \
    if ((++_sp & 255u) == 0u) { if (xb_ld(&(bar)[XB_TMO])) break; if (_sp > XB_SPIN_CAP) { atomicAdd(&(bar)[XB_TMO], 1u); break; } } } } while (0)

struct XcdBarrier {
    unsigned* bar; unsigned x;
    volatile LAS unsigned* st;
};

__device__ __forceinline__ XcdBarrier xcd_barrier_post(unsigned* bar, volatile LAS unsigned* st) {
    XcdBarrier b; b.bar = bar; b.x = xb_xcc_id(); b.st = st;
    if (threadIdx.x == 0) (void)xb_add(&bar[XB_XCNT(b.x)], 1u);
    return b;
}
__device__ __forceinline__ void xcd_barrier_complete(unsigned* bar, unsigned x, unsigned& nloc, unsigned& nx) {
    const unsigned G = gridDim.x * gridDim.y * gridDim.z;
    unsigned sum, cnt, mine, sp = 0u;
    for (;;) {
        sum = 0u; cnt = 0u; mine = 0u;
#pragma unroll
        for (unsigned j = 0; j < 16; ++j) { const unsigned c = xb_ld(&bar[XB_XCNT(j)]); sum += c; cnt += (c > 0u) ? 1u : 0u; mine = (j == x) ? c : mine; }
        if (sum == G) break;
        __builtin_amdgcn_s_sleep(1);
        if ((++sp & 255u) == 0u) { if (xb_ld(&bar[XB_TMO])) break; if (sp > XB_SPIN_CAP) { atomicAdd(&bar[XB_TMO], 1u); break; } }
    }
    nloc = mine > 0u ? mine : 1u; nx = cnt > 0u ? cnt : 1u;
}

__device__ __forceinline__ void xcd_barrier(const XcdBarrier& b) {
    asm volatile("s_waitcnt vmcnt(0)" ::: "memory");
    __syncthreads();
    if (threadIdx.x == 0) {
        unsigned* bar = b.bar;
        __builtin_amdgcn_s_waitcnt(0);
        unsigned nloc = b.st[0], nx = b.st[1];
        if (nloc == 0u) { xcd_barrier_complete(bar, b.x, nloc, nx); b.st[0] = nloc; b.st[1] = nx; }
        const unsigned old = xb_add(&bar[XB_XSUB(b.x)], 1u);
        const unsigned gen = old / nloc;
        if (old + 1u == (gen + 1u) * nloc) {
            __builtin_amdgcn_fence(__ATOMIC_RELEASE, "agent");
            asm volatile("s_waitcnt vmcnt(0)" ::: "memory");
            const unsigned og = xb_add(&bar[XB_TOP], 1u);
            const unsigned tg = og / nx;
            if (og + 1u == (tg + 1u) * nx) xb_add(&bar[XB_TOPGEN], 1u);
            else XB_SPIN(xb_ld(&bar[XB_TOPGEN]) == tg, bar);
            __builtin_amdgcn_fence(__ATOMIC_ACQUIRE, "agent");
            xb_add(&bar[XB_XGEN(b.x)], 1u);
            asm volatile("s_waitcnt vmcnt(0)" ::: "memory");
        } else {
            XB_SPIN(xb_ld(&bar[XB_XGEN(b.x)]) == gen, bar);
            __builtin_amdgcn_fence(__ATOMIC_ACQUIRE, "agent");
            asm volatile("s_waitcnt vmcnt(0)" ::: "memory");
        }
    }
    __syncthreads();
}

constexpr int D = 1024, BATCH = 8, SEQ = 2048, NMETA = 16, LTOT = SEQ + NMETA;
constexpr int NREAL = BATCH * SEQ;
constexpr int MROWS = 16640;
constexpr int NROWS_D = NREAL + BATCH * NMETA;
constexpr int IN_W = 12320;
constexpr int RH = 4, RDK = 256, RDV = 512;
constexpr int DH = 8, DDK = 128, DDV = 128;
constexpr int NEXP = 16384, PH = 8, PK = 16;
constexpr int WT_ROWS = 12544, WT_A0 = 0, WT_A_N = 4096, WT_B0 = 4096, WT_B_N = 3328, WT_C0 = 7424, WT_C_N = 5120;
constexpr float LN_EPS = 1e-5f, RMS_EPS = 1e-6f;
constexpr float DN_ALPHA = 1.189207115f;

constexpr size_t MiB = 1u << 20;
constexpr size_t WS_CTL = 0, CTL_ZERO_BYTES = 1 * MiB;
constexpr size_t WS_HB = 1 * MiB;
constexpr size_t WS_WT = WS_HB + (size_t)MROWS * D * 2;
constexpr size_t WS_AR = 58 * MiB;
constexpr size_t WS_END = 264 * MiB;
static_assert(WS_WT + (size_t)WT_ROWS * D * 2 <= WS_AR, "map");
constexpr size_t AR_QKVR = WS_AR;
constexpr size_t AR_RAWD = WS_AR;
constexpr size_t AR_GBETA = WS_AR + 97 * MiB + 512 * 1024;
constexpr size_t AR_QKVD = WS_AR + 100 * MiB;
constexpr size_t AR_OD = WS_AR;
constexpr size_t AR_GRG = WS_AR + 32 * MiB, AR_GDZ = WS_AR + 96 * MiB, AR_GGA = WS_AR + 128 * MiB, AR_GGB = WS_AR + 160 * MiB;
constexpr size_t AR_PRETT = WS_AR + 192 * MiB, AR_PDNT = WS_AR + 196 * MiB, AR_WOUTT = WS_AR + 198 * MiB, AR_W2T = WS_AR + 200 * MiB;
constexpr size_t AR_M1 = WS_AR + 32 * MiB, AR_MERGED = WS_AR + 64 * MiB, AR_PRE = WS_AR + 96 * MiB;
constexpr size_t AR_H1 = WS_AR;
constexpr size_t WS_UB = 1 * MiB, AR_VB = WS_AR + 160 * MiB;
constexpr size_t AR_SCORES = WS_AR + 32 * MiB;
constexpr size_t WS_EXP = WS_WT, WS_GATE = WS_WT + 8 * MiB;
static_assert(AR_QKVD + (size_t)NROWS_D * 3072 * 2 <= WS_END && AR_W2T + 4 * MiB <= WS_END && AR_GBETA + (size_t)MROWS * 32 * 4 <= AR_QKVD, "map");
constexpr int CW_BAR = 4096;

constexpr int RING_BYTES = 131072, MISC_OFF = RING_BYTES + 320, LDS_BYTES = 147456;
constexpr int NWAVES = 8, NTHREADS = 512;

#define GAS __attribute__((address_space(1)))
#define LAS __attribute__((address_space(3)))
typedef unsigned short bf16;
typedef unsigned v4u __attribute__((ext_vector_type(4)));
typedef unsigned v2u __attribute__((ext_vector_type(2)));
typedef float f32x4 __attribute__((ext_vector_type(4)));
#define RLX_AGENT __ATOMIC_RELAXED, __HIP_MEMORY_SCOPE_AGENT

__device__ __forceinline__ unsigned f2bf(float f) { unsigned u = __builtin_bit_cast(unsigned, f); return (u + 0x7fffu + ((u >> 16) & 1u)) >> 16; }
__device__ __forceinline__ unsigned pk2(float lo, float hi) { return f2bf(lo) | (f2bf(hi) << 16); }
__device__ __forceinline__ float bflo(unsigned u) { return __builtin_bit_cast(float, u << 16); }
__device__ __forceinline__ float bfhi(unsigned u) { return __builtin_bit_cast(float, u & 0xffff0000u); }
__device__ __forceinline__ float bf2f(bf16 h) { return __builtin_bit_cast(float, ((unsigned)h) << 16); }
__device__ __forceinline__ float sigmoidf_(float x) { return 1.0f / (1.0f + __expf(-x)); }
__device__ __forceinline__ float siluf_(float x) { return x / (1.0f + __expf(-x)); }
__device__ __forceinline__ float wave_sum(float v) {
#pragma unroll
    for (int o = 1; o < 64; o <<= 1) v += __shfl_xor(v, o);
    return v;
}
__device__ __forceinline__ int row_of(int b, int p) { return p < NMETA ? NREAL + p : b * SEQ + (p - NMETA); }
__device__ __forceinline__ int rowd_of(int b, int p) { return p < NMETA ? NREAL + b * NMETA + p : b * SEQ + (p - NMETA); }

struct Args {
    const float *x, *meta, *emb_g, *emb_b, *w_in, *ret_decay, *dn_conv, *dn_a_log, *dn_dt_bias, *dn_norm_g, *p_ret, *p_dn, *w_out, *ln1_g, *ln1_b,
                *peer_wq, *peer_keys, *peer_u, *peer_v, *ln2_g, *ln2_b;
    float* out; unsigned char* ws; int ph_lo, ph_hi;
};

struct Frame {
    LAS unsigned char* lds;
    int tid, lane, wave, G, gw, NGW;
};

namespace ep {
using pg8::f32x4; using pg8::Unit; using pg8::u32x4; using pg8::cvt_pk_bf16;
__device__ __forceinline__ u32x4 pack8(f32x4 a, f32x4 b) { u32x4 w; w.x = cvt_pk_bf16(a[0], a[1]); w.y = cvt_pk_bf16(a[2], a[3]); w.z = cvt_pk_bf16(b[0], b[1]); w.w = cvt_pk_bf16(b[2], b[3]); return w; }
__device__ __forceinline__ void unpack8(u32x4 w, f32x4& a, f32x4& b) { a = (f32x4){bflo(w.x), bfhi(w.x), bflo(w.y), bfhi(w.y)}; b = (f32x4){bflo(w.z), bfhi(w.z), bflo(w.w), bfhi(w.w)}; }

struct EpiRot {
    static constexpr bool PERM = true, AFTER_DRAIN = false;
    bf16* O;
    __device__ __forceinline__ void operator()(const f32x4 (&acc)[2][2][4][2], const Unit& u, int wr, int wc, int fr, int fq) const {
        const int row0 = u.pm * 256 + wr * 64 + fr, colb = wc * 32 + 8 * fq;
        if (u.pn < 8) {
            const float sc = (u.pn >= 4) ? 0.0625f : 1.0f;
            float rev[8];
#pragma unroll
            for (int e = 0; e < 8; ++e) rev[e] = exp2f(-(float)(colb + e) * (13.287712379549449f / 128.0f)) * 0.15915494309189535f;
#pragma unroll
            for (int ai = 0; ai < 2; ++ai)
#pragma unroll
                for (int m = 0; m < 4; ++m) {
                    const int r = row0 + ai * 128 + m * 16;
                    const float pos = (float)(r < NREAL ? (r & (SEQ - 1)) + NMETA : r - NREAL);
                    f32x4 o1[2], o2[2];
#pragma unroll
                    for (int n = 0; n < 2; ++n)
#pragma unroll
                        for (int e = 0; e < 4; ++e) {
                            float t = pos * rev[n * 4 + e]; t = t - floorf(t);
                            const float s = __builtin_amdgcn_sinf(t), c = __builtin_amdgcn_cosf(t);
                            const float x1 = acc[ai][0][m][n][e], x2 = acc[ai][1][m][n][e];
                            o1[n][e] = (x1 * c - x2 * s) * sc; o2[n][e] = (x1 * s + x2 * c) * sc;
                        }
                    bf16* rowp = O + (size_t)r * 4096 + u.pn * 256 + colb;
                    *(u32x4*)(rowp) = pack8(o1[0], o1[1]);
                    *(u32x4*)(rowp + 128) = pack8(o2[0], o2[1]);
                }
        } else {
#pragma unroll
            for (int ai = 0; ai < 2; ++ai)
#pragma unroll
                for (int m = 0; m < 4; ++m) {
                    bf16* rowp = O + (size_t)(row0 + ai * 128 + m * 16) * 4096 + u.pn * 256 + colb;
#pragma unroll
                    for (int bj = 0; bj < 2; ++bj) *(u32x4*)(rowp + bj * 128) = pack8(acc[ai][bj][m][0], acc[ai][bj][m][1]);
                }
        }
    }
};
struct EpiDn {
    static constexpr bool PERM = true, AFTER_DRAIN = false;
    bf16* O; float* GB; const float* a_log; const float* dt_bias;
    __device__ __forceinline__ void operator()(const f32x4 (&acc)[2][2][4][2], const Unit& u, int wr, int wc, int fr, int fq) const {
        const int row0 = u.pm * 256 + wr * 64 + fr, colb = wc * 32 + 8 * fq;
        if (u.pn < 12) {
#pragma unroll
            for (int ai = 0; ai < 2; ++ai)
#pragma unroll
                for (int m = 0; m < 4; ++m) {
                    bf16* rowp = O + (size_t)(row0 + ai * 128 + m * 16) * 3072 + u.pn * 256 + colb;
#pragma unroll
                    for (int bj = 0; bj < 2; ++bj) *(u32x4*)(rowp + bj * 128) = pack8(acc[ai][bj][m][0], acc[ai][bj][m][1]);
                }
        } else if (wc == 0) {
            float ea[8], db[8];
#pragma unroll
            for (int e = 0; e < 8; ++e) { const int c = (colb + e) & 15; ea[e] = -__expf(a_log[c]); db[e] = dt_bias[c]; }
#pragma unroll
            for (int ai = 0; ai < 2; ++ai)
#pragma unroll
                for (int m = 0; m < 4; ++m) {
                    float* rowp = GB + (size_t)(row0 + ai * 128 + m * 16) * 32 + colb;
                    f32x4 o[2];
#pragma unroll
                    for (int n = 0; n < 2; ++n)
#pragma unroll
                        for (int e = 0; e < 4; ++e) {
                            const float v = acc[ai][0][m][n][e];
                            if (colb < 16) { const float z = v + db[n * 4 + e]; const float sp = z > 20.f ? z : log1pf(__expf(z)); o[n][e] = ea[n * 4 + e] * sp; }
                            else o[n][e] = sigmoidf_(v);
                        }
                    *(f32x4*)(rowp) = o[0]; *(f32x4*)(rowp + 4) = o[1];
                }
        }
    }
};
struct EpiGates {
    static constexpr bool PERM = true, AFTER_DRAIN = false;
    bf16 *rg, *dz, *ga, *gb;
    __device__ __forceinline__ void operator()(const f32x4 (&acc)[2][2][4][2], const Unit& u, int wr, int wc, int fr, int fq) const {
        const int row0 = u.pm * 256 + wr * 64 + fr, colb = wc * 32 + 8 * fq;
        bf16* base; int ld, ct;
        if (u.pn < 8) { base = rg; ld = 2048; ct = u.pn; } else if (u.pn < 12) { base = dz; ld = 1024; ct = u.pn - 8; } else if (u.pn < 16) { base = ga; ld = 1024; ct = u.pn - 12; } else { base = gb; ld = 1024; ct = u.pn - 16; }
#pragma unroll
        for (int ai = 0; ai < 2; ++ai)
#pragma unroll
            for (int m = 0; m < 4; ++m) {
                bf16* rowp = base + (size_t)(row0 + ai * 128 + m * 16) * ld + ct * 256 + colb;
#pragma unroll
                for (int bj = 0; bj < 2; ++bj) *(u32x4*)(rowp + bj * 128) = pack8(acc[ai][bj][m][0], acc[ai][bj][m][1]);
            }
    }
};
template <bool ADD> struct EpiMerge {
    static constexpr bool PERM = true, AFTER_DRAIN = false;
    const bf16* gate; const bf16* prev; bf16* O;
    __device__ __forceinline__ void operator()(const f32x4 (&acc)[2][2][4][2], const Unit& u, int wr, int wc, int fr, int fq) const {
        const int row0 = u.pm * 256 + wr * 64 + fr, colb = u.pn * 256 + wc * 32 + 8 * fq;
#pragma unroll
        for (int ai = 0; ai < 2; ++ai)
#pragma unroll
            for (int m = 0; m < 4; ++m) {
                const size_t off = (size_t)(row0 + ai * 128 + m * 16) * 1024 + colb;
#pragma unroll
                for (int bj = 0; bj < 2; ++bj) {
                    f32x4 g0, g1; unpack8(*(const u32x4*)(gate + off + bj * 128), g0, g1);
                    f32x4 o0, o1;
#pragma unroll
                    for (int e = 0; e < 4; ++e) { o0[e] = sigmoidf_(g0[e]) * acc[ai][bj][m][0][e]; o1[e] = sigmoidf_(g1[e]) * acc[ai][bj][m][1][e]; }
                    if (ADD) { f32x4 p0, p1; unpack8(*(const u32x4*)(prev + off + bj * 128), p0, p1); o0 += p0; o1 += p1; }
                    *(u32x4*)(O + off + bj * 128) = pack8(o0, o1);
                }
            }
    }
};
struct EpiRes {
    static constexpr bool PERM = true, AFTER_DRAIN = false;
    const bf16* H; float* O;
    __device__ __forceinline__ void operator()(const f32x4 (&acc)[2][2][4][2], const Unit& u, int wr, int wc, int fr, int fq) const {
        const int row0 = u.pm * 256 + wr * 64 + fr, colb = u.pn * 256 + wc * 32 + 8 * fq;
#pragma unroll
        for (int ai = 0; ai < 2; ++ai)
#pragma unroll
            for (int m = 0; m < 4; ++m) {
                const size_t off = (size_t)(row0 + ai * 128 + m * 16) * 1024 + colb;
#pragma unroll
                for (int bj = 0; bj < 2; ++bj) {
                    f32x4 h0, h1; unpack8(*(const u32x4*)(H + off + bj * 128), h0, h1);
                    *(f32x4*)(O + off + bj * 128) = h0 * DN_ALPHA + acc[ai][bj][m][0];
                    *(f32x4*)(O + off + bj * 128 + 4) = h1 * DN_ALPHA + acc[ai][bj][m][1];
                }
            }
    }
};
struct EpiF32 {
    static constexpr bool PERM = true, AFTER_DRAIN = false;
    float* O; int ld;
    __device__ __forceinline__ void operator()(const f32x4 (&acc)[2][2][4][2], const Unit& u, int wr, int wc, int fr, int fq) const {
        const int row0 = u.pm * 256 + wr * 64 + fr, colb = u.pn * 256 + wc * 32 + 8 * fq;
#pragma unroll
        for (int ai = 0; ai < 2; ++ai)
#pragma unroll
            for (int m = 0; m < 4; ++m) {
                float* rowp = O + (size_t)(row0 + ai * 128 + m * 16) * ld + colb;
#pragma unroll
                for (int bj = 0; bj < 2; ++bj) { *(f32x4*)(rowp + bj * 128) = acc[ai][bj][m][0]; *(f32x4*)(rowp + bj * 128 + 4) = acc[ai][bj][m][1]; }
            }
    }
};
}

__device__ __forceinline__ void transpose_item(const float* W, int ldsrc, int K, bf16* WT, int k0, int srcn0, int dstn0, LAS float* scr, int lane) {
    if (srcn0 >= 0) {
#pragma unroll 8
        for (int i = 0; i < 32; ++i) { const int kk = 2 * i + (lane >> 5); scr[kk * 33 + (lane & 31)] = W[(size_t)(k0 + kk) * ldsrc + srcn0 + (lane & 31)]; }
    } else {
#pragma unroll 8
        for (int i = 0; i < 32; ++i) { const int kk = 2 * i + (lane >> 5); scr[kk * 33 + (lane & 31)] = 0.f; }
    }
    asm volatile("s_waitcnt lgkmcnt(0)" ::: "memory");
    const int c = lane & 7;
#pragma unroll
    for (int j = 0; j < 4; ++j) { const int n = (lane >> 3) + 8 * j; const LAS float* s = scr + (8 * c) * 33 + n;
        v4u o; o.x = pk2(s[0 * 33], s[1 * 33]); o.y = pk2(s[2 * 33], s[3 * 33]); o.z = pk2(s[4 * 33], s[5 * 33]); o.w = pk2(s[6 * 33], s[7 * 33]);
        *(v4u*)(WT + (size_t)(dstn0 + n) * K + k0 + 8 * c) = o; }
    asm volatile("s_waitcnt lgkmcnt(0)" ::: "memory");
}
__device__ __forceinline__ int wt_src_col(int n0) {
    if (n0 < 4096) return n0;
    if (n0 < 7168) return n0 - 4096 + 6144;
    if (n0 < 7200) return n0 - 7168 + 10240;
    if (n0 < 7424) return -1;
    if (n0 < 9472) return n0 - 7424 + 4096;
    if (n0 < 10496) return n0 - 9472 + 9216;
    if (n0 < 11520) return n0 - 10496 + 10272;
    return n0 - 11520 + 11296;
}
__device__ __forceinline__ void ln_row_affine_bf16(const float* xrow, const float* g, const float* bb, bf16* orow, int lane) {
    const f32x4* xr = (const f32x4*)xrow + lane;
    f32x4 v[4]; float s = 0.f;
#pragma unroll
    for (int j = 0; j < 4; ++j) { v[j] = xr[64 * j]; s += (v[j][0] + v[j][1]) + (v[j][2] + v[j][3]); }
    const float mean = wave_sum(s) * (1.f / D); float s2 = 0.f;
#pragma unroll
    for (int j = 0; j < 4; ++j) { v[j] = v[j] - mean; s2 += (v[j][0] * v[j][0] + v[j][1] * v[j][1]) + (v[j][2] * v[j][2] + v[j][3] * v[j][3]); }
    const float rstd = 1.f / sqrtf(wave_sum(s2) * (1.f / D) + LN_EPS);
    v2u* o8 = (v2u*)orow + lane;
#pragma unroll
    for (int j = 0; j < 4; ++j) { const f32x4 gg = ((const f32x4*)g)[lane + 64 * j], b4 = ((const f32x4*)bb)[lane + 64 * j]; const f32x4 y = v[j] * rstd * gg + b4;
        v2u w; w.x = pk2(y[0], y[1]); w.y = pk2(y[2], y[3]); o8[64 * j] = w; }
}

__device__ __forceinline__ void p0_prologue(const Args& a, Frame& F) {
    LAS float* scr = (LAS float*)(F.lds + F.wave * 16384);
    bf16* HB = (bf16*)(a.ws + WS_HB); bf16* WT = (bf16*)(a.ws + WS_WT);
    constexpr int NB = WT_ROWS / 32, NITEMS = NB * (D / 64);
    for (int it = F.gw; it < NITEMS; it += F.NGW) { const int nb = it % NB, kb = it / NB; transpose_item(a.w_in, IN_W, D, WT, 64 * kb, wt_src_col(32 * nb), 32 * nb, scr, F.lane); }
    for (int r = F.gw; r < MROWS; r += F.NGW) {
        bf16* orow = HB + (size_t)r * D;
        if (r < NREAL) ln_row_affine_bf16(a.x + (size_t)r * D, a.emb_g, a.emb_b, orow, F.lane);
        else if (r < NREAL + NMETA) ln_row_affine_bf16(a.meta + (size_t)(r - NREAL) * D, a.emb_g, a.emb_b, orow, F.lane);
        else { v2u z; z.x = 0u; z.y = 0u; v2u* o8 = (v2u*)orow + F.lane;
#pragma unroll
            for (int j = 0; j < 4; ++j) o8[64 * j] = z; }
    }
}

__device__ __forceinline__ void p2_scan_ret_simple(const Args& a, Frame& F) {
    const bf16* QKV = (const bf16*)(a.ws + AR_QKVR); bf16* OR = (bf16*)a.out;
    constexpr int TG = 8;
    LAS bf16* qt = (LAS bf16*)F.lds; LAS bf16* kt = qt + TG * 256; LAS bf16* vt = kt + TG * 256;
    const int col = 16 * F.wave + (F.lane >> 2), qtr = F.lane & 3;
    for (int u = blockIdx.x; u < BATCH * RH * 4; u += F.G) {
        const int b = u >> 4, h = (u >> 2) & 3, dvb = u & 3;
        for (int pass = 0; pass < 2; ++pass) {
            const int dir = 1 - pass;
            const float gamma = sigmoidf_(a.ret_decay[dir * RH + h]);
            float S[64];
#pragma unroll
            for (int j = 0; j < 64; ++j) S[j] = 0.f;
            const int ntok = dir ? SEQ : LTOT;
            for (int t0 = 0; t0 < ntok; t0 += TG) {
                __syncthreads();
                for (int c = F.tid; c < TG * 80; c += NTHREADS) {
                    const int i = c / 80, w = c % 80; const int t = t0 + i, p = dir ? (LTOT - 1 - t) : t; const size_t rb = (size_t)row_of(b, p) * 4096;
                    if (w < 32) *(LAS v4u*)(qt + i * 256 + w * 8) = *(const v4u*)(QKV + rb + h * 256 + w * 8);
                    else if (w < 64) *(LAS v4u*)(kt + i * 256 + (w - 32) * 8) = *(const v4u*)(QKV + rb + 1024 + h * 256 + (w - 32) * 8);
                    else *(LAS v4u*)(vt + i * 128 + (w - 64) * 8) = *(const v4u*)(QKV + rb + 2048 + h * 512 + dvb * 128 + (w - 64) * 8);
                }
                __syncthreads();
                for (int i = 0; i < TG; ++i) {
                    const float v = bf2f(vt[i * 128 + col]);
                    float o = 0.f;
#pragma unroll
                    for (int j8 = 0; j8 < 8; ++j8) {
                        const v4u kw = *(const LAS v4u*)(kt + i * 256 + qtr * 64 + j8 * 8), qw = *(const LAS v4u*)(qt + i * 256 + qtr * 64 + j8 * 8);
                        const float kk[8] = {bflo(kw.x), bfhi(kw.x), bflo(kw.y), bfhi(kw.y), bflo(kw.z), bfhi(kw.z), bflo(kw.w), bfhi(kw.w)};
                        const float qq[8] = {bflo(qw.x), bfhi(qw.x), bflo(qw.y), bfhi(qw.y), bflo(qw.z), bfhi(qw.z), bflo(qw.w), bfhi(qw.w)};
#pragma unroll
                        for (int e = 0; e < 8; ++e) {
                            float s = S[j8 * 8 + e] * gamma;
                            if (dir == 0) { s += kk[e] * v; o += qq[e] * s; } else { o += qq[e] * s; s += kk[e] * v; }
                            S[j8 * 8 + e] = s;
                        }
                    }
                    o += __shfl_xor(o, 1); o += __shfl_xor(o, 2);
                    const float o2 = __shfl_down(o, 4);
                    const int t = t0 + i, p = dir ? (LTOT - 1 - t) : t;
                    if ((F.lane & 7) == 0 && p >= NMETA) {
                        unsigned* dst = (unsigned*)(OR + (size_t)(b * SEQ + p - NMETA) * 2048 + h * 512 + dvb * 128 + col);
                        float r0 = o, r1 = o2;
                        if (pass == 1) { const unsigned old = __hip_atomic_load(dst, RLX_AGENT); r0 += bflo(old); r1 += bfhi(old); }
                        *dst = pk2(r0, r1);
                    }
                }
            }
        }
    }
}

__device__ __forceinline__ void p4_conv(const Args& a, Frame& F) {
    const bf16* RAW = (const bf16*)(a.ws + AR_RAWD); bf16* QD = (bf16*)(a.ws + AR_QKVD);
    constexpr int NSEG = 65;
    for (int it = F.gw; it < BATCH * 24 * NSEG; it += F.NGW) {
        const int seg = it % NSEG, bs = it / NSEG, slab = bs % 24, b = bs / 24;
        const int p0 = seg * 32, ch = slab * 128 + 2 * F.lane;
        unsigned raw[36];
#pragma unroll
        for (int k = 0; k < 36; ++k) { const int pp = p0 - 2 + k; raw[k] = (pp >= 0 && pp < LTOT) ? *(const unsigned*)(RAW + (size_t)row_of(b, pp) * 3072 + ch) : 0u; }
        float w0[5], w1[5];
#pragma unroll
        for (int j = 0; j < 5; ++j) { const float2 cw = *(const float2*)(a.dn_conv + j * 3072 + ch); w0[j] = cw.x; w1[j] = cw.y; }
        const float qsc = (slab < 8) ? 0.08838834764831845f : 1.0f;
#pragma unroll
        for (int t = 0; t < 32; ++t) {
            float y0 = 0.f, y1 = 0.f;
#pragma unroll
            for (int j = 0; j < 5; ++j) { y0 += w0[j] * bflo(raw[t + j]); y1 += w1[j] * bfhi(raw[t + j]); }
            y0 = siluf_(y0); y1 = siluf_(y1);
            if (slab < 16) { const float ss = wave_sum(y0 * y0 + y1 * y1); const float sc = qsc / sqrtf(ss + RMS_EPS); y0 *= sc; y1 *= sc; }
            const int p = p0 + t;
            if (p < LTOT) *(unsigned*)(QD + (size_t)rowd_of(b, p) * 3072 + ch) = pk2(y0, y1);
        }
    }
}

__device__ __forceinline__ void p5_scan_dn_simple(const Args& a, Frame& F) {
    const bf16* QD = (const bf16*)(a.ws + AR_QKVD); const float* GB = (const float*)(a.ws + AR_GBETA); bf16* OD = (bf16*)(a.ws + AR_OD);
    constexpr int TG = 8;
    LAS bf16* qt = (LAS bf16*)F.lds; LAS bf16* kt = qt + TG * 128; LAS bf16* vt = kt + TG * 128; LAS float* gt = (LAS float*)(vt + TG * 64); LAS float* bt = gt + TG;
    const int cl = 8 * F.wave + (F.lane >> 3), sub = F.lane & 7;
    for (int u = blockIdx.x; u < BATCH * DH * 2; u += F.G) {
        const int b = u >> 4, h = (u >> 1) & 7, dvh = u & 1;
        for (int pass = 0; pass < 2; ++pass) {
            const int dir = 1 - pass;
            float S[16];
#pragma unroll
            for (int j = 0; j < 16; ++j) S[j] = 0.f;
            const int ntok = dir ? SEQ : LTOT;
            for (int t0 = 0; t0 < ntok; t0 += TG) {
                __syncthreads();
                for (int c = F.tid; c < TG * 40; c += NTHREADS) {
                    const int i = c / 40, w = c % 40; const int t = t0 + i, p = dir ? (LTOT - 1 - t) : t; const size_t rb = (size_t)rowd_of(b, p) * 3072;
                    if (w < 16) *(LAS v4u*)(qt + i * 128 + w * 8) = *(const v4u*)(QD + rb + h * 128 + w * 8);
                    else if (w < 32) *(LAS v4u*)(kt + i * 128 + (w - 16) * 8) = *(const v4u*)(QD + rb + 1024 + h * 128 + (w - 16) * 8);
                    else *(LAS v4u*)(vt + i * 64 + (w - 32) * 8) = *(const v4u*)(QD + rb + 2048 + h * 128 + dvh * 64 + (w - 32) * 8);
                }
                if (F.tid < TG) { const int t = t0 + F.tid, p = dir ? (LTOT - 1 - t) : t; const size_t rg = (size_t)row_of(b, p) * 32;
                    gt[F.tid] = GB[rg + dir * 8 + h]; bt[F.tid] = GB[rg + 16 + dir * 8 + h]; }
                __syncthreads();
                for (int i = 0; i < TG; ++i) {
                    const float v = bf2f(vt[i * 64 + cl]);
                    const float ag = __expf(gt[i]), beta = bt[i];
                    const v4u kw0 = *(const LAS v4u*)(kt + i * 128 + sub * 16), kw1 = *(const LAS v4u*)(kt + i * 128 + sub * 16 + 8);
                    const v4u qw0 = *(const LAS v4u*)(qt + i * 128 + sub * 16), qw1 = *(const LAS v4u*)(qt + i * 128 + sub * 16 + 8);
                    const float kk[16] = {bflo(kw0.x), bfhi(kw0.x), bflo(kw0.y), bfhi(kw0.y), bflo(kw0.z), bfhi(kw0.z), bflo(kw0.w), bfhi(kw0.w),
                                          bflo(kw1.x), bfhi(kw1.x), bflo(kw1.y), bfhi(kw1.y), bflo(kw1.z), bfhi(kw1.z), bflo(kw1.w), bfhi(kw1.w)};
                    const float qq[16] = {bflo(qw0.x), bfhi(qw0.x), bflo(qw0.y), bfhi(qw0.y), bflo(qw0.z), bfhi(qw0.z), bflo(qw0.w), bfhi(qw0.w),
                                          bflo(qw1.x), bfhi(qw1.x), bflo(qw1.y), bfhi(qw1.y), bflo(qw1.z), bfhi(qw1.z), bflo(qw1.w), bfhi(qw1.w)};
                    float r = 0.f;
#pragma unroll
                    for (int j = 0; j < 16; ++j) r += S[j] * kk[j];
                    r += __shfl_xor(r, 1); r += __shfl_xor(r, 2); r += __shfl_xor(r, 4);
                    const float vn = beta * (v - ag * r);
                    float o = 0.f;
#pragma unroll
                    for (int j = 0; j < 16; ++j) { S[j] = ag * S[j] + kk[j] * vn; o += S[j] * qq[j]; }
                    o += __shfl_xor(o, 1); o += __shfl_xor(o, 2); o += __shfl_xor(o, 4);
                    const float o2 = __shfl_down(o, 8);
                    const int t = t0 + i, p = dir ? (LTOT - 1 - t) : t;
                    if ((F.lane & 15) == 0 && p >= NMETA) {
                        unsigned* dst = (unsigned*)(OD + (size_t)(b * SEQ + p - NMETA) * 1024 + h * 128 + dvh * 64 + cl);
                        float r0 = o, r1 = o2;
                        if (pass == 1) { const unsigned old = __hip_atomic_load(dst, RLX_AGENT); r0 += bflo(old); r1 += bfhi(old); }
                        *dst = pk2(r0, r1);
                    }
                }
            }
        }
    }
}

__device__ __forceinline__ void p6_small_weights(const Args& a, Frame& F) {
    LAS float* scr = (LAS float*)(F.lds + F.wave * 16384);
    bf16* PRT = (bf16*)(a.ws + AR_PRETT); bf16* PDT = (bf16*)(a.ws + AR_PDNT); bf16* WOT = (bf16*)(a.ws + AR_WOUTT); bf16* W2T = (bf16*)(a.ws + AR_W2T);
    constexpr int I_PR = (2048 / 64) * (1024 / 32), I_PD = (1024 / 64) * (1024 / 32), I_WO = I_PD;
    for (int it = F.gw; it < I_PR + I_PD + I_WO; it += F.NGW) {
        int r = it;
        if (r < I_PR) { transpose_item(a.p_ret, 1024, 2048, PRT, 64 * (r / 32), 32 * (r % 32), 32 * (r % 32), scr, F.lane); continue; } r -= I_PR;
        if (r < I_PD) { transpose_item(a.p_dn, 1024, 1024, PDT, 64 * (r / 32), 32 * (r % 32), 32 * (r % 32), scr, F.lane); continue; } r -= I_PD;
        transpose_item(a.w_out, 1024, 1024, WOT, 64 * (r / 32), 32 * (r % 32), 32 * (r % 32), scr, F.lane);
    }
    for (int it = F.gw; it < 128 * 16; it += F.NGW) {
        const int nt = it >> 4, ks = it & 15, hp = nt >> 3, lane = F.lane, g = lane >> 4, l15 = lane & 15;
        typedef short bfx8_ __attribute__((ext_vector_type(8)));
        bfx8_ kf[4];
#pragma unroll
        for (int sx = 0; sx < 4; ++sx) { const f32x4* p = (const f32x4*)(a.peer_keys + (size_t)(nt * 16 + l15) * 128 + 32 * sx + 8 * g); const f32x4 x = p[0], y = p[1];
            const v4u w = {pk2(x[0], x[1]), pk2(x[2], x[3]), pk2(y[0], y[1]), pk2(y[2], y[3])}; kf[sx] = __builtin_bit_cast(bfx8_, w); }
#pragma unroll
        for (int kt = 0; kt < 4; ++kt) {
            const int k0 = ks * 64 + kt * 16;
            f32x4 acc = (f32x4){0.f, 0.f, 0.f, 0.f};
#pragma unroll
            for (int sx = 0; sx < 4; ++sx) { const f32x4* p = (const f32x4*)(a.peer_wq + (size_t)(k0 + l15) * 2048 + hp * 128 + 32 * sx + 8 * g); const f32x4 x = p[0], y = p[1];
                const v4u w = {pk2(x[0], x[1]), pk2(x[2], x[3]), pk2(y[0], y[1]), pk2(y[2], y[3])};
                acc = __builtin_amdgcn_mfma_f32_16x16x32_bf16(__builtin_bit_cast(bfx8_, w), kf[sx], acc, 0, 0, 0); }
            v2u o; o.x = pk2(acc[0], acc[1]); o.y = pk2(acc[2], acc[3]);
            *(v2u*)(W2T + (size_t)(nt * 16 + l15) * 1024 + k0 + 4 * g) = o;
        }
    }
}

__device__ __forceinline__ void p7_gate_norm(const Args& a, Frame& F) {
    bf16* OR = (bf16*)a.out; bf16* OD = (bf16*)(a.ws + AR_OD); const bf16* GRG = (const bf16*)(a.ws + AR_GRG); const bf16* GDZ = (const bf16*)(a.ws + AR_GDZ);
    for (int it = F.gw; it < NREAL * 5; it += F.NGW) {
        const int r = it / 5, part = it % 5;
        if (part < 4) {
            const size_t off = (size_t)r * 2048 + part * 512 + F.lane * 8;
            f32x4 v0, v1, g0, g1; ep::unpack8(*(const v4u*)(OR + off), v0, v1); ep::unpack8(*(const v4u*)(GRG + off), g0, g1);
            float s = (v0[0] + v0[1]) + (v0[2] + v0[3]) + (v1[0] + v1[1]) + (v1[2] + v1[3]);
            const float mean = wave_sum(s) * (1.f / 512.f);
            v0 = v0 - mean; v1 = v1 - mean;
            float s2 = (v0[0] * v0[0] + v0[1] * v0[1]) + (v0[2] * v0[2] + v0[3] * v0[3]) + (v1[0] * v1[0] + v1[1] * v1[1]) + (v1[2] * v1[2] + v1[3] * v1[3]);
            const float rstd = 1.f / sqrtf(wave_sum(s2) * (1.f / 512.f) + LN_EPS);
#pragma unroll
            for (int e = 0; e < 4; ++e) { v0[e] = v0[e] * rstd * siluf_(g0[e]); v1[e] = v1[e] * rstd * siluf_(g1[e]); }
            *(v4u*)(OR + off) = ep::pack8(v0, v1);
        } else {
#pragma unroll
            for (int hh = 0; hh < 2; ++hh) {
                const size_t off = (size_t)r * 1024 + hh * 512 + F.lane * 8;
                f32x4 v0, v1, g0, g1; ep::unpack8(*(const v4u*)(OD + off), v0, v1); ep::unpack8(*(const v4u*)(GDZ + off), g0, g1);
                float s2 = (v0[0] * v0[0] + v0[1] * v0[1]) + (v0[2] * v0[2] + v0[3] * v0[3]) + (v1[0] * v1[0] + v1[1] * v1[1]) + (v1[2] * v1[2] + v1[3] * v1[3]);
                s2 += __shfl_xor(s2, 1); s2 += __shfl_xor(s2, 2); s2 += __shfl_xor(s2, 4); s2 += __shfl_xor(s2, 8);
                const float rs = 1.f / sqrtf(s2 * (1.f / 128.f) + RMS_EPS);
                const int c = (F.lane & 15) * 8;
                const f32x4 n0 = *(const f32x4*)(a.dn_norm_g + c), n1 = *(const f32x4*)(a.dn_norm_g + c + 4);
#pragma unroll
                for (int e = 0; e < 4; ++e) { v0[e] = v0[e] * rs * n0[e] * siluf_(g0[e]); v1[e] = v1[e] * rs * n1[e] * siluf_(g1[e]); }
                *(v4u*)(OD + off) = ep::pack8(v0, v1);
            }
        }
    }
}

constexpr size_t WS_UB8 = 1 * MiB, WS_SCU = 17 * MiB, WS_SCV = 17 * MiB + 65536, AR_VB8 = WS_AR + 160 * MiB;
__device__ __forceinline__ void p11_ln1_tables(const Args& a, Frame& F) {
    const float* PRE = (const float*)(a.ws + AR_PRE); bf16* H1 = (bf16*)(a.ws + AR_H1);
    for (int r = F.gw; r < NREAL; r += F.NGW) ln_row_affine_bf16(PRE + (size_t)r * D, a.ln1_g, a.ln1_b, H1 + (size_t)r * D, F.lane);
    for (int r = F.gw; r < 2 * NEXP; r += F.NGW) {
        const bool second = r >= NEXP; const int e = second ? r - NEXP : r;
        const f32x4* src = (const f32x4*)((second ? a.peer_v : a.peer_u) + (size_t)e * D + F.lane * 16);
        f32x4 x[4]; float am = 0.f;
#pragma unroll
        for (int j = 0; j < 4; ++j) { x[j] = src[j]; am = fmaxf(am, fmaxf(fmaxf(fabsf(x[j][0]), fabsf(x[j][1])), fmaxf(fabsf(x[j][2]), fabsf(x[j][3])))); }
#pragma unroll
        for (int o = 1; o < 64; o <<= 1) am = fmaxf(am, __shfl_xor(am, o));
        int ex = 0; if (am > 0.f) (void)frexpf(am, &ex); else ex = 8;
        const float sc = ldexpf(1.0f, 8 - ex), isc = ldexpf(1.0f, ex - 8);
        v4u w;
#pragma unroll
        for (int j = 0; j < 4; ++j) { int q = __builtin_amdgcn_cvt_pk_fp8_f32(x[j][0] * sc, x[j][1] * sc, 0, false); q = __builtin_amdgcn_cvt_pk_fp8_f32(x[j][2] * sc, x[j][3] * sc, q, true); w[j] = (unsigned)q; }
        *(v4u*)(a.ws + (second ? AR_VB8 : WS_UB8) + (size_t)e * 1024 + F.lane * 16) = w;
        if (F.lane == 0) ((float*)(a.ws + (second ? WS_SCV : WS_SCU)))[e] = isc;
    }
}

__device__ __forceinline__ unsigned ord_key(float v) { const unsigned u = __builtin_bit_cast(unsigned, v); return (u & 0x80000000u) ? ~u : (u | 0x80000000u); }
__device__ __forceinline__ float ord_val(unsigned k) { const unsigned u = (k & 0x80000000u) ? (k & 0x7fffffffu) : ~k; return __builtin_bit_cast(float, u); }
#define DPP_ROR(x, n) ((unsigned)__builtin_amdgcn_update_dpp(0, (int)(x), 0x120 + (n), 0xf, 0xf, false))
__device__ __forceinline__ unsigned row16_max(unsigned m) { m = max(m, DPP_ROR(m, 1)); m = max(m, DPP_ROR(m, 2)); m = max(m, DPP_ROR(m, 4)); m = max(m, DPP_ROR(m, 8)); return m; }
__device__ __forceinline__ float row16_sum(float s) {
    s += __builtin_bit_cast(float, DPP_ROR(__builtin_bit_cast(unsigned, s), 1)); s += __builtin_bit_cast(float, DPP_ROR(__builtin_bit_cast(unsigned, s), 2));
    s += __builtin_bit_cast(float, DPP_ROR(__builtin_bit_cast(unsigned, s), 4)); s += __builtin_bit_cast(float, DPP_ROR(__builtin_bit_cast(unsigned, s), 8)); return s;
}
__device__ __forceinline__ void p13_topk(const Args& a, Frame& F) {
    const float* SC = (const float*)(a.ws + AR_SCORES); int* EXP = (int*)(a.ws + WS_EXP); float* GATE = (float*)(a.ws + WS_GATE);
    LAS float* tops = (LAS float*)(F.lds + F.wave * 2048); LAS int* topi = (LAS int*)(F.lds + F.wave * 2048 + 1024);
    const int q4 = F.lane >> 4, li = F.lane & 15;
    int ci[4], cj[4];
#pragma unroll
    for (int k = 0; k < 4; ++k) { const int t = li * 4 + k; int cnt = 0; ci[k] = -1; cj[k] = 0;
        for (int i = 0; i < 16; ++i) { const int ni = 16 / (i + 1); if (ci[k] < 0 && t < cnt + ni) { ci[k] = i; cj[k] = t - cnt; } cnt += ni; } }
    for (int tok = F.gw; tok < NREAL; tok += F.NGW) {
        const float* srow = SC + (size_t)tok * 2048;
#pragma unroll 1
        for (int it = 0; it < 4; ++it) {
            const int grp = it * 4 + q4;
            const f32x4 x0 = *(const f32x4*)(srow + grp * 128 + li * 8), x1 = *(const f32x4*)(srow + grp * 128 + li * 8 + 4);
            unsigned key[8];
#pragma unroll
            for (int j = 0; j < 8; ++j) { const float v = j < 4 ? x0[j] : x1[j - 4]; key[j] = (ord_key(v) & ~127u) | (unsigned)(127 - (li * 8 + j)); }
            unsigned mine = 0u;
#pragma unroll 4
            for (int rnd = 0; rnd < 16; ++rnd) {
                unsigned m = max(max(max(key[0], key[1]), max(key[2], key[3])), max(max(key[4], key[5]), max(key[6], key[7])));
                m = row16_max(m);
#pragma unroll
                for (int j = 0; j < 8; ++j) key[j] = (key[j] == m) ? 0u : key[j];
                mine = (li == rnd) ? m : mine;
            }
            tops[grp * 16 + li] = ord_val((mine & ~127u) | 64u); topi[grp * 16 + li] = 127 - (int)(mine & 127u);
        }
        asm volatile("s_waitcnt lgkmcnt(0)" ::: "memory");
#pragma unroll 1
        for (int it = 0; it < 2; ++it) {
            const int hh = it * 4 + q4;
            unsigned key[4];
#pragma unroll
            for (int k = 0; k < 4; ++k) { const int i = ci[k] < 0 ? 0 : ci[k]; const float sum = tops[(2 * hh) * 16 + i] + tops[(2 * hh + 1) * 16 + cj[k]];
                key[k] = ci[k] < 0 ? 0u : ((ord_key(sum) & ~255u) | (unsigned)(255 - (i * 16 + cj[k]))); }
            unsigned mine = 0u;
#pragma unroll 4
            for (int rnd = 0; rnd < 16; ++rnd) {
                unsigned m = max(max(key[0], key[1]), max(key[2], key[3]));
                m = row16_max(m);
#pragma unroll
                for (int k = 0; k < 4; ++k) key[k] = (key[k] == m) ? 0u : key[k];
                mine = (li == rnd) ? m : mine;
            }
            const int flat = 255 - (int)(mine & 255u);
            const float best = ord_val((mine & ~255u) | 128u);
            const int i1 = topi[(2 * hh) * 16 + (flat >> 4)], i2 = topi[(2 * hh + 1) * 16 + (flat & 15)];
            const float bmax = __shfl(best, F.lane & 48);
            const float e = __expf(best - bmax);
            const float se = row16_sum(e);
            EXP[(size_t)tok * 128 + hh * 16 + li] = i1 * 128 + i2;
            GATE[(size_t)tok * 128 + hh * 16 + li] = e / se;
        }
        asm volatile("s_waitcnt lgkmcnt(0)" ::: "memory");
    }
}

__device__ __forceinline__ float gelu_exact(float x) { return 0.5f * x * (1.0f + erff(x * 0.70710678118654752f)); }
typedef float f32x2_ __attribute__((ext_vector_type(2)));
__device__ __forceinline__ void p14_gather(const Args& a, Frame& F) {
    const bf16* H1 = (const bf16*)(a.ws + AR_H1); const int* EXP = (const int*)(a.ws + WS_EXP); const float* GATE = (const float*)(a.ws + WS_GATE);
    const unsigned char* UB = a.ws + WS_UB8; const unsigned char* VB = a.ws + AR_VB8; const float* SCU = (const float*)(a.ws + WS_SCU); const float* SCV = (const float*)(a.ws + WS_SCV);
    const int lane = F.lane;
    for (int tok = F.gw; tok < NREAL; tok += F.NGW) {
        float x[16], y[16];
        { const v4u w0 = *(const v4u*)(H1 + (size_t)tok * D + lane * 16), w1 = *(const v4u*)(H1 + (size_t)tok * D + lane * 16 + 8);
          const unsigned ww[8] = {w0.x, w0.y, w0.z, w0.w, w1.x, w1.y, w1.z, w1.w};
#pragma unroll
          for (int j = 0; j < 8; ++j) { x[2 * j] = bflo(ww[j]); x[2 * j + 1] = bfhi(ww[j]); y[2 * j] = 0.f; y[2 * j + 1] = 0.f; } }
        const int e0 = EXP[(size_t)tok * 128 + lane], e1 = EXP[(size_t)tok * 128 + 64 + lane];
        const float gv0 = GATE[(size_t)tok * 128 + lane] * SCV[e0], gv1 = GATE[(size_t)tok * 128 + 64 + lane] * SCV[e1];
        const float su0 = SCU[e0], su1 = SCU[e1];
        v4u ucur[8], unext[8];
#pragma unroll
        for (int k = 0; k < 8; ++k) { const int eid = __builtin_amdgcn_readlane(e0, k); ucur[k] = *(const v4u*)(UB + (size_t)eid * 1024 + lane * 16); }
#pragma unroll 1
        for (int bt = 0; bt < 16; ++bt) {
            v4u vv[8];
#pragma unroll
            for (int k = 0; k < 8; ++k) { const int slot = bt * 8 + k; const int eid = __builtin_amdgcn_readlane(slot < 64 ? e0 : e1, slot & 63); vv[k] = *(const v4u*)(VB + (size_t)eid * 1024 + lane * 16); }
            if (bt < 15) {
#pragma unroll
                for (int k = 0; k < 8; ++k) { const int slot = bt * 8 + 8 + k; const int eid = __builtin_amdgcn_readlane(slot < 64 ? e0 : e1, slot & 63); unext[k] = *(const v4u*)(UB + (size_t)eid * 1024 + lane * 16); }
            }
            float d[8];
#pragma unroll
            for (int k = 0; k < 8; ++k) {
                float s = 0.f;
#pragma unroll
                for (int j = 0; j < 4; ++j) { const f32x2_ lo = __builtin_amdgcn_cvt_pk_f32_fp8((int)ucur[k][j], false), hi = __builtin_amdgcn_cvt_pk_f32_fp8((int)ucur[k][j], true);
                    s += x[4 * j] * lo[0] + x[4 * j + 1] * lo[1] + x[4 * j + 2] * hi[0] + x[4 * j + 3] * hi[1]; }
                d[k] = s;
            }
            float r4[4], r2[2], r1;
#pragma unroll
            for (int i = 0; i < 4; ++i) { const bool up = lane & 32; const float keep = up ? d[i + 4] : d[i], send = up ? d[i] : d[i + 4]; r4[i] = keep + __shfl_xor(send, 32); }
#pragma unroll
            for (int i = 0; i < 2; ++i) { const bool up = lane & 16; const float keep = up ? r4[i + 2] : r4[i], send = up ? r4[i] : r4[i + 2]; r2[i] = keep + __shfl_xor(send, 16); }
            { const bool up = lane & 8; const float keep = up ? r2[1] : r2[0], send = up ? r2[0] : r2[1]; r1 = keep + __shfl_xor(send, 8); }
            r1 += __shfl_xor(r1, 4); r1 += __shfl_xor(r1, 2); r1 += __shfl_xor(r1, 1);
            const int myslot = bt * 8 + (lane >> 3);
            const float su = __shfl(myslot < 64 ? su0 : su1, myslot & 63), gv = __shfl(myslot < 64 ? gv0 : gv1, myslot & 63);
            const float wmine = gv * gelu_exact(r1 * su);
#pragma unroll
            for (int k = 0; k < 8; ++k) {
                const float wgt = __builtin_bit_cast(float, __builtin_amdgcn_readlane(__builtin_bit_cast(int, wmine), 8 * k));
#pragma unroll
                for (int j = 0; j < 4; ++j) { const f32x2_ lo = __builtin_amdgcn_cvt_pk_f32_fp8((int)vv[k][j], false), hi = __builtin_amdgcn_cvt_pk_f32_fp8((int)vv[k][j], true);
                    y[4 * j] += wgt * lo[0]; y[4 * j + 1] += wgt * lo[1]; y[4 * j + 2] += wgt * hi[0]; y[4 * j + 3] += wgt * hi[1]; }
            }
#pragma unroll
            for (int k = 0; k < 8; ++k) ucur[k] = unext[k];
        }
        float s = 0.f;
#pragma unroll
        for (int j = 0; j < 16; ++j) { y[j] = DN_ALPHA * x[j] + y[j]; s += y[j]; }
        const float mean = wave_sum(s) * (1.f / D); float s2 = 0.f;
#pragma unroll
        for (int j = 0; j < 16; ++j) { y[j] -= mean; s2 += y[j] * y[j]; }
        const float rstd = 1.f / sqrtf(wave_sum(s2) * (1.f / D) + LN_EPS);
#pragma unroll
        for (int q = 0; q < 4; ++q) {
            const int col = lane * 16 + q * 4;
            const f32x4 gg = *(const f32x4*)(a.ln2_g + col), bb = *(const f32x4*)(a.ln2_b + col);
            f32x4 o;
#pragma unroll
            for (int e = 0; e < 4; ++e) o[e] = y[q * 4 + e] * rstd * gg[e] + bb[e];
            *(f32x4*)(a.out + (size_t)tok * D + col) = o;
        }
    }
}

typedef short s16x4 __attribute__((ext_vector_type(4)));
typedef short bfx8 __attribute__((ext_vector_type(8)));
constexpr int R2_QS = 544, R2_VS = 144, R2_PS = 80;
constexpr int R2_Q = 0, R2_K = 32 * R2_QS, R2_V = 2 * 32 * R2_QS, R2_P = R2_V + 32 * R2_VS, R2_GRP = R2_P + 32 * R2_PS;
__device__ __forceinline__ bfx8 tr16_frag(const LAS unsigned char* p0, const LAS unsigned char* p1) {
    const s16x4 a = __builtin_amdgcn_ds_read_tr16_b64_v4i16((LAS s16x4*)p0), b = __builtin_amdgcn_ds_read_tr16_b64_v4i16((LAS s16x4*)p1);
    return (bfx8){a[0], a[1], a[2], a[3], b[0], b[1], b[2], b[3]};
}
__device__ __forceinline__ bfx8 ld2x8(const LAS unsigned char* p0, const LAS unsigned char* p1) {
    const v2u a = *(const LAS v2u*)p0, b = *(const LAS v2u*)p1; const v4u w = {a.x, a.y, b.x, b.y}; return __builtin_bit_cast(bfx8, w);
}
__device__ __forceinline__ bfx8 pack_acc2(f32x4 a, f32x4 b, float sc) {
    const v4u w = {pk2(a[0] * sc, a[1] * sc), pk2(a[2] * sc, a[3] * sc), pk2(b[0] * sc, b[1] * sc), pk2(b[2] * sc, b[3] * sc)}; return __builtin_bit_cast(bfx8, w);
}
#define MFMA16(a, b, c) __builtin_amdgcn_mfma_f32_16x16x32_bf16((a), (b), (c), 0, 0, 0)

__device__ __forceinline__ void p2_scan_ret(const Args& a, Frame& F) {
    const bf16* QKV = (const bf16*)(a.ws + AR_QKVR); bf16* OR = (bf16*)a.out;
    const int grp = F.wave >> 2, wq = F.wave & 3, tg = F.tid & 255, lane = F.lane, g = lane >> 4, l15 = lane & 15, q4 = (lane & 15) >> 2, p4 = lane & 3;
    LAS unsigned char* L = F.lds + grp * R2_GRP;
    constexpr int NSTEP = 65;
    for (int u = blockIdx.x; u < BATCH * RH * 8; u += F.G) {
        const int b = u >> 5, h = (u >> 3) & 3, dvs = u & 7;
        const float xl = a.ret_decay[grp * RH + h];
        const float lg2 = -log2f(1.0f + __expf(-xl));
        const float gC = exp2f(32.f * lg2);
        f32x4 S[16];
#pragma unroll
        for (int d = 0; d < 16; ++d) S[d] = (f32x4){0.f, 0.f, 0.f, 0.f};
        v4u rq[4], rk[4], rv;
        const float vscale = exp2f((float)(31 - (tg >> 3)) * lg2);
        const float rs0 = exp2f((float)(l15 - 31) * lg2), rs1 = exp2f((float)(l15 + 16 - 31) * lg2);
#define R2_ROW(st, i, row)    \
        do { if (grp == 0) { if ((st) == 0) row = (i) >= 16 ? NREAL + (i) - 16 : -1; else row = b * SEQ + 32 * ((st) - 1) + (i); } \
             else { if ((st) == 0) row = -1; else row = b * SEQ + 32 * (64 - (st)) + 31 - (i); } } while (0)
#define R2_LOADS(st) do { \
        _Pragma("unroll") for (int i_ = 0; i_ < 4; ++i_) { const int cid = tg + 256 * i_, ti = cid >> 5, c16 = cid & 31; int row; R2_ROW(st, ti, row); \
            if (row >= 0) { const bf16* src = QKV + (size_t)row * 4096 + h * 256 + c16 * 8; rq[i_] = *(const v4u*)src; rk[i_] = *(const v4u*)(src + 1024); } \
            else { rq[i_] = (v4u){0u, 0u, 0u, 0u}; rk[i_] = (v4u){0u, 0u, 0u, 0u}; } } \
        { const int ti = tg >> 3, c16 = tg & 7; int row; R2_ROW(st, ti, row); \
            if (row >= 0) rv = *(const v4u*)(QKV + (size_t)row * 4096 + 2048 + h * 512 + dvs * 64 + c16 * 8); else rv = (v4u){0u, 0u, 0u, 0u}; } } while (0)
        R2_LOADS(0);
#pragma unroll 1
        for (int st = 0; st < NSTEP; ++st) {
#pragma unroll
            for (int i_ = 0; i_ < 4; ++i_) { const int cid = tg + 256 * i_, ti = cid >> 5, c16 = cid & 31;
                *(LAS v4u*)(L + R2_Q + ti * R2_QS + c16 * 16) = rq[i_]; *(LAS v4u*)(L + R2_K + ti * R2_QS + c16 * 16) = rk[i_]; }
            { const int ti = tg >> 3, c16 = tg & 7; v4u w;
                w.x = pk2(bflo(rv.x) * vscale, bfhi(rv.x) * vscale); w.y = pk2(bflo(rv.y) * vscale, bfhi(rv.y) * vscale);
                w.z = pk2(bflo(rv.z) * vscale, bfhi(rv.z) * vscale); w.w = pk2(bflo(rv.w) * vscale, bfhi(rv.w) * vscale);
                *(LAS v4u*)(L + R2_V + ti * R2_VS + c16 * 16) = w; }
            __syncthreads();
            if (st + 1 < NSTEP) { R2_LOADS(st + 1); }
            {
                const int mi = wq >> 1, ni = wq & 1;
                f32x4 pacc = (f32x4){0.f, 0.f, 0.f, 0.f};
                const LAS unsigned char* qa = L + R2_Q + (16 * mi + l15) * R2_QS + g * 16; const LAS unsigned char* kb = L + R2_K + (16 * ni + l15) * R2_QS + g * 16;
#pragma unroll
                for (int s = 0; s < 8; ++s) pacc = MFMA16(*(const LAS bfx8*)(qa + s * 64), *(const LAS bfx8*)(kb + s * 64), pacc);
                const int j = 16 * ni + l15;
#pragma unroll
                for (int r = 0; r < 4; ++r) { const int i = 16 * mi + 4 * g + r; const bool keep = grp == 0 ? (j <= i) : (j < i);
                    *(LAS bf16*)(L + R2_P + i * R2_PS + j * 2) = (bf16)f2bf(keep ? pacc[r] : 0.f); }
            }
            __syncthreads();
            const bfx8 vdf = tr16_frag(L + R2_V + (8 * g + q4) * R2_VS + (16 * wq + 4 * p4) * 2, L + R2_V + (8 * g + 4 + q4) * R2_VS + (16 * wq + 4 * p4) * 2);
            f32x4 oT[2] = {(f32x4){0.f, 0.f, 0.f, 0.f}, (f32x4){0.f, 0.f, 0.f, 0.f}};
#pragma unroll
            for (int s = 0; s < 8; ++s) {
                const bfx8 sf = pack_acc2(S[2 * s], S[2 * s + 1], gC);
#pragma unroll
                for (int mt = 0; mt < 2; ++mt) { const LAS unsigned char* qp = L + R2_Q + (16 * mt + l15) * R2_QS + (32 * s + 4 * g) * 2;
                    oT[mt] = MFMA16(sf, ld2x8(qp, qp + 32), oT[mt]); }
            }
#pragma unroll
            for (int mt = 0; mt < 2; ++mt) oT[mt] = MFMA16(vdf, *(const LAS bfx8*)(L + R2_P + (16 * mt + l15) * R2_PS + g * 16), oT[mt]);
#pragma unroll
            for (int d = 0; d < 16; ++d) {
                const bfx8 kf = tr16_frag(L + R2_K + (8 * g + q4) * R2_QS + (16 * d + 4 * p4) * 2, L + R2_K + (8 * g + 4 + q4) * R2_QS + (16 * d + 4 * p4) * 2);
                S[d] = MFMA16(kf, vdf, S[d] * gC);
            }
            const bool active = (st >= 1);
            if (active) {
#pragma unroll
                for (int mt = 0; mt < 2; ++mt) {
                    int row; R2_ROW(st, 16 * mt + l15, row);
                    unsigned long long* dst = (unsigned long long*)(OR + (size_t)row * 2048 + h * 512 + dvs * 64 + 16 * wq + 4 * g);
                    const float rs = mt ? rs1 : rs0;
                    float o0 = oT[mt][0] * rs, o1 = oT[mt][1] * rs, o2 = oT[mt][2] * rs, o3 = oT[mt][3] * rs;
                    if (st >= 33) { const unsigned long long old = __hip_atomic_load(dst, RLX_AGENT); const unsigned lo = (unsigned)old, hi = (unsigned)(old >> 32);
                        o0 += bflo(lo); o1 += bfhi(lo); o2 += bflo(hi); o3 += bfhi(hi); }
                    *dst = (unsigned long long)pk2(o0, o1) | ((unsigned long long)pk2(o2, o3) << 32);
                }
            }
            if (st == 32) asm volatile("s_waitcnt vmcnt(0)" ::: "memory");
            __syncthreads();
        }
#undef R2_ROW
#undef R2_LOADS
    }
}

constexpr size_t AR_TBUF = WS_AR + 32 * MiB;
constexpr int DN_REC = 4608, DN_NSTEP = 65;
static_assert(AR_TBUF + (size_t)BATCH * DH * 2 * DN_NSTEP * DN_REC <= AR_GBETA, "TBUF fits the dead RAW_D region");

__device__ __forceinline__ void dn_rows(int b, int dir, int st, int i, int& rq, int& rg) {
    if (dir == 0) { if (st == 0) { if (i >= 16) { rq = NREAL + b * NMETA + (i - 16); rg = NREAL + (i - 16); } else { rq = -1; rg = -1; } }
                    else { rq = b * SEQ + 32 * (st - 1) + i; rg = rq; } }
    else { if (st == 0) { rq = -1; rg = -1; } else { rq = b * SEQ + 32 * (64 - st) + 31 - i; rg = rq; } }
}

__device__ __forceinline__ void p4b_dn_tinv(const Args& a, Frame& F) {
    const bf16* QD = (const bf16*)(a.ws + AR_QKVD); const float* GB = (const float*)(a.ws + AR_GBETA); unsigned char* TB = a.ws + AR_TBUF;
    LAS float* Am = (LAS float*)(F.lds + F.wave * 4352);
    const int lane = F.lane, g = lane >> 4, l15 = lane & 15;
    for (int idx = F.gw; idx < BATCH * DH * 2 * DN_NSTEP; idx += F.NGW) {
        const int st = idx % DN_NSTEP, bhd = idx / DN_NSTEP, dir = bhd & 1, h = (bhd >> 1) & 7, b = bhd >> 4;
        if (dir == 1 && st == 0) continue;
        float gi = 0.f, bi = 0.f;
        { int rq, rg; dn_rows(b, dir, st, lane & 31, rq, rg); if (rg >= 0) { gi = GB[(size_t)rg * 32 + dir * 8 + h]; bi = GB[(size_t)rg * 32 + 16 + dir * 8 + h]; } }
        float bc = gi;
#pragma unroll
        for (int off = 1; off < 32; off <<= 1) { const float t = __shfl_up(bc, off); if ((lane & 31) >= off) bc += t; }
        bfx8 kf[2][4];
#pragma unroll
        for (int mi = 0; mi < 2; ++mi) { int rq, rg; dn_rows(b, dir, st, 16 * mi + l15, rq, rg);
#pragma unroll
            for (int s = 0; s < 4; ++s) { if (rq >= 0) kf[mi][s] = *(const bfx8*)(QD + (size_t)rq * 3072 + 1024 + h * 128 + 32 * s + 8 * g); else kf[mi][s] = (bfx8){0, 0, 0, 0, 0, 0, 0, 0}; } }
#pragma unroll
        for (int mi = 0; mi < 2; ++mi)
#pragma unroll
            for (int ni = 0; ni < 2; ++ni) {
                f32x4 acc = (f32x4){0.f, 0.f, 0.f, 0.f};
#pragma unroll
                for (int s = 0; s < 4; ++s) acc = MFMA16(kf[mi][s], kf[ni][s], acc);
                const int j = 16 * ni + l15; const float bj = __shfl(bc, j);
#pragma unroll
                for (int r = 0; r < 4; ++r) { const int i = 16 * mi + 4 * g + r; const float bi_ = __shfl(bc, i), be = __shfl(bi, i);
                    Am[i * 33 + j] = (i > j) ? be * acc[r] * __expf(bi_ - bj) : 0.f; }
            }
        asm volatile("s_waitcnt lgkmcnt(0)" ::: "memory");
        float T[32];
        const int c = lane & 31;
#pragma unroll
        for (int i = 0; i < 32; ++i) {
            float s0 = (i == c) ? 1.f : 0.f, s1 = 0.f;
#pragma unroll
            for (int j = 0; j < i; ++j) { const float av = Am[i * 33 + j]; if (j & 1) s1 -= av * T[j]; else s0 -= av * T[j]; }
            T[i] = s0 + s1;
        }
        unsigned char* rec = TB + (size_t)idx * DN_REC;
        const float csc = bi * __expf(bc);
        if (lane < 32) {
#pragma unroll
            for (int i = 0; i < 32; ++i) { ((bf16*)rec)[i * 32 + c] = (bf16)f2bf(T[i]); ((bf16*)(rec + 2048))[i * 32 + c] = (bf16)f2bf(T[i] * csc); }
            ((float*)(rec + 4096))[c] = bc; ((float*)(rec + 4224))[c] = bi;
        }
        asm volatile("s_waitcnt lgkmcnt(0)" ::: "memory");
    }
}

constexpr int D5_QS = 288, D5_VS = 144, D5_TS = 80;
constexpr int D5_Q = 0, D5_K = 9216, D5_V = 18432, D5_T = 23040, D5_T2 = 25600, D5_A = 28160, D5_W = 30720, D5_VEC = 39936, D5_GRP = 40192;
__device__ __forceinline__ void p5_scan_dn(const Args& a, Frame& F) {
    const bf16* QD = (const bf16*)(a.ws + AR_QKVD); const unsigned char* TB = a.ws + AR_TBUF; bf16* OD = (bf16*)(a.ws + AR_OD);
    const int grp = F.wave >> 2, wq = F.wave & 3, tg = F.tid & 255, lane = F.lane, g = lane >> 4, l15 = lane & 15, q4 = (lane & 15) >> 2, p4 = lane & 3;
    LAS unsigned char* L = F.lds + grp * D5_GRP;
    const LAS float* bcv = (const LAS float*)(L + D5_VEC);
    for (int u = blockIdx.x; u < BATCH * DH * 2; u += F.G) {
        const int b = u >> 4, h = (u >> 1) & 7, dvh = u & 1;
        const unsigned char* recbase = TB + (size_t)(((b * DH + h) * 2 + grp) * DN_NSTEP) * DN_REC;
        f32x4 S[8];
#pragma unroll
        for (int d = 0; d < 8; ++d) S[d] = (f32x4){0.f, 0.f, 0.f, 0.f};
        v4u rq[2], rk[2], rv, rt, rvec; float rbeta;
#define D5_LOADS(st) do { \
        _Pragma("unroll") for (int i_ = 0; i_ < 2; ++i_) { const int cid = tg + 256 * i_, ti = cid >> 4, c16 = cid & 15; int r_, rg_; dn_rows(b, grp, (st), ti, r_, rg_); \
            if (r_ >= 0) { const bf16* src = QD + (size_t)r_ * 3072 + h * 128 + c16 * 8; rq[i_] = *(const v4u*)src; rk[i_] = *(const v4u*)(src + 1024); } \
            else { rq[i_] = (v4u){0u, 0u, 0u, 0u}; rk[i_] = (v4u){0u, 0u, 0u, 0u}; } } \
        { const int ti = tg >> 3, c16 = tg & 7; int r_, rg_; dn_rows(b, grp, (st), ti, r_, rg_); \
            if (r_ >= 0) rv = *(const v4u*)(QD + (size_t)r_ * 3072 + 2048 + h * 128 + dvh * 64 + c16 * 8); else rv = (v4u){0u, 0u, 0u, 0u}; } \
        if (grp == 0 || (st) >= 1) { const unsigned char* rec = recbase + (size_t)(st) * DN_REC; rt = *(const v4u*)(rec + tg * 16); rbeta = *(const float*)(rec + 4224 + (tg >> 3) * 4); \
            if (tg < 16) rvec = *(const v4u*)(rec + 4096 + tg * 16); } \
        else { rt = (v4u){0u, 0u, 0u, 0u}; rbeta = 0.f; rvec = (v4u){0u, 0u, 0u, 0u}; } } while (0)
        D5_LOADS(0);
#pragma unroll 1
        for (int st = 0; st < DN_NSTEP; ++st) {
#pragma unroll
            for (int i_ = 0; i_ < 2; ++i_) { const int cid = tg + 256 * i_, ti = cid >> 4, c16 = cid & 15;
                *(LAS v4u*)(L + D5_Q + ti * D5_QS + c16 * 16) = rq[i_]; *(LAS v4u*)(L + D5_K + ti * D5_QS + c16 * 16) = rk[i_]; }
            { const int ti = tg >> 3, c16 = tg & 7; v4u w;
                w.x = pk2(bflo(rv.x) * rbeta, bfhi(rv.x) * rbeta); w.y = pk2(bflo(rv.y) * rbeta, bfhi(rv.y) * rbeta);
                w.z = pk2(bflo(rv.z) * rbeta, bfhi(rv.z) * rbeta); w.w = pk2(bflo(rv.w) * rbeta, bfhi(rv.w) * rbeta);
                *(LAS v4u*)(L + D5_V + ti * D5_VS + c16 * 16) = w; }
            { const int tsel = tg >> 7, c = tg & 127; *(LAS v4u*)(L + (tsel ? D5_T2 : D5_T) + (c >> 2) * D5_TS + (c & 3) * 16) = rt; }
            if (tg < 16) *(LAS v4u*)(L + D5_VEC + tg * 16) = rvec;
            __syncthreads();
            if (st + 1 < DN_NSTEP) { D5_LOADS(st + 1); }
            {
                const int mi = wq >> 1, ni = wq & 1;
                f32x4 pacc = (f32x4){0.f, 0.f, 0.f, 0.f};
                const LAS unsigned char* qa = L + D5_Q + (16 * mi + l15) * D5_QS + g * 16; const LAS unsigned char* kb = L + D5_K + (16 * ni + l15) * D5_QS + g * 16;
#pragma unroll
                for (int s = 0; s < 4; ++s) pacc = MFMA16(*(const LAS bfx8*)(qa + s * 64), *(const LAS bfx8*)(kb + s * 64), pacc);
                const int j = 16 * ni + l15; const float bj = bcv[j];
#pragma unroll
                for (int r = 0; r < 4; ++r) { const int i = 16 * mi + 4 * g + r;
                    *(LAS bf16*)(L + D5_A + i * D5_TS + j * 2) = (bf16)f2bf((j <= i) ? pacc[r] * __expf(bcv[i] - bj) : 0.f); }
#pragma unroll
                for (int dd = 0; dd < 2; ++dd) { const int d = 2 * wq + dd;
                    const bfx8 kf = tr16_frag(L + D5_K + (8 * g + q4) * D5_QS + (16 * d + 4 * p4) * 2, L + D5_K + (8 * g + 4 + q4) * D5_QS + (16 * d + 4 * p4) * 2);
#pragma unroll
                    for (int mt = 0; mt < 2; ++mt) {
                        f32x4 wacc = MFMA16(kf, *(const LAS bfx8*)(L + D5_T2 + (16 * mt + l15) * D5_TS + g * 16), ((f32x4){0.f, 0.f, 0.f, 0.f}));
                        v2u w; w.x = pk2(-wacc[0], -wacc[1]); w.y = pk2(-wacc[2], -wacc[3]);
                        *(LAS v2u*)(L + D5_W + (16 * mt + l15) * D5_QS + (16 * d + 4 * g) * 2) = w;
                    }
                }
            }
            __syncthreads();
            const float blast = bcv[31], eL = __expf(blast);
            const bfx8 vf = tr16_frag(L + D5_V + (8 * g + q4) * D5_VS + (16 * wq + 4 * p4) * 2, L + D5_V + (8 * g + 4 + q4) * D5_VS + (16 * wq + 4 * p4) * 2);
            f32x4 vn[2], o1[2];
#pragma unroll
            for (int mt = 0; mt < 2; ++mt) { vn[mt] = MFMA16(*(const LAS bfx8*)(L + D5_T + (16 * mt + l15) * D5_TS + g * 16), vf, ((f32x4){0.f, 0.f, 0.f, 0.f})); o1[mt] = (f32x4){0.f, 0.f, 0.f, 0.f}; }
#pragma unroll
            for (int s = 0; s < 4; ++s) {
                const bfx8 sf = pack_acc2(S[2 * s], S[2 * s + 1], 1.0f);
#pragma unroll
                for (int mt = 0; mt < 2; ++mt) {
                    const LAS unsigned char* wp = L + D5_W + (16 * mt + l15) * D5_QS + (32 * s + 4 * g) * 2; const LAS unsigned char* qp = L + D5_Q + (16 * mt + l15) * D5_QS + (32 * s + 4 * g) * 2;
                    vn[mt] = MFMA16(ld2x8(wp, wp + 32), sf, vn[mt]);
                    o1[mt] = MFMA16(sf, ld2x8(qp, qp + 32), o1[mt]);
                }
            }
            const bfx8 vnf = pack_acc2(vn[0], vn[1], 1.0f);
            f32x4 vs0, vs1;
#pragma unroll
            for (int r = 0; r < 4; ++r) { vs0[r] = vn[0][r] * __expf(blast - bcv[4 * g + r]); vs1[r] = vn[1][r] * __expf(blast - bcv[16 + 4 * g + r]); }
            const bfx8 vnsf = pack_acc2(vs0, vs1, 1.0f);
            f32x4 o2[2];
#pragma unroll
            for (int mt = 0; mt < 2; ++mt) { const LAS unsigned char* ap = L + D5_A + (16 * mt + l15) * D5_TS + (4 * g) * 2; o2[mt] = MFMA16(vnf, ld2x8(ap, ap + 32), ((f32x4){0.f, 0.f, 0.f, 0.f})); }
#pragma unroll
            for (int d = 0; d < 8; ++d) {
                const bfx8 kp = tr16_frag(L + D5_K + (4 * g + q4) * D5_QS + (16 * d + 4 * p4) * 2, L + D5_K + (16 + 4 * g + q4) * D5_QS + (16 * d + 4 * p4) * 2);
                S[d] = MFMA16(kp, vnsf, S[d] * eL);
            }
            if (st >= 1) {
#pragma unroll
                for (int mt = 0; mt < 2; ++mt) {
                    const int i = 16 * mt + l15; int row, rg_; dn_rows(b, grp, st, i, row, rg_);
                    unsigned long long* dst = (unsigned long long*)(OD + (size_t)row * 1024 + h * 128 + dvh * 64 + 16 * wq + 4 * g);
                    const float ei = __expf(bcv[i]);
                    float x0 = o1[mt][0] * ei + o2[mt][0], x1 = o1[mt][1] * ei + o2[mt][1], x2 = o1[mt][2] * ei + o2[mt][2], x3 = o1[mt][3] * ei + o2[mt][3];
                    if (st >= 33) { const unsigned long long old = __hip_atomic_load(dst, RLX_AGENT); const unsigned lo = (unsigned)old, hi = (unsigned)(old >> 32);
                        x0 += bflo(lo); x1 += bfhi(lo); x2 += bflo(hi); x3 += bfhi(hi); }
                    *dst = (unsigned long long)pk2(x0, x1) | ((unsigned long long)pk2(x2, x3) << 32);
                }
            }
            if (st == 32) asm volatile("s_waitcnt vmcnt(0)" ::: "memory");
            __syncthreads();
        }
#undef D5_LOADS
    }
}

constexpr int NPHASES = 16;
__global__ void __launch_bounds__(NTHREADS, 2) fwd_kernel(Args args) {
    extern __shared__ __attribute__((aligned(16))) unsigned char lds_raw[];
    Frame F;
    F.lds = (LAS unsigned char*)lds_raw;
    F.tid = threadIdx.x; F.lane = F.tid & 63; F.wave = __builtin_amdgcn_readfirstlane(F.tid >> 6);
    F.G = gridDim.x; F.gw = blockIdx.x * NWAVES + F.wave; F.NGW = F.G * NWAVES;
    volatile LAS unsigned* MISC = (volatile LAS unsigned*)(F.lds + MISC_OFF);
    for (int u = F.tid; u < (LDS_BYTES - RING_BYTES) / 4; u += NTHREADS) ((LAS unsigned*)(F.lds + RING_BYTES))[u] = 0u;
    __syncthreads();
    unsigned* ctl = (unsigned*)(args.ws + WS_CTL);
    const int lo = args.ph_lo, hi = args.ph_hi;
    XcdBarrier bar; bar.bar = ctl + CW_BAR; bar.x = 0; bar.st = nullptr;
    if (hi - lo > 1) bar = xcd_barrier_post(ctl + CW_BAR, MISC + 8);
#define IN(k) (lo <= (k) && (k) < hi)
#define SEAM(k) do { if (IN(k) && IN((k) + 1)) xcd_barrier(bar); } while (0)
    unsigned char* ws = args.ws;
    bf16* HB = (bf16*)(ws + WS_HB); bf16* WT = (bf16*)(ws + WS_WT);

    if (IN(0)) { p0_prologue(args, F); } SEAM(0);
    if (IN(1)) {
        pg8::Gemm g{HB, WT + (size_t)WT_A0 * D, MROWS, WT_A_N, D}; pg8::StaticOrder S; S.init(MROWS, WT_A_N, F.G, (int)blockIdx.x);
        ep::EpiRot E{(bf16*)(ws + AR_QKVR)};
        pg8::gemm_phase<ep::EpiRot, pg8::StaticOrder, true, true>(F.lds, g, S, E);
    } SEAM(1);
    if (IN(2)) { p2_scan_ret(args, F); } SEAM(2);
    if (IN(3)) {
        pg8::Gemm g{HB, WT + (size_t)WT_B0 * D, MROWS, WT_B_N, D}; pg8::StaticOrder S; S.init(MROWS, WT_B_N, F.G, (int)blockIdx.x);
        ep::EpiDn E{(bf16*)(ws + AR_RAWD), (float*)(ws + AR_GBETA), args.dn_a_log, args.dn_dt_bias};
        pg8::gemm_phase<ep::EpiDn, pg8::StaticOrder, true, true>(F.lds, g, S, E);
    } SEAM(3);
    if (IN(4)) { p4_conv(args, F); } SEAM(4);
    if (IN(5)) { p4b_dn_tinv(args, F); } SEAM(5);
    if (IN(6)) { p5_scan_dn(args, F); } SEAM(6);
    if (IN(7)) {
        p6_small_weights(args, F);
        __syncthreads();
        pg8::Gemm g{HB, WT + (size_t)WT_C0 * D, NREAL, WT_C_N, D}; pg8::StaticOrder S; S.init(NREAL, WT_C_N, F.G, (int)blockIdx.x);
        ep::EpiGates E{(bf16*)(ws + AR_GRG), (bf16*)(ws + AR_GDZ), (bf16*)(ws + AR_GGA), (bf16*)(ws + AR_GGB)};
        pg8::gemm_phase<ep::EpiGates, pg8::StaticOrder, true, true>(F.lds, g, S, E);
    } SEAM(7);
    if (IN(8)) { p7_gate_norm(args, F); } SEAM(8);
    if (IN(9)) {
        pg8::Gemm g{(const bf16*)args.out, (const bf16*)(ws + AR_PRETT), NREAL, 1024, 2048}; pg8::StaticOrder S; S.init(NREAL, 1024, F.G, (int)blockIdx.x);
        ep::EpiMerge<false> E{(const bf16*)(ws + AR_GGA), nullptr, (bf16*)(ws + AR_M1)};
        pg8::gemm_phase<ep::EpiMerge<false>, pg8::StaticOrder, true, true>(F.lds, g, S, E);
    } SEAM(9);
    if (IN(10)) {
        pg8::Gemm g{(const bf16*)(ws + AR_OD), (const bf16*)(ws + AR_PDNT), NREAL, 1024, 1024}; pg8::StaticOrder S; S.init(NREAL, 1024, F.G, (int)blockIdx.x);
        ep::EpiMerge<true> E{(const bf16*)(ws + AR_GGB), (const bf16*)(ws + AR_M1), (bf16*)(ws + AR_MERGED)};
        pg8::gemm_phase<ep::EpiMerge<true>, pg8::StaticOrder, true, true>(F.lds, g, S, E);
    } SEAM(10);
    if (IN(11)) {
        pg8::Gemm g{(const bf16*)(ws + AR_MERGED), (const bf16*)(ws + AR_WOUTT), NREAL, 1024, 1024}; pg8::StaticOrder S; S.init(NREAL, 1024, F.G, (int)blockIdx.x);
        ep::EpiRes E{HB, (float*)(ws + AR_PRE)};
        pg8::gemm_phase<ep::EpiRes, pg8::StaticOrder, true, true>(F.lds, g, S, E);
    } SEAM(11);
    if (IN(12)) { p11_ln1_tables(args, F); } SEAM(12);
    if (IN(13)) {
        pg8::Gemm g{(const bf16*)(ws + AR_H1), (const bf16*)(ws + AR_W2T), NREAL, 2048, 1024}; pg8::StaticOrder S; S.init(NREAL, 2048, F.G, (int)blockIdx.x);
        ep::EpiF32 E{(float*)(ws + AR_SCORES), 2048};
        pg8::gemm_phase<ep::EpiF32, pg8::StaticOrder, true, true>(F.lds, g, S, E);
    } SEAM(13);
    if (IN(14)) { p13_topk(args, F); } SEAM(14);
    if (IN(15)) { p14_gather(args, F); }
#undef IN
#undef SEAM
}

#ifndef PROBE_PHASE
#define PROBE_PHASE -1
#endif
#ifndef N_LAUNCH_MODE
#define N_LAUNCH_MODE 1
#endif
extern "C" void kernel_launch(void* const* d_in, const int* in_sizes, int n_in, void* d_out, int out_size, void* d_ws, size_t ws_size, hipStream_t stream) {
    static int grid = 0;
    if (grid == 0) {
        if (n_in != 21 || out_size != NREAL * D || ws_size < WS_END) { fprintf(stderr, "kernel_launch: unexpected shapes (n_in %d, out %d, ws %zu)\n", n_in, out_size, ws_size); grid = -1; return; }
        int dev = 0, cus = 0;
        if (hipGetDevice(&dev) != hipSuccess || hipDeviceGetAttribute(&cus, hipDeviceAttributeMultiprocessorCount, dev) != hipSuccess) { grid = -1; return; }
        if (hipFuncSetAttribute((const void*)fwd_kernel, hipFuncAttributeMaxDynamicSharedMemorySize, LDS_BYTES) != hipSuccess) { grid = -1; return; }
        int per_cu = 0;
        (void)hipOccupancyMaxActiveBlocksPerMultiprocessor(&per_cu, (const void*)fwd_kernel, NTHREADS, LDS_BYTES);
        (void)hipGetLastError();
        grid = cus;
    }
    if (grid < 0) return;
    (void)hipMemsetAsync((char*)d_ws + WS_CTL, 0, CTL_ZERO_BYTES, stream);
    Args a{};
    const float** fp = (const float**)&a;
    for (int i = 0; i < 21; ++i) fp[i] = (const float*)d_in[i];
    a.out = (float*)d_out; a.ws = (unsigned char*)d_ws;
    if (N_LAUNCH_MODE == 1) {
#if PROBE_PHASE >= 0 && PROBE_PHASE < 13
        a.ph_lo = PROBE_PHASE; a.ph_hi = PROBE_PHASE + 1;
        hipLaunchKernelGGL(fwd_kernel, dim3(grid), dim3(NTHREADS), LDS_BYTES, stream, a);
#endif
        a.ph_lo = 0; a.ph_hi = NPHASES;
        hipLaunchKernelGGL(fwd_kernel, dim3(grid), dim3(NTHREADS), LDS_BYTES, stream, a);
#if PROBE_PHASE >= 13
        a.ph_lo = PROBE_PHASE; a.ph_hi = PROBE_PHASE + 1;
        hipLaunchKernelGGL(fwd_kernel, dim3(grid), dim3(NTHREADS), LDS_BYTES, stream, a);
#endif
    } else {
        for (int p = 0; p < NPHASES; ++p) { a.ph_lo = p; a.ph_hi = p + 1; hipLaunchKernelGGL(fwd_kernel, dim3(grid), dim3(NTHREADS), LDS_BYTES, stream, a); }
    }
}
```

```cpp
#include <hip/hip_runtime.h>
#include <cstdio>
#include <cstdint>
namespace pg8 {
#define PG8_LAS __attribute__((address_space(3)))
typedef unsigned short bf16_t;
typedef short bf16x8 __attribute__((ext_vector_type(8)));
typedef float f32x4 __attribute__((ext_vector_type(4)));
typedef unsigned u32x4 __attribute__((ext_vector_type(4)));
constexpr int BM = 256, BK = 64, HALF = 128, HTB = HALF * BK * 2  , STAGE_BYTES = 8 * HTB, NXCD = 8, WGM = 8;

__host__ __device__ __forceinline__ int lds_byte(int r, int c) { const int st = (r >> 4) * 2 + (c >> 5), rr = r & 15, cc = c & 31, ob = rr * 64 + cc * 2; return st * 1024 + (ob ^ (((ob >> 9) & 1) << 5)); }
__host__ __device__ __forceinline__ void stage_rc(int b, int& R, int& C) { const int st = b / 1024, sb = b % 1024, swz = sb ^ (((sb >> 9) & 1) << 5); R = (st >> 1) * 16 + swz / 64; C = (st & 1) * 32 + (swz % 64) / 2; }
__host__ __device__ __forceinline__ int perm32(int rho) { const int n = rho >> 4, i = rho & 15; return 8 * (i >> 2) + 4 * n + (i & 3); }

struct Unit { int pm, pn; };
struct Gemm { const bf16_t* A; const bf16_t* Bt; int M, N, K; };

struct StaticOrder {
    int nM, nN, nwg, G, c;
    __host__ __device__ void init(int M, int N, int G_, int c_) { nM = M / BM; nN = N / BM; nwg = nM * nN; G = G_; c = c_; }
    __host__ __device__ bool next(int i, Unit& u) const {
        const long L = (long)i * G + c; if (L >= nwg) return false;
        int wgid = (int)L; { const int q = nwg / NXCD, r = nwg % NXCD, xcd = wgid % NXCD, off = wgid / NXCD; wgid = (xcd < r ? xcd * (q + 1) : r * (q + 1) + (xcd - r) * q) + off; }
        const int nig = WGM * nN, gid = wgid / nig, fm = gid * WGM, gsz = (nM - fm) < WGM ? (nM - fm) : WGM;
        u.pm = fm + ((wgid % nig) % gsz); u.pn = (wgid % nig) / gsz; return true;
    }
    __device__ __forceinline__ void a_ready(const Unit&) const {}
    __device__ __forceinline__ void done(const Unit&) const {}
};
__device__ __forceinline__ unsigned cvt_pk_bf16(float lo, float hi) { unsigned r; asm volatile("v_cvt_pk_bf16_f32 %0, %1, %2" : "=v"(r) : "v"(lo), "v"(hi)); return r; }
template <class Epi, class Sched, bool ALIGN_EPI = false, bool SP2 = false>
__device__ __forceinline__ void gemm_phase(PG8_LAS unsigned char* lds, const Gemm g, const Sched& S, const Epi& E) {
    const int tid = threadIdx.x, wid = __builtin_amdgcn_readfirstlane(tid >> 6), lane = tid & 63, wr = wid >> 2, wc = wid & 3, fr = lane & 15, fq = lane >> 4;
    const int K = g.K, nt = K / BK;
    unsigned voffA[2], voffB[2];
#pragma unroll
    for (int i = 0; i < 2; ++i) { int R, C; stage_rc(tid * 16 + i * 8192, R, C); const int Rb = Epi::PERM ? ((R & ~31) + perm32(R & 31)) : R;
        voffA[i] = (unsigned)(R * K + C) * 2u; voffB[i] = (unsigned)(Rb * K + C) * 2u; }
    const size_t kstep = (size_t)(BK * 2);
    const size_t hstep = (size_t)HALF * K * 2;
    const size_t tstep = 2 * hstep;
    const unsigned ldsw = (unsigned)wid * 1024u;
    const int aoff = lds_byte(wr * 64 + fr, fq * 8), boff = lds_byte(wc * 32 + fr, fq * 8);
#define PG8_SA(b, h) (((b) * 2 + (h)) * HTB)
#define PG8_SB(b, h) ((4 + (b) * 2 + (h)) * HTB)
#define PG8_STAGE(bufoff, gbase, voff) do { _Pragma("unroll") for (int _i = 0; _i < 2; ++_i) \
        __builtin_amdgcn_global_load_lds((const unsigned*)((const char*)(gbase) + (voff)[_i]), (PG8_LAS unsigned*)(lds + (bufoff) + ldsw + _i * 8192), 16, 0, 0); } while (0)
#define PG8_LDA(dst, b, h) do { _Pragma("unroll") for (int m = 0; m < 4; ++m) _Pragma("unroll") for (int k = 0; k < 2; ++k) dst[m][k] = *(const PG8_LAS bf16x8*)(lds + PG8_SA(b, h) + aoff + m * 2048 + k * 1024); } while (0)
#define PG8_LDB(dst, b, h) do { _Pragma("unroll") for (int n = 0; n < 2; ++n) _Pragma("unroll") for (int k = 0; k < 2; ++k) dst[n][k] = *(const PG8_LAS bf16x8*)(lds + PG8_SB(b, h) + boff + n * 2048 + k * 1024); } while (0)
#define PG8_MMA(ai, bj, At, Bt) do { __builtin_amdgcn_s_setprio(1); _Pragma("unroll") for (int m = 0; m < 4; ++m) _Pragma("unroll") for (int n = 0; n < 2; ++n) _Pragma("unroll") for (int k = 0; k < 2; ++k) \
        acc[ai][bj][m][n] = __builtin_amdgcn_mfma_f32_16x16x32_bf16(Bt[n][k], At[m][k], acc[ai][bj][m][n], 0, 0, 0); __builtin_amdgcn_s_setprio(0); } while (0)
#define PG8_WAIT_V(n) asm volatile("s_waitcnt vmcnt(" #n ")" ::: "memory")
#define PG8_WAIT_L(n) asm volatile("s_waitcnt lgkmcnt(" #n ")" ::: "memory")
#define PG8_BAR __builtin_amdgcn_s_barrier()
#define PG8_SCHED __builtin_amdgcn_sched_barrier(0)
    Unit cur, nxt; int ui = 0;
    if (!S.next(0, cur)) return;
    f32x4 acc[2][2][4][2];
#pragma unroll
    for (int a = 0; a < 2; ++a)
#pragma unroll
        for (int b = 0; b < 2; ++b)
#pragma unroll
            for (int m = 0; m < 4; ++m)
#pragma unroll
                for (int n = 0; n < 2; ++n) acc[a][b][m][n] = (f32x4){0.f, 0.f, 0.f, 0.f};
    bf16x8 At[4][2], B0[2][2], B1[2][2];
    const char* cA = (const char*)g.A + (size_t)cur.pm * tstep; const char* cB = (const char*)g.Bt + (size_t)cur.pn * tstep;
    S.a_ready(cur);
    if constexpr (SP2) {
        PG8_STAGE(PG8_SB(0, 0), cB, voffB); PG8_STAGE(PG8_SB(0, 1), cB + hstep, voffB); PG8_STAGE(PG8_SA(0, 0), cA, voffA); PG8_STAGE(PG8_SA(0, 1), cA + hstep, voffA);
        if (wr == 1) PG8_BAR;
        PG8_WAIT_V(2); PG8_BAR;
        PG8_STAGE(PG8_SB(1, 0), cB + kstep, voffB); PG8_STAGE(PG8_SA(1, 0), cA + kstep, voffA); PG8_STAGE(PG8_SB(1, 1), cB + hstep + kstep, voffB);
        PG8_WAIT_V(6); PG8_BAR;
    } else {
        PG8_STAGE(PG8_SB(0, 0), cB, voffB); PG8_STAGE(PG8_SA(0, 0), cA, voffA); PG8_STAGE(PG8_SB(0, 1), cB + hstep, voffB); PG8_STAGE(PG8_SA(0, 1), cA + hstep, voffA);
        if (wr == 1) PG8_BAR;
        PG8_WAIT_V(4); PG8_BAR;
        PG8_STAGE(PG8_SB(1, 0), cB + kstep, voffB); PG8_STAGE(PG8_SA(1, 0), cA + kstep, voffA); PG8_STAGE(PG8_SB(1, 1), cB + hstep + kstep, voffB);
        PG8_WAIT_V(6); PG8_BAR;
    }
    for (;;) {
        const bool has_next = S.next(ui + 1, nxt);
        const char* nA = has_next ? (const char*)g.A + (size_t)nxt.pm * tstep : cA; const char* nB = has_next ? (const char*)g.Bt + (size_t)nxt.pn * tstep : cB;
        for (int t = 0; t < nt; t += 2) {
            const bool last = (t == nt - 2);
            const char* a1 = cA + (size_t)(t + 1) * kstep;
            const char* a2 = last ? nA : cA + (size_t)(t + 2) * kstep; const char* b2 = last ? nB : cB + (size_t)(t + 2) * kstep;
            const char* a3 = a2 + kstep; const char* b3 = b2 + kstep;
            if (last && has_next) S.a_ready(nxt);
            if constexpr (SP2) {
            PG8_LDB(B0, 0, 0); PG8_LDB(B1, 0, 1); PG8_SCHED; PG8_LDA(At, 0, 0); PG8_STAGE(PG8_SA(1, 1), a1 + hstep, voffA);
            PG8_WAIT_V(8); PG8_WAIT_L(0); PG8_BAR; PG8_MMA(0, 0, At, B0); PG8_MMA(0, 1, At, B1); PG8_BAR; PG8_SCHED;
            PG8_LDA(At, 0, 1); PG8_STAGE(PG8_SB(0, 0), b2, voffB); PG8_STAGE(PG8_SB(0, 1), b2 + hstep, voffB); PG8_STAGE(PG8_SA(0, 0), a2, voffA);
            PG8_WAIT_V(8); PG8_WAIT_L(0); PG8_BAR; PG8_MMA(1, 0, At, B0); PG8_MMA(1, 1, At, B1); PG8_BAR; PG8_SCHED;
            PG8_LDB(B0, 1, 0); PG8_LDB(B1, 1, 1); PG8_SCHED; PG8_LDA(At, 1, 0); PG8_STAGE(PG8_SA(0, 1), a2 + hstep, voffA);
            PG8_WAIT_V(8); PG8_WAIT_L(0); PG8_BAR; PG8_MMA(0, 0, At, B0); PG8_MMA(0, 1, At, B1); PG8_BAR; PG8_SCHED;
            PG8_LDA(At, 1, 1); PG8_STAGE(PG8_SB(1, 0), b3, voffB); PG8_STAGE(PG8_SB(1, 1), b3 + hstep, voffB); PG8_STAGE(PG8_SA(1, 0), a3, voffA);
            PG8_WAIT_V(8); PG8_WAIT_L(0); PG8_BAR; PG8_MMA(1, 0, At, B0); PG8_MMA(1, 1, At, B1); PG8_BAR; PG8_SCHED;
            } else {
            PG8_LDB(B0, 0, 0); PG8_SCHED; PG8_LDA(At, 0, 0); PG8_STAGE(PG8_SA(1, 1), a1 + hstep, voffA);
            PG8_WAIT_L(8); PG8_BAR; PG8_WAIT_L(0); PG8_MMA(0, 0, At, B0); PG8_BAR; PG8_SCHED;
            PG8_LDB(B1, 0, 1); PG8_STAGE(PG8_SB(0, 0), b2, voffB);
            PG8_BAR; PG8_WAIT_L(0); PG8_MMA(0, 1, At, B1); PG8_BAR;
            PG8_LDA(At, 0, 1); PG8_STAGE(PG8_SA(0, 0), a2, voffA);
            PG8_BAR; PG8_WAIT_L(0); PG8_MMA(1, 0, At, B0); PG8_BAR; PG8_SCHED;
            PG8_STAGE(PG8_SB(0, 1), b2 + hstep, voffB);
            PG8_WAIT_V(6); PG8_BAR; PG8_MMA(1, 1, At, B1); PG8_BAR;
            PG8_LDB(B0, 1, 0); PG8_SCHED; PG8_LDA(At, 1, 0); PG8_STAGE(PG8_SA(0, 1), a2 + hstep, voffA);
            PG8_WAIT_L(8); PG8_BAR; PG8_WAIT_L(0); PG8_MMA(0, 0, At, B0); PG8_BAR; PG8_SCHED;
            PG8_LDB(B1, 1, 1); PG8_STAGE(PG8_SB(1, 0), b3, voffB);
            PG8_BAR; PG8_WAIT_L(0); PG8_MMA(0, 1, At, B1); PG8_BAR;
            PG8_LDA(At, 1, 1); PG8_STAGE(PG8_SA(1, 0), a3, voffA);
            PG8_BAR; PG8_WAIT_L(0); PG8_MMA(1, 0, At, B0); PG8_BAR; PG8_SCHED;
            PG8_STAGE(PG8_SB(1, 1), b3 + hstep, voffB);
            PG8_WAIT_V(6); PG8_BAR; PG8_MMA(1, 1, At, B1); PG8_BAR;
            }
        }
        if constexpr (ALIGN_EPI) { if (wr == 0) PG8_BAR; }
        if constexpr (!Epi::AFTER_DRAIN) { E(acc, cur, wr, wc, fr, fq); S.done(cur); }
        if (!has_next) break;
#pragma unroll
        for (int a = 0; a < 2; ++a)
#pragma unroll
            for (int b = 0; b < 2; ++b)
#pragma unroll
                for (int m = 0; m < 4; ++m)
#pragma unroll
                    for (int n = 0; n < 2; ++n) acc[a][b][m][n] = (f32x4){0.f, 0.f, 0.f, 0.f};
        cur = nxt; cA = nA; cB = nB; ++ui;
        if constexpr (ALIGN_EPI) { if (wr == 1) PG8_BAR; }
    }
    PG8_WAIT_V(0);
    if constexpr (!ALIGN_EPI) { if (wr == 0) PG8_BAR; }
    PG8_BAR;
    if constexpr (Epi::AFTER_DRAIN) { E.fused(acc, cur, wr, wc, fr, fq, lds, wid, lane); S.done(cur); }
#undef PG8_SA
#undef PG8_SB
#undef PG8_STAGE
#undef PG8_LDA
#undef PG8_LDB
#undef PG8_MMA
#undef PG8_WAIT_V
#undef PG8_WAIT_L
#undef PG8_BAR
#undef PG8_SCHED
}
}
#define XB_TMO      128
#define XB_XCNT(j)  (256  + 64 * (j))
#define XB_XSUB(j)  (1280 + 64 * (j))
#define XB_XGEN(j)  (2304 + 64 * (j))
#define XB_TOP      3328
#define XB_TOPGEN   3392
#define XCD_BAR_WORDS 3456
#define XB_SPIN_CAP (1u << 18)
#define LAS __attribute__((address_space(3)))

__device__ __forceinline__ unsigned xb_ld(unsigned* p)              { return __hip_atomic_load(p, __ATOMIC_RELAXED, __HIP_MEMORY_SCOPE_AGENT); }
__device__ __forceinline__ unsigned xb_add(unsigned* p, unsigned v) { return __hip_atomic_fetch_add(p, v, __ATOMIC_RELAXED, __HIP_MEMORY_SCOPE_AGENT); }
__device__ __forceinline__ unsigned xb_xcc_id() { return (unsigned)__builtin_amdgcn_s_getreg((3 << 11) | 20) & 0xFu; }
#define XB_SPIN(cond, bar) do { unsigned _sp = 0; while (cond) { __builtin_amdgcn_s_sleep(1); \
    if ((++_sp & 255u) == 0u) { if (xb_ld(&(bar)[XB_TMO])) break; if (_sp > XB_SPIN_CAP) { atomicAdd(&(bar)[XB_TMO], 1u); break; } } } } while (0)

struct XcdBarrier {
    unsigned* bar; unsigned x;
    volatile LAS unsigned* st;
};

__device__ __forceinline__ XcdBarrier xcd_barrier_post(unsigned* bar, volatile LAS unsigned* st) {
    XcdBarrier b; b.bar = bar; b.x = xb_xcc_id(); b.st = st;
    if (threadIdx.x == 0) (void)xb_add(&bar[XB_XCNT(b.x)], 1u);
    return b;
}
__device__ __forceinline__ void xcd_barrier_complete(unsigned* bar, unsigned x, unsigned& nloc, unsigned& nx) {
    const unsigned G = gridDim.x * gridDim.y * gridDim.z;
    unsigned sum, cnt, mine, sp = 0u;
    for (;;) {
        sum = 0u; cnt = 0u; mine = 0u;
#pragma unroll
        for (unsigned j = 0; j < 16; ++j) { const unsigned c = xb_ld(&bar[XB_XCNT(j)]); sum += c; cnt += (c > 0u) ? 1u : 0u; mine = (j == x) ? c : mine; }
        if (sum == G) break;
        __builtin_amdgcn_s_sleep(1);
        if ((++sp & 255u) == 0u) { if (xb_ld(&bar[XB_TMO])) break; if (sp > XB_SPIN_CAP) { atomicAdd(&bar[XB_TMO], 1u); break; } }
    }
    nloc = mine > 0u ? mine : 1u; nx = cnt > 0u ? cnt : 1u;
}

__device__ __forceinline__ void xcd_barrier(const XcdBarrier& b) {
    asm volatile("s_waitcnt vmcnt(0)" ::: "memory");
    __syncthreads();
    if (threadIdx.x == 0) {
        unsigned* bar = b.bar;
        __builtin_amdgcn_s_waitcnt(0);
        unsigned nloc = b.st[0], nx = b.st[1];
        if (nloc == 0u) { xcd_barrier_complete(bar, b.x, nloc, nx); b.st[0] = nloc; b.st[1] = nx; }
        const unsigned old = xb_add(&bar[XB_XSUB(b.x)], 1u);
        const unsigned gen = old / nloc;
        if (old + 1u == (gen + 1u) * nloc) {
            __builtin_amdgcn_fence(__ATOMIC_RELEASE, "agent");
            asm volatile("s_waitcnt vmcnt(0)" ::: "memory");
            const unsigned og = xb_add(&bar[XB_TOP], 1u);
            const unsigned tg = og / nx;
            if (og + 1u == (tg + 1u) * nx) xb_add(&bar[XB_TOPGEN], 1u);
            else XB_SPIN(xb_ld(&bar[XB_TOPGEN]) == tg, bar);
            __builtin_amdgcn_fence(__ATOMIC_ACQUIRE, "agent");
            xb_add(&bar[XB_XGEN(b.x)], 1u);
            asm volatile("s_waitcnt vmcnt(0)" ::: "memory");
        } else {
            XB_SPIN(xb_ld(&bar[XB_XGEN(b.x)]) == gen, bar);
            __builtin_amdgcn_fence(__ATOMIC_ACQUIRE, "agent");
            asm volatile("s_waitcnt vmcnt(0)" ::: "memory");
        }
    }
    __syncthreads();
}

constexpr int D = 1024, BATCH = 8, SEQ = 2048, NMETA = 16, LTOT = SEQ + NMETA;
constexpr int NREAL = BATCH * SEQ;
constexpr int MROWS = 16640;
constexpr int NROWS_D = NREAL + BATCH * NMETA;
constexpr int IN_W = 12320;
constexpr int RH = 4, RDK = 256, RDV = 512;
constexpr int DH = 8, DDK = 128, DDV = 128;
constexpr int NEXP = 16384, PH = 8, PK = 16;
constexpr int WT_ROWS = 12544, WT_A0 = 0, WT_A_N = 4096, WT_B0 = 4096, WT_B_N = 3328, WT_C0 = 7424, WT_C_N = 5120;
constexpr float LN_EPS = 1e-5f, RMS_EPS = 1e-6f;
constexpr float DN_ALPHA = 1.189207115f;

constexpr size_t MiB = 1u << 20;
constexpr size_t WS_CTL = 0, CTL_ZERO_BYTES = 1 * MiB;
constexpr size_t WS_HB = 1 * MiB;
constexpr size_t WS_WT = WS_HB + (size_t)MROWS * D * 2;
constexpr size_t WS_AR = 58 * MiB;
constexpr size_t WS_END = 264 * MiB;
static_assert(WS_WT + (size_t)WT_ROWS * D * 2 <= WS_AR, "map");
constexpr size_t AR_QKVR = WS_AR;
constexpr size_t AR_RAWD = WS_AR;
constexpr size_t AR_GBETA = WS_AR + 97 * MiB + 512 * 1024;
constexpr size_t AR_QKVD = WS_AR + 100 * MiB;
constexpr size_t AR_OD = WS_AR;
constexpr size_t AR_GRG = WS_AR + 32 * MiB, AR_GDZ = WS_AR + 96 * MiB, AR_GGA = WS_AR + 128 * MiB, AR_GGB = WS_AR + 160 * MiB;
constexpr size_t AR_PRETT = WS_AR + 192 * MiB, AR_PDNT = WS_AR + 196 * MiB, AR_WOUTT = WS_AR + 198 * MiB, AR_W2T = WS_AR + 200 * MiB;
constexpr size_t AR_M1 = WS_AR + 32 * MiB, AR_MERGED = WS_AR + 64 * MiB, AR_PRE = WS_AR + 96 * MiB;
constexpr size_t AR_H1 = WS_AR;
constexpr size_t WS_UB = 1 * MiB, AR_VB = WS_AR + 160 * MiB;
constexpr size_t AR_SCORES = WS_AR + 32 * MiB;
constexpr size_t WS_EXP = WS_WT, WS_GATE = WS_WT + 8 * MiB;
static_assert(AR_QKVD + (size_t)NROWS_D * 3072 * 2 <= WS_END && AR_W2T + 4 * MiB <= WS_END && AR_GBETA + (size_t)MROWS * 32 * 4 <= AR_QKVD, "map");
constexpr int CW_BAR = 4096;

constexpr int RING_BYTES = 131072, MISC_OFF = RING_BYTES + 320, LDS_BYTES = 147456;
constexpr int NWAVES = 8, NTHREADS = 512;

#define GAS __attribute__((address_space(1)))
#define LAS __attribute__((address_space(3)))
typedef unsigned short bf16;
typedef unsigned v4u __attribute__((ext_vector_type(4)));
typedef unsigned v2u __attribute__((ext_vector_type(2)));
typedef float f32x4 __attribute__((ext_vector_type(4)));
#define RLX_AGENT __ATOMIC_RELAXED, __HIP_MEMORY_SCOPE_AGENT

typedef __bf16 bf2_t __attribute__((ext_vector_type(2)));
typedef float f2_t __attribute__((ext_vector_type(2)));
__device__ __forceinline__ unsigned pk2(float lo, float hi) { const f2_t f = {lo, hi}; return __builtin_bit_cast(unsigned, __builtin_convertvector(f, bf2_t)); }
__device__ __forceinline__ unsigned f2bf(float f) { return pk2(f, 0.f) & 0xffffu; }
__device__ __forceinline__ float bflo(unsigned u) { return __builtin_bit_cast(float, u << 16); }
__device__ __forceinline__ float bfhi(unsigned u) { return __builtin_bit_cast(float, u & 0xffff0000u); }
__device__ __forceinline__ float bf2f(bf16 h) { return __builtin_bit_cast(float, ((unsigned)h) << 16); }
__device__ __forceinline__ float sigmoidf_(float x) { return 1.0f / (1.0f + __expf(-x)); }
__device__ __forceinline__ float siluf_(float x) { return x / (1.0f + __expf(-x)); }
__device__ __forceinline__ float wave_sum(float v) {
#pragma unroll
    for (int o = 1; o < 64; o <<= 1) v += __shfl_xor(v, o);
    return v;
}
__device__ __forceinline__ int row_of(int b, int p) { return p < NMETA ? NREAL + p : b * SEQ + (p - NMETA); }
__device__ __forceinline__ int rowd_of(int b, int p) { return p < NMETA ? NREAL + b * NMETA + p : b * SEQ + (p - NMETA); }

struct Args {
    const float *x, *meta, *emb_g, *emb_b, *w_in, *ret_decay, *dn_conv, *dn_a_log, *dn_dt_bias, *dn_norm_g, *p_ret, *p_dn, *w_out, *ln1_g, *ln1_b,
                *peer_wq, *peer_keys, *peer_u, *peer_v, *ln2_g, *ln2_b;
    float* out; unsigned char* ws; int ph_lo, ph_hi, variant, pad_;
};

struct Frame {
    LAS unsigned char* lds;
    int tid, lane, wave, G, gw, NGW;
};

namespace ep {
using pg8::f32x4; using pg8::Unit; using pg8::u32x4; using pg8::cvt_pk_bf16;
__device__ __forceinline__ u32x4 pack8(f32x4 a, f32x4 b) { u32x4 w; w.x = cvt_pk_bf16(a[0], a[1]); w.y = cvt_pk_bf16(a[2], a[3]); w.z = cvt_pk_bf16(b[0], b[1]); w.w = cvt_pk_bf16(b[2], b[3]); return w; }
__device__ __forceinline__ void unpack8(u32x4 w, f32x4& a, f32x4& b) { a = (f32x4){bflo(w.x), bfhi(w.x), bflo(w.y), bfhi(w.y)}; b = (f32x4){bflo(w.z), bfhi(w.z), bflo(w.w), bfhi(w.w)}; }

struct EpiRot {
    static constexpr bool PERM = true, AFTER_DRAIN = false;
    bf16* O;
    __device__ __forceinline__ void operator()(const f32x4 (&acc)[2][2][4][2], const Unit& u, int wr, int wc, int fr, int fq) const {
        const int row0 = u.pm * 256 + wr * 64 + fr, colb = wc * 32 + 8 * fq;
        if (u.pn < 8) {
            const float sc = (u.pn >= 4) ? 0.0625f : 1.0f;
            float rev[8];
#pragma unroll
            for (int e = 0; e < 8; ++e) rev[e] = exp2f(-(float)(colb + e) * (13.287712379549449f / 128.0f)) * 0.15915494309189535f;
#pragma unroll
            for (int ai = 0; ai < 2; ++ai)
#pragma unroll
                for (int m = 0; m < 4; ++m) {
                    const int r = row0 + ai * 128 + m * 16;
                    const float pos = (float)(r < NREAL ? (r & (SEQ - 1)) + NMETA : r - NREAL);
                    f32x4 o1[2], o2[2];
#pragma unroll
                    for (int n = 0; n < 2; ++n)
#pragma unroll
                        for (int e = 0; e < 4; ++e) {
                            float t = pos * rev[n * 4 + e]; t = t - floorf(t);
                            const float s = __builtin_amdgcn_sinf(t), c = __builtin_amdgcn_cosf(t);
                            const float x1 = acc[ai][0][m][n][e], x2 = acc[ai][1][m][n][e];
                            o1[n][e] = (x1 * c - x2 * s) * sc; o2[n][e] = (x1 * s + x2 * c) * sc;
                        }
                    bf16* rowp = O + (size_t)r * 4096 + u.pn * 256 + colb;
                    *(u32x4*)(rowp) = pack8(o1[0], o1[1]);
                    *(u32x4*)(rowp + 128) = pack8(o2[0], o2[1]);
                }
        } else {
#pragma unroll
            for (int ai = 0; ai < 2; ++ai)
#pragma unroll
                for (int m = 0; m < 4; ++m) {
                    bf16* rowp = O + (size_t)(row0 + ai * 128 + m * 16) * 4096 + u.pn * 256 + colb;
#pragma unroll
                    for (int bj = 0; bj < 2; ++bj) *(u32x4*)(rowp + bj * 128) = pack8(acc[ai][bj][m][0], acc[ai][bj][m][1]);
                }
        }
    }
};
struct EpiDn {
    static constexpr bool PERM = true, AFTER_DRAIN = false;
    bf16* O; float* GB; const float* a_log; const float* dt_bias;
    __device__ __forceinline__ void operator()(const f32x4 (&acc)[2][2][4][2], const Unit& u, int wr, int wc, int fr, int fq) const {
        const int row0 = u.pm * 256 + wr * 64 + fr, colb = wc * 32 + 8 * fq;
        if (u.pn < 12) {
#pragma unroll
            for (int ai = 0; ai < 2; ++ai)
#pragma unroll
                for (int m = 0; m < 4; ++m) {
                    bf16* rowp = O + (size_t)(row0 + ai * 128 + m * 16) * 3072 + u.pn * 256 + colb;
#pragma unroll
                    for (int bj = 0; bj < 2; ++bj) *(u32x4*)(rowp + bj * 128) = pack8(acc[ai][bj][m][0], acc[ai][bj][m][1]);
                }
        } else if (wc == 0) {
            float ea[8], db[8];
#pragma unroll
            for (int e = 0; e < 8; ++e) { const int c = (colb + e) & 15; ea[e] = -__expf(a_log[c]); db[e] = dt_bias[c]; }
#pragma unroll
            for (int ai = 0; ai < 2; ++ai)
#pragma unroll
                for (int m = 0; m < 4; ++m) {
                    float* rowp = GB + (size_t)(row0 + ai * 128 + m * 16) * 32 + colb;
                    f32x4 o[2];
#pragma unroll
                    for (int n = 0; n < 2; ++n)
#pragma unroll
                        for (int e = 0; e < 4; ++e) {
                            const float v = acc[ai][0][m][n][e];
                            if (colb < 16) { const float z = v + db[n * 4 + e]; const float sp = z > 20.f ? z : log1pf(__expf(z)); o[n][e] = ea[n * 4 + e] * sp; }
                            else o[n][e] = sigmoidf_(v);
                        }
                    *(f32x4*)(rowp) = o[0]; *(f32x4*)(rowp + 4) = o[1];
                }
        }
    }
};
struct EpiGates {
    static constexpr bool PERM = true, AFTER_DRAIN = false;
    bf16 *rg, *dz, *ga, *gb;
    __device__ __forceinline__ void operator()(const f32x4 (&acc)[2][2][4][2], const Unit& u, int wr, int wc, int fr, int fq) const {
        const int row0 = u.pm * 256 + wr * 64 + fr, colb = wc * 32 + 8 * fq;
        bf16* base; int ld, ct;
        if (u.pn < 8) { base = rg; ld = 2048; ct = u.pn; } else if (u.pn < 12) { base = dz; ld = 1024; ct = u.pn - 8; } else if (u.pn < 16) { base = ga; ld = 1024; ct = u.pn - 12; } else { base = gb; ld = 1024; ct = u.pn - 16; }
#pragma unroll
        for (int ai = 0; ai < 2; ++ai)
#pragma unroll
            for (int m = 0; m < 4; ++m) {
                bf16* rowp = base + (size_t)(row0 + ai * 128 + m * 16) * ld + ct * 256 + colb;
#pragma unroll
                for (int bj = 0; bj < 2; ++bj) *(u32x4*)(rowp + bj * 128) = pack8(acc[ai][bj][m][0], acc[ai][bj][m][1]);
            }
    }
};
template <bool ADD> struct EpiMerge {
    static constexpr bool PERM = true, AFTER_DRAIN = false;
    const bf16* gate; const bf16* prev; bf16* O;
    __device__ __forceinline__ void operator()(const f32x4 (&acc)[2][2][4][2], const Unit& u, int wr, int wc, int fr, int fq) const {
        const int row0 = u.pm * 256 + wr * 64 + fr, colb = u.pn * 256 + wc * 32 + 8 * fq;
#pragma unroll
        for (int ai = 0; ai < 2; ++ai)
#pragma unroll
            for (int m = 0; m < 4; ++m) {
                const size_t off = (size_t)(row0 + ai * 128 + m * 16) * 1024 + colb;
#pragma unroll
                for (int bj = 0; bj < 2; ++bj) {
                    f32x4 g0, g1; unpack8(*(const u32x4*)(gate + off + bj * 128), g0, g1);
                    f32x4 o0, o1;
#pragma unroll
                    for (int e = 0; e < 4; ++e) { o0[e] = sigmoidf_(g0[e]) * acc[ai][bj][m][0][e]; o1[e] = sigmoidf_(g1[e]) * acc[ai][bj][m][1][e]; }
                    if (ADD) { f32x4 p0, p1; unpack8(*(const u32x4*)(prev + off + bj * 128), p0, p1); o0 += p0; o1 += p1; }
                    *(u32x4*)(O + off + bj * 128) = pack8(o0, o1);
                }
            }
    }
};
struct EpiRes {
    static constexpr bool PERM = true, AFTER_DRAIN = false;
    const bf16* H; float* O;
    __device__ __forceinline__ void operator()(const f32x4 (&acc)[2][2][4][2], const Unit& u, int wr, int wc, int fr, int fq) const {
        const int row0 = u.pm * 256 + wr * 64 + fr, colb = u.pn * 256 + wc * 32 + 8 * fq;
#pragma unroll
        for (int ai = 0; ai < 2; ++ai)
#pragma unroll
            for (int m = 0; m < 4; ++m) {
                const size_t off = (size_t)(row0 + ai * 128 + m * 16) * 1024 + colb;
#pragma unroll
                for (int bj = 0; bj < 2; ++bj) {
                    f32x4 h0, h1; unpack8(*(const u32x4*)(H + off + bj * 128), h0, h1);
                    *(f32x4*)(O + off + bj * 128) = h0 * DN_ALPHA + acc[ai][bj][m][0];
                    *(f32x4*)(O + off + bj * 128 + 4) = h1 * DN_ALPHA + acc[ai][bj][m][1];
                }
            }
    }
};
struct EpiF32 {
    static constexpr bool PERM = true, AFTER_DRAIN = false;
    float* O; int ld;
    __device__ __forceinline__ void operator()(const f32x4 (&acc)[2][2][4][2], const Unit& u, int wr, int wc, int fr, int fq) const {
        const int row0 = u.pm * 256 + wr * 64 + fr, colb = u.pn * 256 + wc * 32 + 8 * fq;
#pragma unroll
        for (int ai = 0; ai < 2; ++ai)
#pragma unroll
            for (int m = 0; m < 4; ++m) {
                float* rowp = O + (size_t)(row0 + ai * 128 + m * 16) * ld + colb;
#pragma unroll
                for (int bj = 0; bj < 2; ++bj) { *(f32x4*)(rowp + bj * 128) = acc[ai][bj][m][0]; *(f32x4*)(rowp + bj * 128 + 4) = acc[ai][bj][m][1]; }
            }
    }
};
}

__device__ __forceinline__ void transpose_item(const float* W, int ldsrc, int K, bf16* WT, int k0, int srcn0, int dstn0, LAS float* scr, int lane) {
    if (srcn0 >= 0) {
#pragma unroll 8
        for (int i = 0; i < 32; ++i) { const int kk = 2 * i + (lane >> 5); scr[kk * 33 + (lane & 31)] = W[(size_t)(k0 + kk) * ldsrc + srcn0 + (lane & 31)]; }
    } else {
#pragma unroll 8
        for (int i = 0; i < 32; ++i) { const int kk = 2 * i + (lane >> 5); scr[kk * 33 + (lane & 31)] = 0.f; }
    }
    asm volatile("s_waitcnt lgkmcnt(0)" ::: "memory");
    const int c = lane & 7;
#pragma unroll
    for (int j = 0; j < 4; ++j) { const int n = (lane >> 3) + 8 * j; const LAS float* s = scr + (8 * c) * 33 + n;
        v4u o; o.x = pk2(s[0 * 33], s[1 * 33]); o.y = pk2(s[2 * 33], s[3 * 33]); o.z = pk2(s[4 * 33], s[5 * 33]); o.w = pk2(s[6 * 33], s[7 * 33]);
        *(v4u*)(WT + (size_t)(dstn0 + n) * K + k0 + 8 * c) = o; }
    asm volatile("s_waitcnt lgkmcnt(0)" ::: "memory");
}
__device__ __forceinline__ int wt_src_col(int n0) {
    if (n0 < 4096) return n0;
    if (n0 < 7168) return n0 - 4096 + 6144;
    if (n0 < 7200) return n0 - 7168 + 10240;
    if (n0 < 7424) return -1;
    if (n0 < 9472) return n0 - 7424 + 4096;
    if (n0 < 10496) return n0 - 9472 + 9216;
    if (n0 < 11520) return n0 - 10496 + 10272;
    return n0 - 11520 + 11296;
}
__device__ __forceinline__ void ln_row_affine_bf16(const float* xrow, const float* g, const float* bb, bf16* orow, int lane) {
    const f32x4* xr = (const f32x4*)xrow + lane;
    f32x4 v[4]; float s = 0.f;
#pragma unroll
    for (int j = 0; j < 4; ++j) { v[j] = xr[64 * j]; s += (v[j][0] + v[j][1]) + (v[j][2] + v[j][3]); }
    const float mean = wave_sum(s) * (1.f / D); float s2 = 0.f;
#pragma unroll
    for (int j = 0; j < 4; ++j) { v[j] = v[j] - mean; s2 += (v[j][0] * v[j][0] + v[j][1] * v[j][1]) + (v[j][2] * v[j][2] + v[j][3] * v[j][3]); }
    const float rstd = 1.f / sqrtf(wave_sum(s2) * (1.f / D) + LN_EPS);
    v2u* o8 = (v2u*)orow + lane;
#pragma unroll
    for (int j = 0; j < 4; ++j) { const f32x4 gg = ((const f32x4*)g)[lane + 64 * j], b4 = ((const f32x4*)bb)[lane + 64 * j]; const f32x4 y = v[j] * rstd * gg + b4;
        v2u w; w.x = pk2(y[0], y[1]); w.y = pk2(y[2], y[3]); o8[64 * j] = w; }
}

__device__ __forceinline__ void p0_prologue(const Args& a, Frame& F) {
    LAS float* scr = (LAS float*)(F.lds + F.wave * 16384);
    bf16* HB = (bf16*)(a.ws + WS_HB); bf16* WT = (bf16*)(a.ws + WS_WT);
    constexpr int NB = WT_ROWS / 32, NITEMS = NB * (D / 64);
    for (int it = F.gw; it < NITEMS; it += F.NGW) { const int nb = it % NB, kb = it / NB; transpose_item(a.w_in, IN_W, D, WT, 64 * kb, wt_src_col(32 * nb), 32 * nb, scr, F.lane); }
    for (int r = F.gw; r < MROWS; r += F.NGW) {
        bf16* orow = HB + (size_t)r * D;
        if (r < NREAL) ln_row_affine_bf16(a.x + (size_t)r * D, a.emb_g, a.emb_b, orow, F.lane);
        else if (r < NREAL + NMETA) ln_row_affine_bf16(a.meta + (size_t)(r - NREAL) * D, a.emb_g, a.emb_b, orow, F.lane);
        else { v2u z; z.x = 0u; z.y = 0u; v2u* o8 = (v2u*)orow + F.lane;
#pragma unroll
            for (int j = 0; j < 4; ++j) o8[64 * j] = z; }
    }
}

__device__ __forceinline__ void p2_scan_ret_simple(const Args& a, Frame& F) {
    const bf16* QKV = (const bf16*)(a.ws + AR_QKVR); bf16* OR = (bf16*)a.out;
    constexpr int TG = 8;
    LAS bf16* qt = (LAS bf16*)F.lds; LAS bf16* kt = qt + TG * 256; LAS bf16* vt = kt + TG * 256;
    const int col = 16 * F.wave + (F.lane >> 2), qtr = F.lane & 3;
    for (int u = blockIdx.x; u < BATCH * RH * 4; u += F.G) {
        const int b = u >> 4, h = (u >> 2) & 3, dvb = u & 3;
        for (int pass = 0; pass < 2; ++pass) {
            const int dir = 1 - pass;
            const float gamma = sigmoidf_(a.ret_decay[dir * RH + h]);
            float S[64];
#pragma unroll
            for (int j = 0; j < 64; ++j) S[j] = 0.f;
            const int ntok = dir ? SEQ : LTOT;
            for (int t0 = 0; t0 < ntok; t0 += TG) {
                __syncthreads();
                for (int c = F.tid; c < TG * 80; c += NTHREADS) {
                    const int i = c / 80, w = c % 80; const int t = t0 + i, p = dir ? (LTOT - 1 - t) : t; const size_t rb = (size_t)row_of(b, p) * 4096;
                    if (w < 32) *(LAS v4u*)(qt + i * 256 + w * 8) = *(const v4u*)(QKV + rb + h * 256 + w * 8);
                    else if (w < 64) *(LAS v4u*)(kt + i * 256 + (w - 32) * 8) = *(const v4u*)(QKV + rb + 1024 + h * 256 + (w - 32) * 8);
                    else *(LAS v4u*)(vt + i * 128 + (w - 64) * 8) = *(const v4u*)(QKV + rb + 2048 + h * 512 + dvb * 128 + (w - 64) * 8);
                }
                __syncthreads();
                for (int i = 0; i < TG; ++i) {
                    const float v = bf2f(vt[i * 128 + col]);
                    float o = 0.f;
#pragma unroll
                    for (int j8 = 0; j8 < 8; ++j8) {
                        const v4u kw = *(const LAS v4u*)(kt + i * 256 + qtr * 64 + j8 * 8), qw = *(const LAS v4u*)(qt + i * 256 + qtr * 64 + j8 * 8);
                        const float kk[8] = {bflo(kw.x), bfhi(kw.x), bflo(kw.y), bfhi(kw.y), bflo(kw.z), bfhi(kw.z), bflo(kw.w), bfhi(kw.w)};
                        const float qq[8] = {bflo(qw.x), bfhi(qw.x), bflo(qw.y), bfhi(qw.y), bflo(qw.z), bfhi(qw.z), bflo(qw.w), bfhi(qw.w)};
#pragma unroll
                        for (int e = 0; e < 8; ++e) {
                            float s = S[j8 * 8 + e] * gamma;
                            if (dir == 0) { s += kk[e] * v; o += qq[e] * s; } else { o += qq[e] * s; s += kk[e] * v; }
                            S[j8 * 8 + e] = s;
                        }
                    }
                    o += __shfl_xor(o, 1); o += __shfl_xor(o, 2);
                    const float o2 = __shfl_down(o, 4);
                    const int t = t0 + i, p = dir ? (LTOT - 1 - t) : t;
                    if ((F.lane & 7) == 0 && p >= NMETA) {
                        unsigned* dst = (unsigned*)(OR + (size_t)(b * SEQ + p - NMETA) * 2048 + h * 512 + dvb * 128 + col);
                        float r0 = o, r1 = o2;
                        if (pass == 1) { const unsigned old = __hip_atomic_load(dst, RLX_AGENT); r0 += bflo(old); r1 += bfhi(old); }
                        *dst = pk2(r0, r1);
                    }
                }
            }
        }
    }
}

__device__ __forceinline__ void p4_conv(const Args& a, Frame& F) {
    const bf16* RAW = (const bf16*)(a.ws + AR_RAWD); bf16* QD = (bf16*)(a.ws + AR_QKVD);
    constexpr int NSEG = 65;
    for (int it = F.gw; it < BATCH * 24 * NSEG; it += F.NGW) {
        const int seg = it % NSEG, bs = it / NSEG, slab = bs % 24, b = bs / 24;
        const int p0 = seg * 32, ch = slab * 128 + 2 * F.lane;
        unsigned raw[36];
#pragma unroll
        for (int k = 0; k < 36; ++k) { const int pp = p0 - 2 + k; raw[k] = (pp >= 0 && pp < LTOT) ? *(const unsigned*)(RAW + (size_t)row_of(b, pp) * 3072 + ch) : 0u; }
        float w0[5], w1[5];
#pragma unroll
        for (int j = 0; j < 5; ++j) { const float2 cw = *(const float2*)(a.dn_conv + j * 3072 + ch); w0[j] = cw.x; w1[j] = cw.y; }
        const float qsc = (slab < 8) ? 0.08838834764831845f : 1.0f;
#pragma unroll
        for (int t = 0; t < 32; ++t) {
            float y0 = 0.f, y1 = 0.f;
#pragma unroll
            for (int j = 0; j < 5; ++j) { y0 += w0[j] * bflo(raw[t + j]); y1 += w1[j] * bfhi(raw[t + j]); }
            y0 = siluf_(y0); y1 = siluf_(y1);
            if (slab < 16) { const float ss = wave_sum(y0 * y0 + y1 * y1); const float sc = qsc / sqrtf(ss + RMS_EPS); y0 *= sc; y1 *= sc; }
            const int p = p0 + t;
            if (p < LTOT) *(unsigned*)(QD + (size_t)rowd_of(b, p) * 3072 + ch) = pk2(y0, y1);
        }
    }
}

__device__ __forceinline__ void p5_scan_dn_simple(const Args& a, Frame& F) {
    const bf16* QD = (const bf16*)(a.ws + AR_QKVD); const float* GB = (const float*)(a.ws + AR_GBETA); bf16* OD = (bf16*)(a.ws + AR_OD);
    constexpr int TG = 8;
    LAS bf16* qt = (LAS bf16*)F.lds; LAS bf16* kt = qt + TG * 128; LAS bf16* vt = kt + TG * 128; LAS float* gt = (LAS float*)(vt + TG * 64); LAS float* bt = gt + TG;
    const int cl = 8 * F.wave + (F.lane >> 3), sub = F.lane & 7;
    for (int u = blockIdx.x; u < BATCH * DH * 2; u += F.G) {
        const int b = u >> 4, h = (u >> 1) & 7, dvh = u & 1;
        for (int pass = 0; pass < 2; ++pass) {
            const int dir = 1 - pass;
            float S[16];
#pragma unroll
            for (int j = 0; j < 16; ++j) S[j] = 0.f;
            const int ntok = dir ? SEQ : LTOT;
            for (int t0 = 0; t0 < ntok; t0 += TG) {
                __syncthreads();
                for (int c = F.tid; c < TG * 40; c += NTHREADS) {
                    const int i = c / 40, w = c % 40; const int t = t0 + i, p = dir ? (LTOT - 1 - t) : t; const size_t rb = (size_t)rowd_of(b, p) * 3072;
                    if (w < 16) *(LAS v4u*)(qt + i * 128 + w * 8) = *(const v4u*)(QD + rb + h * 128 + w * 8);
                    else if (w < 32) *(LAS v4u*)(kt + i * 128 + (w - 16) * 8) = *(const v4u*)(QD + rb + 1024 + h * 128 + (w - 16) * 8);
                    else *(LAS v4u*)(vt + i * 64 + (w - 32) * 8) = *(const v4u*)(QD + rb + 2048 + h * 128 + dvh * 64 + (w - 32) * 8);
                }
                if (F.tid < TG) { const int t = t0 + F.tid, p = dir ? (LTOT - 1 - t) : t; const size_t rg = (size_t)row_of(b, p) * 32;
                    gt[F.tid] = GB[rg + dir * 8 + h]; bt[F.tid] = GB[rg + 16 + dir * 8 + h]; }
                __syncthreads();
                for (int i = 0; i < TG; ++i) {
                    const float v = bf2f(vt[i * 64 + cl]);
                    const float ag = __expf(gt[i]), beta = bt[i];
                    const v4u kw0 = *(const LAS v4u*)(kt + i * 128 + sub * 16), kw1 = *(const LAS v4u*)(kt + i * 128 + sub * 16 + 8);
                    const v4u qw0 = *(const LAS v4u*)(qt + i * 128 + sub * 16), qw1 = *(const LAS v4u*)(qt + i * 128 + sub * 16 + 8);
                    const float kk[16] = {bflo(kw0.x), bfhi(kw0.x), bflo(kw0.y), bfhi(kw0.y), bflo(kw0.z), bfhi(kw0.z), bflo(kw0.w), bfhi(kw0.w),
                                          bflo(kw1.x), bfhi(kw1.x), bflo(kw1.y), bfhi(kw1.y), bflo(kw1.z), bfhi(kw1.z), bflo(kw1.w), bfhi(kw1.w)};
                    const float qq[16] = {bflo(qw0.x), bfhi(qw0.x), bflo(qw0.y), bfhi(qw0.y), bflo(qw0.z), bfhi(qw0.z), bflo(qw0.w), bfhi(qw0.w),
                                          bflo(qw1.x), bfhi(qw1.x), bflo(qw1.y), bfhi(qw1.y), bflo(qw1.z), bfhi(qw1.z), bflo(qw1.w), bfhi(qw1.w)};
                    float r = 0.f;
#pragma unroll
                    for (int j = 0; j < 16; ++j) r += S[j] * kk[j];
                    r += __shfl_xor(r, 1); r += __shfl_xor(r, 2); r += __shfl_xor(r, 4);
                    const float vn = beta * (v - ag * r);
                    float o = 0.f;
#pragma unroll
                    for (int j = 0; j < 16; ++j) { S[j] = ag * S[j] + kk[j] * vn; o += S[j] * qq[j]; }
                    o += __shfl_xor(o, 1); o += __shfl_xor(o, 2); o += __shfl_xor(o, 4);
                    const float o2 = __shfl_down(o, 8);
                    const int t = t0 + i, p = dir ? (LTOT - 1 - t) : t;
                    if ((F.lane & 15) == 0 && p >= NMETA) {
                        unsigned* dst = (unsigned*)(OD + (size_t)(b * SEQ + p - NMETA) * 1024 + h * 128 + dvh * 64 + cl);
                        float r0 = o, r1 = o2;
                        if (pass == 1) { const unsigned old = __hip_atomic_load(dst, RLX_AGENT); r0 += bflo(old); r1 += bfhi(old); }
                        *dst = pk2(r0, r1);
                    }
                }
            }
        }
    }
}

__device__ __forceinline__ void p6_small_weights(const Args& a, Frame& F) {
    LAS float* scr = (LAS float*)(F.lds + F.wave * 16384);
    bf16* PRT = (bf16*)(a.ws + AR_PRETT); bf16* PDT = (bf16*)(a.ws + AR_PDNT); bf16* WOT = (bf16*)(a.ws + AR_WOUTT); bf16* W2T = (bf16*)(a.ws + AR_W2T);
    constexpr int I_PR = (2048 / 64) * (1024 / 32), I_PD = (1024 / 64) * (1024 / 32), I_WO = I_PD;
    for (int it = F.gw; it < I_PR + I_PD + I_WO; it += F.NGW) {
        int r = it;
        if (r < I_PR) { transpose_item(a.p_ret, 1024, 2048, PRT, 64 * (r / 32), 32 * (r % 32), 32 * (r % 32), scr, F.lane); continue; } r -= I_PR;
        if (r < I_PD) { transpose_item(a.p_dn, 1024, 1024, PDT, 64 * (r / 32), 32 * (r % 32), 32 * (r % 32), scr, F.lane); continue; } r -= I_PD;
        transpose_item(a.w_out, 1024, 1024, WOT, 64 * (r / 32), 32 * (r % 32), 32 * (r % 32), scr, F.lane);
    }
    for (int it = F.gw; it < 128 * 16; it += F.NGW) {
        const int nt = it >> 4, ks = it & 15, hp = nt >> 3, lane = F.lane, g = lane >> 4, l15 = lane & 15;
        typedef short bfx8_ __attribute__((ext_vector_type(8)));
        bfx8_ kf[4];
#pragma unroll
        for (int sx = 0; sx < 4; ++sx) { const f32x4* p = (const f32x4*)(a.peer_keys + (size_t)(nt * 16 + l15) * 128 + 32 * sx + 8 * g); const f32x4 x = p[0], y = p[1];
            const v4u w = {pk2(x[0], x[1]), pk2(x[2], x[3]), pk2(y[0], y[1]), pk2(y[2], y[3])}; kf[sx] = __builtin_bit_cast(bfx8_, w); }
#pragma unroll
        for (int kt = 0; kt < 4; ++kt) {
            const int k0 = ks * 64 + kt * 16;
            f32x4 acc = (f32x4){0.f, 0.f, 0.f, 0.f};
#pragma unroll
            for (int sx = 0; sx < 4; ++sx) { const f32x4* p = (const f32x4*)(a.peer_wq + (size_t)(k0 + l15) * 2048 + hp * 128 + 32 * sx + 8 * g); const f32x4 x = p[0], y = p[1];
                const v4u w = {pk2(x[0], x[1]), pk2(x[2], x[3]), pk2(y[0], y[1]), pk2(y[2], y[3])};
                acc = __builtin_amdgcn_mfma_f32_16x16x32_bf16(__builtin_bit_cast(bfx8_, w), kf[sx], acc, 0, 0, 0); }
            v2u o; o.x = pk2(acc[0], acc[1]); o.y = pk2(acc[2], acc[3]);
            *(v2u*)(W2T + (size_t)(nt * 16 + l15) * 1024 + k0 + 4 * g) = o;
        }
    }
}

__device__ __forceinline__ void p7_gate_norm(const Args& a, Frame& F) {
    bf16* OR = (bf16*)a.out; bf16* OD = (bf16*)(a.ws + AR_OD); const bf16* GRG = (const bf16*)(a.ws + AR_GRG); const bf16* GDZ = (const bf16*)(a.ws + AR_GDZ);
    for (int it = F.gw; it < NREAL * 5; it += F.NGW) {
        const int r = it / 5, part = it % 5;
        if (part < 4) {
            const size_t off = (size_t)r * 2048 + part * 512 + F.lane * 8;
            f32x4 v0, v1, g0, g1; ep::unpack8(*(const v4u*)(OR + off), v0, v1); ep::unpack8(*(const v4u*)(GRG + off), g0, g1);
            float s = (v0[0] + v0[1]) + (v0[2] + v0[3]) + (v1[0] + v1[1]) + (v1[2] + v1[3]);
            const float mean = wave_sum(s) * (1.f / 512.f);
            v0 = v0 - mean; v1 = v1 - mean;
            float s2 = (v0[0] * v0[0] + v0[1] * v0[1]) + (v0[2] * v0[2] + v0[3] * v0[3]) + (v1[0] * v1[0] + v1[1] * v1[1]) + (v1[2] * v1[2] + v1[3] * v1[3]);
            const float rstd = 1.f / sqrtf(wave_sum(s2) * (1.f / 512.f) + LN_EPS);
#pragma unroll
            for (int e = 0; e < 4; ++e) { v0[e] = v0[e] * rstd * siluf_(g0[e]); v1[e] = v1[e] * rstd * siluf_(g1[e]); }
            *(v4u*)(OR + off) = ep::pack8(v0, v1);
        } else {
#pragma unroll
            for (int hh = 0; hh < 2; ++hh) {
                const size_t off = (size_t)r * 1024 + hh * 512 + F.lane * 8;
                f32x4 v0, v1, g0, g1; ep::unpack8(*(const v4u*)(OD + off), v0, v1); ep::unpack8(*(const v4u*)(GDZ + off), g0, g1);
                float s2 = (v0[0] * v0[0] + v0[1] * v0[1]) + (v0[2] * v0[2] + v0[3] * v0[3]) + (v1[0] * v1[0] + v1[1] * v1[1]) + (v1[2] * v1[2] + v1[3] * v1[3]);
                s2 += __shfl_xor(s2, 1); s2 += __shfl_xor(s2, 2); s2 += __shfl_xor(s2, 4); s2 += __shfl_xor(s2, 8);
                const float rs = 1.f / sqrtf(s2 * (1.f / 128.f) + RMS_EPS);
                const int c = (F.lane & 15) * 8;
                const f32x4 n0 = *(const f32x4*)(a.dn_norm_g + c), n1 = *(const f32x4*)(a.dn_norm_g + c + 4);
#pragma unroll
                for (int e = 0; e < 4; ++e) { v0[e] = v0[e] * rs * n0[e] * siluf_(g0[e]); v1[e] = v1[e] * rs * n1[e] * siluf_(g1[e]); }
                *(v4u*)(OD + off) = ep::pack8(v0, v1);
            }
        }
    }
}

constexpr size_t WS_UB8 = 1 * MiB, WS_SCU = 17 * MiB, WS_SCV = 17 * MiB + 65536, AR_VB8 = WS_AR + 160 * MiB;
typedef __bf16 v32bf_t __attribute__((ext_vector_type(32)));
typedef float v32f_t __attribute__((ext_vector_type(32)));
typedef unsigned v6u_t __attribute__((ext_vector_type(6)));
typedef unsigned v4u_a8 __attribute__((ext_vector_type(4), aligned(8)));
__device__ __forceinline__ void p11_ln1_tables(const Args& a, Frame& F) {
    const float* PRE = (const float*)(a.ws + AR_PRE); bf16* H1 = (bf16*)(a.ws + AR_H1);
    for (int r = F.gw; r < NREAL; r += F.NGW) ln_row_affine_bf16(PRE + (size_t)r * D, a.ln1_g, a.ln1_b, H1 + (size_t)r * D, F.lane);
    const int lp = F.lane & 31, hf = F.lane >> 5;
    for (int it = F.gw; it < NEXP; it += F.NGW) {
        const int r = 2 * it + hf; const bool second = r >= NEXP; const int e = second ? r - NEXP : r;
        const f32x4* src = (const f32x4*)((second ? a.peer_v : a.peer_u) + (size_t)e * D + lp * 32);
        v32f_t x; float am = 0.f;
#pragma unroll
        for (int j = 0; j < 8; ++j) { const f32x4 t = src[j]; x[4 * j] = t[0]; x[4 * j + 1] = t[1]; x[4 * j + 2] = t[2]; x[4 * j + 3] = t[3];
            am = fmaxf(am, fmaxf(fmaxf(fabsf(t[0]), fabsf(t[1])), fmaxf(fabsf(t[2]), fabsf(t[3])))); }
#pragma unroll
        for (int o = 1; o < 32; o <<= 1) am = fmaxf(am, __shfl_xor(am, o));
        int ex = 0; float m = 0.5f; if (am > 0.f) m = frexpf(am, &ex); else ex = 3;
        const int sh = (m > 0.9375f) ? 2 - ex : 3 - ex;
        const float sc = ldexpf(1.0f, sh), isc = ldexpf(1.0f, -sh);
#pragma unroll
        for (int j = 0; j < 32; ++j) x[j] *= sc;
        const v32bf_t xb = __builtin_convertvector(x, v32bf_t);
        const v6u_t p = __builtin_amdgcn_cvt_scalef32_pk32_fp6_bf16(xb, 1.0f);
        unsigned char* dst = a.ws + (second ? AR_VB8 : WS_UB8) + (size_t)e * 768 + lp * 24;
        *(v4u_a8*)dst = (v4u){p[0], p[1], p[2], p[3]}; *(v2u*)(dst + 16) = (v2u){p[4], p[5]};
        if (lp == 0) ((float*)(a.ws + (second ? WS_SCV : WS_SCU)))[e] = isc;
    }
}

__device__ __forceinline__ unsigned ord_key(float v) { const unsigned u = __builtin_bit_cast(unsigned, v); return (u & 0x80000000u) ? ~u : (u | 0x80000000u); }
__device__ __forceinline__ float ord_val(unsigned k) { const unsigned u = (k & 0x80000000u) ? (k & 0x7fffffffu) : ~k; return __builtin_bit_cast(float, u); }
#define DPP_ROR(x, n) ((unsigned)__builtin_amdgcn_update_dpp(0, (int)(x), 0x120 + (n), 0xf, 0xf, false))
__device__ __forceinline__ unsigned row16_max(unsigned m) { m = max(m, DPP_ROR(m, 1)); m = max(m, DPP_ROR(m, 2)); m = max(m, DPP_ROR(m, 4)); m = max(m, DPP_ROR(m, 8)); return m; }
__device__ __forceinline__ float row16_sum(float s) {
    s += __builtin_bit_cast(float, DPP_ROR(__builtin_bit_cast(unsigned, s), 1)); s += __builtin_bit_cast(float, DPP_ROR(__builtin_bit_cast(unsigned, s), 2));
    s += __builtin_bit_cast(float, DPP_ROR(__builtin_bit_cast(unsigned, s), 4)); s += __builtin_bit_cast(float, DPP_ROR(__builtin_bit_cast(unsigned, s), 8)); return s;
}
__device__ __forceinline__ void p13_topk(const Args& a, Frame& F) {
    const float* SC = (const float*)(a.ws + AR_SCORES); int* EXP = (int*)(a.ws + WS_EXP); float* GATE = (float*)(a.ws + WS_GATE);
    LAS float* tops = (LAS float*)(F.lds + F.wave * 2048); LAS int* topi = (LAS int*)(F.lds + F.wave * 2048 + 1024);
    const int q4 = F.lane >> 4, li = F.lane & 15;
    int ci[4], cj[4];
#pragma unroll
    for (int k = 0; k < 4; ++k) { const int t = li * 4 + k; int cnt = 0; ci[k] = -1; cj[k] = 0;
        for (int i = 0; i < 16; ++i) { const int ni = 16 / (i + 1); if (ci[k] < 0 && t < cnt + ni) { ci[k] = i; cj[k] = t - cnt; } cnt += ni; } }
    f32x4 nx[4][2];
    { const float* srow = SC + (size_t)(F.gw < NREAL ? F.gw : 0) * 2048;
#pragma unroll
      for (int it = 0; it < 4; ++it) { nx[it][0] = *(const f32x4*)(srow + (it * 4 + q4) * 128 + li * 8); nx[it][1] = *(const f32x4*)(srow + (it * 4 + q4) * 128 + li * 8 + 4); } }
    for (int tok = F.gw; tok < NREAL; tok += F.NGW) {
        f32x4 cx[4][2];
#pragma unroll
        for (int it = 0; it < 4; ++it) { cx[it][0] = nx[it][0]; cx[it][1] = nx[it][1]; }
        { const int tn = tok + F.NGW < NREAL ? tok + F.NGW : tok; const float* srow = SC + (size_t)tn * 2048;
#pragma unroll
          for (int it = 0; it < 4; ++it) { nx[it][0] = *(const f32x4*)(srow + (it * 4 + q4) * 128 + li * 8); nx[it][1] = *(const f32x4*)(srow + (it * 4 + q4) * 128 + li * 8 + 4); } }
#pragma unroll
        for (int it = 0; it < 4; ++it) {
            const int grp = it * 4 + q4;
            const f32x4 x0 = cx[it][0], x1 = cx[it][1];
            unsigned key[8];
#pragma unroll
            for (int j = 0; j < 8; ++j) { const float v = j < 4 ? x0[j] : x1[j - 4]; key[j] = (ord_key(v) & ~127u) | (unsigned)(127 - (li * 8 + j)); }
            unsigned mine = 0u;
#pragma unroll 4
            for (int rnd = 0; rnd < 16; ++rnd) {
                unsigned m = max(max(max(key[0], key[1]), max(key[2], key[3])), max(max(key[4], key[5]), max(key[6], key[7])));
                m = row16_max(m);
#pragma unroll
                for (int j = 0; j < 8; ++j) key[j] = (key[j] == m) ? 0u : key[j];
                mine = (li == rnd) ? m : mine;
            }
            tops[grp * 16 + li] = ord_val((mine & ~127u) | 64u); topi[grp * 16 + li] = 127 - (int)(mine & 127u);
        }
        asm volatile("s_waitcnt lgkmcnt(0)" ::: "memory");
#pragma unroll 1
        for (int it = 0; it < 2; ++it) {
            const int hh = it * 4 + q4;
            unsigned key[4];
#pragma unroll
            for (int k = 0; k < 4; ++k) { const int i = ci[k] < 0 ? 0 : ci[k]; const float sum = tops[(2 * hh) * 16 + i] + tops[(2 * hh + 1) * 16 + cj[k]];
                key[k] = ci[k] < 0 ? 0u : ((ord_key(sum) & ~255u) | (unsigned)(255 - (i * 16 + cj[k]))); }
            unsigned mine = 0u;
#pragma unroll 4
            for (int rnd = 0; rnd < 16; ++rnd) {
                unsigned m = max(max(key[0], key[1]), max(key[2], key[3]));
                m = row16_max(m);
#pragma unroll
                for (int k = 0; k < 4; ++k) key[k] = (key[k] == m) ? 0u : key[k];
                mine = (li == rnd) ? m : mine;
            }
            const int flat = 255 - (int)(mine & 255u);
            const float best = ord_val((mine & ~255u) | 128u);
            const int i1 = topi[(2 * hh) * 16 + (flat >> 4)], i2 = topi[(2 * hh + 1) * 16 + (flat & 15)];
            const float bmax = __shfl(best, F.lane & 48);
            const float e = __expf(best - bmax);
            const float se = row16_sum(e);
            EXP[(size_t)tok * 128 + hh * 16 + li] = i1 * 128 + i2;
            GATE[(size_t)tok * 128 + hh * 16 + li] = e / se;
        }
        asm volatile("s_waitcnt lgkmcnt(0)" ::: "memory");
    }
}

__device__ __forceinline__ float gelu_exact(float x) { return 0.5f * x * (1.0f + erff(x * 0.70710678118654752f)); }
__device__ __forceinline__ v6u_t ld_fp6(const unsigned char* p) { const v4u a = *(const v4u_a8*)p; const v2u b = *(const v2u*)(p + 16); return (v6u_t){a.x, a.y, a.z, a.w, b.x, b.y}; }
__device__ __forceinline__ void p14_gather(const Args& a, Frame& F) {
    const bf16* H1 = (const bf16*)(a.ws + AR_H1); const int* EXP = (const int*)(a.ws + WS_EXP); const float* GATE = (const float*)(a.ws + WS_GATE);
    const unsigned char* UB = a.ws + WS_UB8; const unsigned char* VB = a.ws + AR_VB8; const float* SCU = (const float*)(a.ws + WS_SCU); const float* SCV = (const float*)(a.ws + WS_SCV);
    const int lane = F.lane, lp = lane & 31, hf = lane >> 5;
    for (int tok = F.gw; tok < NREAL; tok += F.NGW) {
        float x[32], y[32];
        { const v4u* hp = (const v4u*)(H1 + (size_t)tok * D + lp * 32);
#pragma unroll
          for (int q = 0; q < 4; ++q) { const v4u w = hp[q]; const unsigned ww[4] = {w.x, w.y, w.z, w.w};
#pragma unroll
              for (int j = 0; j < 4; ++j) { x[8 * q + 2 * j] = bflo(ww[j]); x[8 * q + 2 * j + 1] = bfhi(ww[j]); } }
#pragma unroll
          for (int j = 0; j < 32; ++j) y[j] = 0.f; }
        const int e0 = EXP[(size_t)tok * 128 + lane], e1 = EXP[(size_t)tok * 128 + 64 + lane];
        const float gv0 = GATE[(size_t)tok * 128 + lane] * SCV[e0], gv1 = GATE[(size_t)tok * 128 + 64 + lane] * SCV[e1];
        const float su0 = SCU[e0], su1 = SCU[e1];
        v6u_t ucur[4];
#pragma unroll 1
        for (int bt = 0; bt < 16; ++bt) {
            v6u_t vv[4];
#pragma unroll
            for (int k = 0; k < 4; ++k) { const int sa = bt * 8 + 2 * k; const int ea = __builtin_amdgcn_readlane(sa < 64 ? e0 : e1, sa & 63), eb = __builtin_amdgcn_readlane(sa < 64 ? e0 : e1, (sa + 1) & 63);
                ucur[k] = ld_fp6(UB + (size_t)(hf ? eb : ea) * 768 + lp * 24); }
#pragma unroll
            for (int k = 0; k < 4; ++k) { const int sa = bt * 8 + 2 * k; const int ea = __builtin_amdgcn_readlane(sa < 64 ? e0 : e1, sa & 63), eb = __builtin_amdgcn_readlane(sa < 64 ? e0 : e1, (sa + 1) & 63);
                vv[k] = ld_fp6(VB + (size_t)(hf ? eb : ea) * 768 + lp * 24); }
            float d[4];
#pragma unroll
            for (int k = 0; k < 4; ++k) {
                const v32f_t r = __builtin_amdgcn_cvt_scalef32_pk32_f32_fp6(ucur[k], 1.0f);
                float s0 = 0.f, s1 = 0.f;
#pragma unroll
                for (int j = 0; j < 16; ++j) { s0 += x[2 * j] * r[2 * j]; s1 += x[2 * j + 1] * r[2 * j + 1]; }
                d[k] = s0 + s1;
            }
            float r2[2], r1;
#pragma unroll
            for (int i = 0; i < 2; ++i) { const bool up = lp & 16; const float keep = up ? d[i + 2] : d[i], send = up ? d[i] : d[i + 2]; r2[i] = keep + __shfl_xor(send, 16); }
            { const bool up = lp & 8; const float keep = up ? r2[1] : r2[0], send = up ? r2[0] : r2[1]; r1 = keep + __shfl_xor(send, 8); }
            r1 += __shfl_xor(r1, 4); r1 += __shfl_xor(r1, 2); r1 += __shfl_xor(r1, 1);
            const int myslot = bt * 8 + 2 * (lp >> 3) + hf;
            const float su = __shfl(myslot < 64 ? su0 : su1, myslot & 63), gv = __shfl(myslot < 64 ? gv0 : gv1, myslot & 63);
            const float wmine = gv * gelu_exact(r1 * su);
#pragma unroll
            for (int k = 0; k < 4; ++k) {
                const float wgt = __shfl(wmine, hf * 32 + 8 * k);
                const v32f_t r = __builtin_amdgcn_cvt_scalef32_pk32_f32_fp6(vv[k], 1.0f);
#pragma unroll
                for (int j = 0; j < 32; ++j) y[j] += wgt * r[j];
            }
        }
        float s = 0.f;
#pragma unroll
        for (int j = 0; j < 32; ++j) { y[j] += __shfl_xor(y[j], 32); y[j] = DN_ALPHA * x[j] + y[j]; s += y[j]; }
#pragma unroll
        for (int o = 1; o < 32; o <<= 1) s += __shfl_xor(s, o);
        const float mean = s * (1.f / D); float s2 = 0.f;
#pragma unroll
        for (int j = 0; j < 32; ++j) { y[j] -= mean; s2 += y[j] * y[j]; }
#pragma unroll
        for (int o = 1; o < 32; o <<= 1) s2 += __shfl_xor(s2, o);
        const float rstd = 1.f / sqrtf(s2 * (1.f / D) + LN_EPS);
#pragma unroll
        for (int q = 0; q < 4; ++q) {
            const int col = lp * 32 + hf * 16 + q * 4;
            const f32x4 gg = *(const f32x4*)(a.ln2_g + col), bb = *(const f32x4*)(a.ln2_b + col);
            f32x4 o;
#pragma unroll
            for (int e = 0; e < 4; ++e) { const float yv = hf ? y[16 + q * 4 + e] : y[q * 4 + e]; o[e] = yv * rstd * gg[e] + bb[e]; }
            *(f32x4*)(a.out + (size_t)tok * D + col) = o;
        }
    }
}

typedef short s16x4 __attribute__((ext_vector_type(4)));
typedef short bfx8 __attribute__((ext_vector_type(8)));
#ifndef R2_STAGGER
#define R2_STAGGER 0
#endif
constexpr int R2_QS = 544, R2_VS = 144, R2_PS = 80;
constexpr int R2_Q = 0, R2_K = 32 * R2_QS, R2_V = 2 * 32 * R2_QS, R2_P = R2_V + 32 * R2_VS, R2_GRP = R2_P + 32 * R2_PS;
__device__ __forceinline__ bfx8 tr16_frag(const LAS unsigned char* p0, const LAS unsigned char* p1) {
    const s16x4 a = __builtin_amdgcn_ds_read_tr16_b64_v4i16((LAS s16x4*)p0), b = __builtin_amdgcn_ds_read_tr16_b64_v4i16((LAS s16x4*)p1);
    return (bfx8){a[0], a[1], a[2], a[3], b[0], b[1], b[2], b[3]};
}
__device__ __forceinline__ bfx8 ld2x8(const LAS unsigned char* p0, const LAS unsigned char* p1) {
    const v2u a = *(const LAS v2u*)p0, b = *(const LAS v2u*)p1; const v4u w = {a.x, a.y, b.x, b.y}; return __builtin_bit_cast(bfx8, w);
}
__device__ __forceinline__ bfx8 pack_acc2(f32x4 a, f32x4 b, float sc) {
    const v4u w = {pk2(a[0] * sc, a[1] * sc), pk2(a[2] * sc, a[3] * sc), pk2(b[0] * sc, b[1] * sc), pk2(b[2] * sc, b[3] * sc)}; return __builtin_bit_cast(bfx8, w);
}
#define MFMA16(a, b, c) __builtin_amdgcn_mfma_f32_16x16x32_bf16((a), (b), (c), 0, 0, 0)

template <int VAR> __device__ __forceinline__ void p2_scan_ret(const Args& a, Frame& F) {
    const bf16* QKV = (const bf16*)(a.ws + AR_QKVR); bf16* OR = (bf16*)a.out;
    const int grp = F.wave >> 2, wq = F.wave & 3, tg = F.tid & 255, lane = F.lane, g = lane >> 4, l15 = lane & 15, q4 = (lane & 15) >> 2, p4 = lane & 3;
    LAS unsigned char* L = F.lds + grp * R2_GRP;
    constexpr int NSTEP = 65;
    if (VAR == 9) return;
    for (int u = blockIdx.x; u < BATCH * RH * 8; u += F.G) {
        const int bh_ = (u & 7) * 4 + ((u >> 3) >> 3), dvs = (u >> 3) & 7, b = bh_ >> 2, h = bh_ & 3;
        for (int i_ = 0; i_ < dvs * R2_STAGGER; ++i_) __builtin_amdgcn_s_sleep(8);
        const float xl = a.ret_decay[grp * RH + h];
        const float lg2 = -log2f(1.0f + __expf(-xl));
        const float gC = exp2f(32.f * lg2);
        f32x4 S[16];
#pragma unroll
        for (int d = 0; d < 16; ++d) S[d] = (f32x4){0.f, 0.f, 0.f, 0.f};
        v4u rqA[4], rkA[4], rvA;
        unsigned long long oldA[2] = {0ull, 0ull};
        const float vscale = exp2f((float)(31 - (tg >> 3)) * lg2);
        const float rs0 = exp2f((float)(l15 - 31) * lg2), rs1 = exp2f((float)(l15 + 16 - 31) * lg2);
#define R2_ROW(st, i, row)    \
        do { if (grp == 0) { if ((st) == 0) row = (i) >= 16 ? NREAL + (i) - 16 : -1; else row = b * SEQ + 32 * ((st) - 1) + (i); } \
             else { if ((st) == 0) row = -1; else row = b * SEQ + 32 * (64 - (st)) + 31 - (i); } } while (0)
#define R2_LOADS(st, rq, rk, rv) do { \
        _Pragma("unroll") for (int i_ = 0; i_ < 4; ++i_) { const int cid = tg + 256 * i_, ti = cid >> 5, c16 = cid & 31; int row; R2_ROW(((VAR == 5 || VAR == 6) ? 1 : (st)), ti, row); \
            if (row >= 0) { const bf16* src = QKV + (size_t)row * 4096 + h * 256 + c16 * 8; rq[i_] = *(const v4u*)src; rk[i_] = *(const v4u*)(src + 1024); } \
            else { rq[i_] = (v4u){0u, 0u, 0u, 0u}; rk[i_] = (v4u){0u, 0u, 0u, 0u}; } } \
        { const int ti = tg >> 3, c16 = tg & 7; int row; R2_ROW(((VAR == 5 || VAR == 6) ? 1 : (st)), ti, row); \
            if (row >= 0) rv = *(const v4u*)(QKV + (size_t)row * 4096 + 2048 + h * 512 + dvs * 64 + c16 * 8); else rv = (v4u){0u, 0u, 0u, 0u}; } } while (0)
#define R2_OLD(st, old) do { _Pragma("unroll") for (int mt_ = 0; mt_ < 2; ++mt_) { int row; R2_ROW(st, 16 * mt_ + l15, row); \
            old[mt_] = __hip_atomic_load((unsigned long long*)(OR + (size_t)row * 2048 + h * 512 + dvs * 64 + 16 * wq + 4 * g), RLX_AGENT); } } while (0)
#define R2_STEP(st, rq, rk, rv, old, oldn, DIST) do { \
              \
            if (VAR == 4 || VAR == 8) { asm volatile("" :: "v"(rq[0]), "v"(rq[1]), "v"(rq[2]), "v"(rq[3]), "v"(rk[0]), "v"(rk[1]), "v"(rk[2]), "v"(rk[3]), "v"(rv)); } \
            if (VAR != 4 && VAR != 8) _Pragma("unroll") for (int i_ = 0; i_ < 4; ++i_) { const int cid = tg + 256 * i_, ti = cid >> 5, c16 = cid & 31; \
                *(LAS v4u*)(L + R2_Q + ti * R2_QS + c16 * 16) = rq[i_]; *(LAS v4u*)(L + R2_K + ti * R2_QS + c16 * 16) = rk[i_]; } \
            if (VAR != 4 && VAR != 8) { const int ti = tg >> 3, c16 = tg & 7; v4u w; \
                w.x = pk2(bflo(rv.x) * vscale, bfhi(rv.x) * vscale); w.y = pk2(bflo(rv.y) * vscale, bfhi(rv.y) * vscale); \
                w.z = pk2(bflo(rv.z) * vscale, bfhi(rv.z) * vscale); w.w = pk2(bflo(rv.w) * vscale, bfhi(rv.w) * vscale); \
                *(LAS v4u*)(L + R2_V + ti * R2_VS + c16 * 16) = w; } \
            __syncthreads(); \
              \
            if (VAR != 1 && (st) >= 33) { R2_OLD(st, old); } \
            if (VAR != 2 && VAR != 7 && VAR != 8 && (st) + (DIST) < NSTEP) { R2_LOADS((st) + (DIST), rq, rk, rv); } \
              \
            if (VAR != 3 && VAR != 5 && VAR != 7 && VAR != 8) { \
                const int mi = wq >> 1, ni = wq & 1; \
                f32x4 pacc = (f32x4){0.f, 0.f, 0.f, 0.f}; \
                const LAS unsigned char* qa = L + R2_Q + (16 * mi + l15) * R2_QS + g * 16; const LAS unsigned char* kb = L + R2_K + (16 * ni + l15) * R2_QS + g * 16; \
                _Pragma("unroll") for (int s_ = 0; s_ < 8; ++s_) pacc = MFMA16(*(const LAS bfx8*)(qa + s_ * 64), *(const LAS bfx8*)(kb + s_ * 64), pacc); \
                const int j = 16 * ni + l15; \
                _Pragma("unroll") for (int r = 0; r < 4; ++r) { const int i = 16 * mi + 4 * g + r; const bool keep = grp == 0 ? (j <= i) : (j < i); \
                    *(LAS bf16*)(L + R2_P + i * R2_PS + j * 2) = (bf16)f2bf(keep ? pacc[r] : 0.f); } \
            } \
            __syncthreads(); \
              \
            if (VAR != 3 && VAR != 5 && VAR != 7 && VAR != 8) { \
            const bfx8 vdf = tr16_frag(L + R2_V + (8 * g + q4) * R2_VS + (16 * wq + 4 * p4) * 2, L + R2_V + (8 * g + 4 + q4) * R2_VS + (16 * wq + 4 * p4) * 2); \
            f32x4 oT[2] = {(f32x4){0.f, 0.f, 0.f, 0.f}, (f32x4){0.f, 0.f, 0.f, 0.f}}; \
            _Pragma("unroll") for (int d = 0; d < 16; ++d) S[d] = S[d] * gC; \
            _Pragma("unroll") for (int sh_ = 0; sh_ < 2; ++sh_) { \
                bfx8 qf[4][2]; \
                _Pragma("unroll") for (int s4 = 0; s4 < 4; ++s4) _Pragma("unroll") for (int mt = 0; mt < 2; ++mt) { \
                    const LAS unsigned char* qp = L + R2_Q + (16 * mt + l15) * R2_QS + (32 * (4 * sh_ + s4) + 4 * g) * 2; qf[s4][mt] = ld2x8(qp, qp + 32); } \
                __builtin_amdgcn_sched_barrier(0); \
                _Pragma("unroll") for (int s4 = 0; s4 < 4; ++s4) { const int s_ = 4 * sh_ + s4; \
                    const bfx8 sf = pack_acc2(S[2 * s_], S[2 * s_ + 1], 1.0f); \
                    oT[0] = MFMA16(sf, qf[s4][0], oT[0]); oT[1] = MFMA16(sf, qf[s4][1], oT[1]); } \
            } \
            _Pragma("unroll") for (int mt = 0; mt < 2; ++mt) oT[mt] = MFMA16(vdf, *(const LAS bfx8*)(L + R2_P + (16 * mt + l15) * R2_PS + g * 16), oT[mt]); \
            _Pragma("unroll") for (int d = 0; d < 16; ++d) { \
                const bfx8 kf = tr16_frag(L + R2_K + (8 * g + q4) * R2_QS + (16 * d + 4 * p4) * 2, L + R2_K + (8 * g + 4 + q4) * R2_QS + (16 * d + 4 * p4) * 2); \
                S[d] = MFMA16(kf, vdf, S[d]); \
            } \
              \
            if (VAR == 1) { asm volatile("" :: "v"(oT[0]), "v"(oT[1])); } \
            if (VAR != 1 && (st) >= 1) { \
                _Pragma("unroll") for (int mt = 0; mt < 2; ++mt) { \
                    int row; R2_ROW(st, 16 * mt + l15, row); \
                    unsigned long long* dst = (unsigned long long*)(OR + (size_t)row * 2048 + h * 512 + dvs * 64 + 16 * wq + 4 * g); \
                    const float rs = mt ? rs1 : rs0; \
                    float o0 = oT[mt][0] * rs, o1 = oT[mt][1] * rs, o2 = oT[mt][2] * rs, o3 = oT[mt][3] * rs; \
                    if ((st) >= 33) { const unsigned lo = (unsigned)old[mt], hi = (unsigned)(old[mt] >> 32); \
                        o0 += bflo(lo); o1 += bfhi(lo); o2 += bflo(hi); o3 += bfhi(hi); } \
                    *dst = (unsigned long long)pk2(o0, o1) | ((unsigned long long)pk2(o2, o3) << 32); \
                } \
            } \
            } \
            if ((st) == 32) asm volatile("s_waitcnt vmcnt(0)" ::: "memory");       \
            __syncthreads(); \
        } while (0)
        R2_LOADS(0, rqA, rkA, rvA);
#pragma unroll 1
        for (int st = 0; st < NSTEP; ++st) { R2_STEP(st, rqA, rkA, rvA, oldA, oldA, 1); }
#undef R2_STEP
#undef R2_OLD
#undef R2_ROW
#undef R2_LOADS
    }
}

constexpr size_t AR_TBUF = WS_AR + 32 * MiB;
constexpr int DN_REC = 4608, DN_NSTEP = 65;
static_assert(AR_TBUF + (size_t)BATCH * DH * 2 * DN_NSTEP * DN_REC <= AR_GBETA, "TBUF fits the dead RAW_D region");

__device__ __forceinline__ void dn_rows(int b, int dir, int st, int i, int& rq, int& rg) {
    if (dir == 0) { if (st == 0) { if (i >= 16) { rq = NREAL + b * NMETA + (i - 16); rg = NREAL + (i - 16); } else { rq = -1; rg = -1; } }
                    else { rq = b * SEQ + 32 * (st - 1) + i; rg = rq; } }
    else { if (st == 0) { rq = -1; rg = -1; } else { rq = b * SEQ + 32 * (64 - st) + 31 - i; rg = rq; } }
}

__device__ __forceinline__ void p4b_dn_tinv(const Args& a, Frame& F) {
    const bf16* QD = (const bf16*)(a.ws + AR_QKVD); const float* GB = (const float*)(a.ws + AR_GBETA); unsigned char* TB = a.ws + AR_TBUF;
    LAS float* Am = (LAS float*)(F.lds + F.wave * 4352);
    const int lane = F.lane, g = lane >> 4, l15 = lane & 15;
    for (int idx = F.gw; idx < BATCH * DH * 2 * DN_NSTEP; idx += F.NGW) {
        const int st = idx % DN_NSTEP, bhd = idx / DN_NSTEP, dir = bhd & 1, h = (bhd >> 1) & 7, b = bhd >> 4;
        if (dir == 1 && st == 0) continue;
        float gi = 0.f, bi = 0.f;
        { int rq, rg; dn_rows(b, dir, st, lane & 31, rq, rg); if (rg >= 0) { gi = GB[(size_t)rg * 32 + dir * 8 + h]; bi = GB[(size_t)rg * 32 + 16 + dir * 8 + h]; } }
        float bc = gi;
#pragma unroll
        for (int off = 1; off < 32; off <<= 1) { const float t = __shfl_up(bc, off); if ((lane & 31) >= off) bc += t; }
        bfx8 kf[2][4];
#pragma unroll
        for (int mi = 0; mi < 2; ++mi) { int rq, rg; dn_rows(b, dir, st, 16 * mi + l15, rq, rg);
#pragma unroll
            for (int s = 0; s < 4; ++s) { if (rq >= 0) kf[mi][s] = *(const bfx8*)(QD + (size_t)rq * 3072 + 1024 + h * 128 + 32 * s + 8 * g); else kf[mi][s] = (bfx8){0, 0, 0, 0, 0, 0, 0, 0}; } }
#pragma unroll
        for (int mi = 0; mi < 2; ++mi)
#pragma unroll
            for (int ni = 0; ni < 2; ++ni) {
                f32x4 acc = (f32x4){0.f, 0.f, 0.f, 0.f};
#pragma unroll
                for (int s = 0; s < 4; ++s) acc = MFMA16(kf[mi][s], kf[ni][s], acc);
                const int j = 16 * ni + l15; const float bj = __shfl(bc, j);
#pragma unroll
                for (int r = 0; r < 4; ++r) { const int i = 16 * mi + 4 * g + r; const float bi_ = __shfl(bc, i), be = __shfl(bi, i);
                    Am[i * 33 + j] = (i > j) ? be * acc[r] * __expf(bi_ - bj) : 0.f; }
            }
        asm volatile("s_waitcnt lgkmcnt(0)" ::: "memory");
        float T[32];
        const int c = lane & 31;
#pragma unroll
        for (int i = 0; i < 32; ++i) {
            float s0 = (i == c) ? 1.f : 0.f, s1 = 0.f;
#pragma unroll
            for (int j = 0; j < i; ++j) { const float av = Am[i * 33 + j]; if (j & 1) s1 -= av * T[j]; else s0 -= av * T[j]; }
            T[i] = s0 + s1;
        }
        unsigned char* rec = TB + (size_t)idx * DN_REC;
        const float csc = bi * __expf(bc);
        if (lane < 32) {
#pragma unroll
            for (int i = 0; i < 32; ++i) { ((bf16*)rec)[i * 32 + c] = (bf16)f2bf(T[i]); ((bf16*)(rec + 2048))[i * 32 + c] = (bf16)f2bf(T[i] * csc); }
            ((float*)(rec + 4096))[c] = bc; ((float*)(rec + 4224))[c] = bi;
        }
        asm volatile("s_waitcnt lgkmcnt(0)" ::: "memory");
    }
}

constexpr int D5_QS = 288, D5_VS = 144, D5_TS = 80;
constexpr int D5_Q = 0, D5_K = 9216, D5_V = 18432, D5_T = 23040, D5_T2 = 25600, D5_A = 28160, D5_W = 30720, D5_VEC = 39936, D5_GRP = 40192;
__device__ __forceinline__ void p5_scan_dn(const Args& a, Frame& F) {
    const bf16* QD = (const bf16*)(a.ws + AR_QKVD); const unsigned char* TB = a.ws + AR_TBUF; bf16* OD = (bf16*)(a.ws + AR_OD);
    const int grp = F.wave >> 2, wq = F.wave & 3, tg = F.tid & 255, lane = F.lane, g = lane >> 4, l15 = lane & 15, q4 = (lane & 15) >> 2, p4 = lane & 3;
    LAS unsigned char* L = F.lds + grp * D5_GRP;
    const LAS float* bcv = (const LAS float*)(L + D5_VEC);
    for (int u = blockIdx.x; u < BATCH * DH * 2; u += F.G) {
        const int bh_ = (u & 7) * 8 + ((u >> 3) >> 1), dvh = (u >> 3) & 1, b = bh_ >> 3, h = bh_ & 7;
        const unsigned char* recbase = TB + (size_t)(((b * DH + h) * 2 + grp) * DN_NSTEP) * DN_REC;
        f32x4 S[8];
#pragma unroll
        for (int d = 0; d < 8; ++d) S[d] = (f32x4){0.f, 0.f, 0.f, 0.f};
        v4u rqA[2], rkA[2], rvA, rtA, rvecA, rqB[2], rkB[2], rvB, rtB, rvecB; float rbetaA, rbetaB;
        unsigned long long oldA[2] = {0ull, 0ull}, oldB[2] = {0ull, 0ull};
#define D5_LOADS(st, rq, rk, rv, rt, rvec, rbeta) do { \
        _Pragma("unroll") for (int i_ = 0; i_ < 2; ++i_) { const int cid = tg + 256 * i_, ti = cid >> 4, c16 = cid & 15; int r_, rg_; dn_rows(b, grp, (st), ti, r_, rg_); \
            if (r_ >= 0) { const bf16* src = QD + (size_t)r_ * 3072 + h * 128 + c16 * 8; rq[i_] = *(const v4u*)src; rk[i_] = *(const v4u*)(src + 1024); } \
            else { rq[i_] = (v4u){0u, 0u, 0u, 0u}; rk[i_] = (v4u){0u, 0u, 0u, 0u}; } } \
        { const int ti = tg >> 3, c16 = tg & 7; int r_, rg_; dn_rows(b, grp, (st), ti, r_, rg_); \
            if (r_ >= 0) rv = *(const v4u*)(QD + (size_t)r_ * 3072 + 2048 + h * 128 + dvh * 64 + c16 * 8); else rv = (v4u){0u, 0u, 0u, 0u}; } \
        if (grp == 0 || (st) >= 1) { const unsigned char* rec = recbase + (size_t)(st) * DN_REC; rt = *(const v4u*)(rec + tg * 16); rbeta = *(const float*)(rec + 4224 + (tg >> 3) * 4); \
            if (tg < 16) rvec = *(const v4u*)(rec + 4096 + tg * 16); } \
        else { rt = (v4u){0u, 0u, 0u, 0u}; rbeta = 0.f; rvec = (v4u){0u, 0u, 0u, 0u}; } } while (0)
#define D5_OLD(st, old) do { _Pragma("unroll") for (int mt_ = 0; mt_ < 2; ++mt_) { int row, rg_; dn_rows(b, grp, (st), 16 * mt_ + l15, row, rg_); \
            old[mt_] = __hip_atomic_load((unsigned long long*)(OD + (size_t)row * 1024 + h * 128 + dvh * 64 + 16 * wq + 4 * g), RLX_AGENT); } } while (0)
#define D5_STEP(st, rq, rk, rv, rt, rvec, rbeta, old, oldn) do { \
              \
            _Pragma("unroll") for (int i_ = 0; i_ < 2; ++i_) { const int cid = tg + 256 * i_, ti = cid >> 4, c16 = cid & 15; \
                *(LAS v4u*)(L + D5_Q + ti * D5_QS + c16 * 16) = rq[i_]; *(LAS v4u*)(L + D5_K + ti * D5_QS + c16 * 16) = rk[i_]; } \
            { const int ti = tg >> 3, c16 = tg & 7; v4u w; \
                w.x = pk2(bflo(rv.x) * rbeta, bfhi(rv.x) * rbeta); w.y = pk2(bflo(rv.y) * rbeta, bfhi(rv.y) * rbeta); \
                w.z = pk2(bflo(rv.z) * rbeta, bfhi(rv.z) * rbeta); w.w = pk2(bflo(rv.w) * rbeta, bfhi(rv.w) * rbeta); \
                *(LAS v4u*)(L + D5_V + ti * D5_VS + c16 * 16) = w; } \
            { const int tsel = tg >> 7, c = tg & 127; *(LAS v4u*)(L + (tsel ? D5_T2 : D5_T) + (c >> 2) * D5_TS + (c & 3) * 16) = rt; } \
            if (tg < 16) *(LAS v4u*)(L + D5_VEC + tg * 16) = rvec; \
            __syncthreads(); \
            if ((st) == 33) { D5_OLD(33, old); } \
            if ((st) + 1 >= 34 && (st) + 1 < DN_NSTEP) { D5_OLD((st) + 1, oldn); } \
            if ((st) + 2 < DN_NSTEP) { D5_LOADS((st) + 2, rq, rk, rv, rt, rvec, rbeta); } \
              \
            { \
                const int mi = wq >> 1, ni = wq & 1; \
                f32x4 pacc = (f32x4){0.f, 0.f, 0.f, 0.f}; \
                const LAS unsigned char* qa = L + D5_Q + (16 * mi + l15) * D5_QS + g * 16; const LAS unsigned char* kb = L + D5_K + (16 * ni + l15) * D5_QS + g * 16; \
                _Pragma("unroll") for (int s_ = 0; s_ < 4; ++s_) pacc = MFMA16(*(const LAS bfx8*)(qa + s_ * 64), *(const LAS bfx8*)(kb + s_ * 64), pacc); \
                const int j = 16 * ni + l15; const float bj = bcv[j]; \
                _Pragma("unroll") for (int r = 0; r < 4; ++r) { const int i = 16 * mi + 4 * g + r; \
                    *(LAS bf16*)(L + D5_A + i * D5_TS + j * 2) = (bf16)f2bf((j <= i) ? pacc[r] * __expf(bcv[i] - bj) : 0.f); } \
                _Pragma("unroll") for (int dd = 0; dd < 2; ++dd) { const int d = 2 * wq + dd; \
                    const bfx8 kf = tr16_frag(L + D5_K + (8 * g + q4) * D5_QS + (16 * d + 4 * p4) * 2, L + D5_K + (8 * g + 4 + q4) * D5_QS + (16 * d + 4 * p4) * 2); \
                    _Pragma("unroll") for (int mt = 0; mt < 2; ++mt) { \
                        f32x4 wacc = MFMA16(kf, *(const LAS bfx8*)(L + D5_T2 + (16 * mt + l15) * D5_TS + g * 16), ((f32x4){0.f, 0.f, 0.f, 0.f})); \
                        v2u w; w.x = pk2(-wacc[0], -wacc[1]); w.y = pk2(-wacc[2], -wacc[3]); \
                        *(LAS v2u*)(L + D5_W + (16 * mt + l15) * D5_QS + (16 * d + 4 * g) * 2) = w; \
                    } \
                } \
            } \
            __syncthreads(); \
              \
            const float blast = bcv[31], eL = __expf(blast); \
            const bfx8 vf = tr16_frag(L + D5_V + (8 * g + q4) * D5_VS + (16 * wq + 4 * p4) * 2, L + D5_V + (8 * g + 4 + q4) * D5_VS + (16 * wq + 4 * p4) * 2); \
            f32x4 vn[2], o1[2]; \
            _Pragma("unroll") for (int mt = 0; mt < 2; ++mt) { vn[mt] = MFMA16(*(const LAS bfx8*)(L + D5_T + (16 * mt + l15) * D5_TS + g * 16), vf, ((f32x4){0.f, 0.f, 0.f, 0.f})); o1[mt] = (f32x4){0.f, 0.f, 0.f, 0.f}; } \
            _Pragma("unroll") for (int s_ = 0; s_ < 4; ++s_) { \
                const bfx8 sf = pack_acc2(S[2 * s_], S[2 * s_ + 1], 1.0f); \
                _Pragma("unroll") for (int mt = 0; mt < 2; ++mt) { \
                    const LAS unsigned char* wp = L + D5_W + (16 * mt + l15) * D5_QS + (32 * s_ + 4 * g) * 2; const LAS unsigned char* qp = L + D5_Q + (16 * mt + l15) * D5_QS + (32 * s_ + 4 * g) * 2; \
                    vn[mt] = MFMA16(ld2x8(wp, wp + 32), sf, vn[mt]); \
                    o1[mt] = MFMA16(sf, ld2x8(qp, qp + 32), o1[mt]); \
                } \
            } \
            const bfx8 vnf = pack_acc2(vn[0], vn[1], 1.0f); \
            f32x4 vs0, vs1; \
            _Pragma("unroll") for (int r = 0; r < 4; ++r) { vs0[r] = vn[0][r] * __expf(blast - bcv[4 * g + r]); vs1[r] = vn[1][r] * __expf(blast - bcv[16 + 4 * g + r]); } \
            const bfx8 vnsf = pack_acc2(vs0, vs1, 1.0f); \
            f32x4 o2[2]; \
            _Pragma("unroll") for (int mt = 0; mt < 2; ++mt) { const LAS unsigned char* ap = L + D5_A + (16 * mt + l15) * D5_TS + (4 * g) * 2; o2[mt] = MFMA16(vnf, ld2x8(ap, ap + 32), ((f32x4){0.f, 0.f, 0.f, 0.f})); } \
            _Pragma("unroll") for (int d = 0; d < 8; ++d) { \
                const bfx8 kp = tr16_frag(L + D5_K + (4 * g + q4) * D5_QS + (16 * d + 4 * p4) * 2, L + D5_K + (16 + 4 * g + q4) * D5_QS + (16 * d + 4 * p4) * 2); \
                S[d] = MFMA16(kp, vnsf, S[d] * eL); \
            } \
              \
            if ((st) >= 1) { \
                _Pragma("unroll") for (int mt = 0; mt < 2; ++mt) { \
                    const int i = 16 * mt + l15; int row, rg_; dn_rows(b, grp, (st), i, row, rg_); \
                    unsigned long long* dst = (unsigned long long*)(OD + (size_t)row * 1024 + h * 128 + dvh * 64 + 16 * wq + 4 * g); \
                    const float ei = __expf(bcv[i]); \
                    float x0 = o1[mt][0] * ei + o2[mt][0], x1 = o1[mt][1] * ei + o2[mt][1], x2 = o1[mt][2] * ei + o2[mt][2], x3 = o1[mt][3] * ei + o2[mt][3]; \
                    if ((st) >= 33) { const unsigned lo = (unsigned)old[mt], hi = (unsigned)(old[mt] >> 32); \
                        x0 += bflo(lo); x1 += bfhi(lo); x2 += bflo(hi); x3 += bfhi(hi); } \
                    *dst = (unsigned long long)pk2(x0, x1) | ((unsigned long long)pk2(x2, x3) << 32); \
                } \
            } \
            if ((st) == 32) asm volatile("s_waitcnt vmcnt(0)" ::: "memory"); \
            __syncthreads(); \
        } while (0)
        D5_LOADS(0, rqA, rkA, rvA, rtA, rvecA, rbetaA);
        D5_LOADS(1, rqB, rkB, rvB, rtB, rvecB, rbetaB);
#pragma unroll 1
        for (int st = 0; st < DN_NSTEP; st += 2) {
            D5_STEP(st, rqA, rkA, rvA, rtA, rvecA, rbetaA, oldA, oldB);
            if (st + 1 < DN_NSTEP) { D5_STEP(st + 1, rqB, rkB, rvB, rtB, rvecB, rbetaB, oldB, oldA); }
        }
#undef D5_STEP
#undef D5_OLD
#undef D5_LOADS
    }
}

#ifndef PROBE_VARIANT
#define PROBE_VARIANT 0
#endif
#ifndef PROBE_PHASE
#define PROBE_PHASE -1
#endif

constexpr int NPHASES = 16;
__global__ void __launch_bounds__(NTHREADS, 2) fwd_kernel(Args args) {
    extern __shared__ __attribute__((aligned(16))) unsigned char lds_raw[];
    Frame F;
    F.lds = (LAS unsigned char*)lds_raw;
    F.tid = threadIdx.x; F.lane = F.tid & 63; F.wave = __builtin_amdgcn_readfirstlane(F.tid >> 6);
    F.G = gridDim.x; F.gw = blockIdx.x * NWAVES + F.wave; F.NGW = F.G * NWAVES;
    volatile LAS unsigned* MISC = (volatile LAS unsigned*)(F.lds + MISC_OFF);
    for (int u = F.tid; u < (LDS_BYTES - RING_BYTES) / 4; u += NTHREADS) ((LAS unsigned*)(F.lds + RING_BYTES))[u] = 0u;
    __syncthreads();
    unsigned* ctl = (unsigned*)(args.ws + WS_CTL);
    const int lo = args.ph_lo, hi = args.ph_hi;
    XcdBarrier bar; bar.bar = ctl + CW_BAR; bar.x = 0; bar.st = nullptr;
    if (hi - lo > 1) bar = xcd_barrier_post(ctl + CW_BAR, MISC + 8);
#define IN(k) (lo <= (k) && (k) < hi)
#define SEAM(k) do { if (IN(k) && IN((k) + 1)) xcd_barrier(bar); } while (0)
    unsigned char* ws = args.ws;
    bf16* HB = (bf16*)(ws + WS_HB); bf16* WT = (bf16*)(ws + WS_WT);

    if (IN(0)) { p0_prologue(args, F); } SEAM(0);
    if (IN(1)) {
        pg8::Gemm g{HB, WT + (size_t)WT_A0 * D, MROWS, WT_A_N, D}; pg8::StaticOrder S; S.init(MROWS, WT_A_N, F.G, (int)blockIdx.x);
        ep::EpiRot E{(bf16*)(ws + AR_QKVR)};
        pg8::gemm_phase<ep::EpiRot, pg8::StaticOrder, true, true>(F.lds, g, S, E);
    } SEAM(1);
    if (IN(2)) { if (args.variant == 0) p2_scan_ret<0>(args, F); else p2_scan_ret<PROBE_VARIANT>(args, F); } SEAM(2);
    if (IN(3)) {
        pg8::Gemm g{HB, WT + (size_t)WT_B0 * D, MROWS, WT_B_N, D}; pg8::StaticOrder S; S.init(MROWS, WT_B_N, F.G, (int)blockIdx.x);
        ep::EpiDn E{(bf16*)(ws + AR_RAWD), (float*)(ws + AR_GBETA), args.dn_a_log, args.dn_dt_bias};
        pg8::gemm_phase<ep::EpiDn, pg8::StaticOrder, true, true>(F.lds, g, S, E);
    } SEAM(3);
    if (IN(4)) { p4_conv(args, F); } SEAM(4);
    if (IN(5)) { p4b_dn_tinv(args, F); } SEAM(5);
    if (IN(6)) { p5_scan_dn(args, F); } SEAM(6);
    if (IN(7)) {
        p6_small_weights(args, F);
        __syncthreads();
        pg8::Gemm g{HB, WT + (size_t)WT_C0 * D, NREAL, WT_C_N, D}; pg8::StaticOrder S; S.init(NREAL, WT_C_N, F.G, (int)blockIdx.x);
        ep::EpiGates E{(bf16*)(ws + AR_GRG), (bf16*)(ws + AR_GDZ), (bf16*)(ws + AR_GGA), (bf16*)(ws + AR_GGB)};
        pg8::gemm_phase<ep::EpiGates, pg8::StaticOrder, true, true>(F.lds, g, S, E);
    } SEAM(7);
    if (IN(8)) { p7_gate_norm(args, F); } SEAM(8);
    if (IN(9)) {
        pg8::Gemm g{(const bf16*)args.out, (const bf16*)(ws + AR_PRETT), NREAL, 1024, 2048}; pg8::StaticOrder S; S.init(NREAL, 1024, F.G, (int)blockIdx.x);
        ep::EpiMerge<false> E{(const bf16*)(ws + AR_GGA), nullptr, (bf16*)(ws + AR_M1)};
        pg8::gemm_phase<ep::EpiMerge<false>, pg8::StaticOrder, true, true>(F.lds, g, S, E);
    } SEAM(9);
    if (IN(10)) {
        pg8::Gemm g{(const bf16*)(ws + AR_OD), (const bf16*)(ws + AR_PDNT), NREAL, 1024, 1024}; pg8::StaticOrder S; S.init(NREAL, 1024, F.G, (int)blockIdx.x);
        ep::EpiMerge<true> E{(const bf16*)(ws + AR_GGB), (const bf16*)(ws + AR_M1), (bf16*)(ws + AR_MERGED)};
        pg8::gemm_phase<ep::EpiMerge<true>, pg8::StaticOrder, true, true>(F.lds, g, S, E);
    } SEAM(10);
    if (IN(11)) {
        pg8::Gemm g{(const bf16*)(ws + AR_MERGED), (const bf16*)(ws + AR_WOUTT), NREAL, 1024, 1024}; pg8::StaticOrder S; S.init(NREAL, 1024, F.G, (int)blockIdx.x);
        ep::EpiRes E{HB, (float*)(ws + AR_PRE)};
        pg8::gemm_phase<ep::EpiRes, pg8::StaticOrder, true, true>(F.lds, g, S, E);
    } SEAM(11);
    if (IN(12)) { p11_ln1_tables(args, F); } SEAM(12);
    if (IN(13)) {
        pg8::Gemm g{(const bf16*)(ws + AR_H1), (const bf16*)(ws + AR_W2T), NREAL, 2048, 1024}; pg8::StaticOrder S; S.init(NREAL, 2048, F.G, (int)blockIdx.x);
        ep::EpiF32 E{(float*)(ws + AR_SCORES), 2048};
        pg8::gemm_phase<ep::EpiF32, pg8::StaticOrder, true, true>(F.lds, g, S, E);
    } SEAM(13);
    if (IN(14)) { p13_topk(args, F); } SEAM(14);
    if (IN(15)) { p14_gather(args, F); }
#undef IN
#undef SEAM
}

#ifndef N_LAUNCH_MODE
#define N_LAUNCH_MODE 1
#endif
extern "C" void kernel_launch(void* const* d_in, const int* in_sizes, int n_in, void* d_out, int out_size, void* d_ws, size_t ws_size, hipStream_t stream) {
    static int grid = 0;
    if (grid == 0) {
        if (n_in != 21 || out_size != NREAL * D || ws_size < WS_END) { fprintf(stderr, "kernel_launch: unexpected shapes (n_in %d, out %d, ws %zu)\n", n_in, out_size, ws_size); grid = -1; return; }
        int dev = 0, cus = 0;
        if (hipGetDevice(&dev) != hipSuccess || hipDeviceGetAttribute(&cus, hipDeviceAttributeMultiprocessorCount, dev) != hipSuccess) { grid = -1; return; }
        if (hipFuncSetAttribute((const void*)fwd_kernel, hipFuncAttributeMaxDynamicSharedMemorySize, LDS_BYTES) != hipSuccess) { grid = -1; return; }
        int per_cu = 0;
        (void)hipOccupancyMaxActiveBlocksPerMultiprocessor(&per_cu, (const void*)fwd_kernel, NTHREADS, LDS_BYTES);
        (void)hipGetLastError();
        grid = cus;
    }
    if (grid < 0) return;
    (void)hipMemsetAsync((char*)d_ws + WS_CTL, 0, CTL_ZERO_BYTES, stream);
    Args a{};
    const float** fp = (const float**)&a;
    for (int i = 0; i < 21; ++i) fp[i] = (const float*)d_in[i];
    a.out = (float*)d_out; a.ws = (unsigned char*)d_ws;
    if (N_LAUNCH_MODE == 1) {
#if PROBE_PHASE >= 0 && PROBE_PHASE < 13
        a.ph_lo = PROBE_PHASE; a.ph_hi = PROBE_PHASE + 1; a.variant = 1;
        hipLaunchKernelGGL(fwd_kernel, dim3(grid), dim3(NTHREADS), LDS_BYTES, stream, a);
        a.variant = 0;
#endif
        a.ph_lo = 0; a.ph_hi = NPHASES;
        hipLaunchKernelGGL(fwd_kernel, dim3(grid), dim3(NTHREADS), LDS_BYTES, stream, a);
#if PROBE_PHASE >= 13
        a.ph_lo = PROBE_PHASE; a.ph_hi = PROBE_PHASE + 1;
        hipLaunchKernelGGL(fwd_kernel, dim3(grid), dim3(NTHREADS), LDS_BYTES, stream, a);
#endif
    } else {
        for (int p = 0; p < NPHASES; ++p) { a.ph_lo = p; a.ph_hi = p + 1; hipLaunchKernelGGL(fwd_kernel, dim3(grid), dim3(NTHREADS), LDS_BYTES, stream, a); }
    }
}
```

```cpp
#include <hip/hip_runtime.h>
#include <cstdio>
#include <cstdint>
namespace pg8 {
#define PG8_LAS __attribute__((address_space(3)))
typedef unsigned short bf16_t;
typedef short bf16x8 __attribute__((ext_vector_type(8)));
typedef float f32x4 __attribute__((ext_vector_type(4)));
typedef unsigned u32x4 __attribute__((ext_vector_type(4)));
constexpr int BM = 256, BK = 64, HALF = 128, HTB = HALF * BK * 2  , STAGE_BYTES = 8 * HTB, NXCD = 8, WGM = 8;

__host__ __device__ __forceinline__ int lds_byte(int r, int c) { const int st = (r >> 4) * 2 + (c >> 5), rr = r & 15, cc = c & 31, ob = rr * 64 + cc * 2; return st * 1024 + (ob ^ (((ob >> 9) & 1) << 5)); }
__host__ __device__ __forceinline__ void stage_rc(int b, int& R, int& C) { const int st = b / 1024, sb = b % 1024, swz = sb ^ (((sb >> 9) & 1) << 5); R = (st >> 1) * 16 + swz / 64; C = (st & 1) * 32 + (swz % 64) / 2; }
__host__ __device__ __forceinline__ int perm32(int rho) { const int n = rho >> 4, i = rho & 15; return 8 * (i >> 2) + 4 * n + (i & 3); }

struct Unit { int pm, pn; };
struct Gemm { const bf16_t* A; const bf16_t* Bt; int M, N, K; };

struct StaticOrder {
    int nM, nN, nwg, G, c;
    __host__ __device__ void init(int M, int N, int G_, int c_) { nM = M / BM; nN = N / BM; nwg = nM * nN; G = G_; c = c_; }
    __host__ __device__ bool next(int i, Unit& u) const {
        const long L = (long)i * G + c; if (L >= nwg) return false;
        int wgid = (int)L; { const int q = nwg / NXCD, r = nwg % NXCD, xcd = wgid % NXCD, off = wgid / NXCD; wgid = (xcd < r ? xcd * (q + 1) : r * (q + 1) + (xcd - r) * q) + off; }
        const int nig = WGM * nN, gid = wgid / nig, fm = gid * WGM, gsz = (nM - fm) < WGM ? (nM - fm) : WGM;
        u.pm = fm + ((wgid % nig) % gsz); u.pn = (wgid % nig) / gsz; return true;
    }
    __device__ __forceinline__ void a_ready(const Unit&) const {}
    __device__ __forceinline__ void done(const Unit&) const {}
};
__device__ __forceinline__ unsigned cvt_pk_bf16(float lo, float hi) { unsigned r; asm volatile("v_cvt_pk_bf16_f32 %0, %1, %2" : "=v"(r) : "v"(lo), "v"(hi)); return r; }
template <class Epi, class Sched, bool ALIGN_EPI = false, bool SP2 = false>
__device__ __forceinline__ void gemm_phase(PG8_LAS unsigned char* lds, const Gemm g, const Sched& S, const Epi& E) {
    const int tid = threadIdx.x, wid = __builtin_amdgcn_readfirstlane(tid >> 6), lane = tid & 63, wr = wid >> 2, wc = wid & 3, fr = lane & 15, fq = lane >> 4;
    const int K = g.K, nt = K / BK;
    unsigned voffA[2], voffB[2];
#pragma unroll
    for (int i = 0; i < 2; ++i) { int R, C; stage_rc(tid * 16 + i * 8192, R, C); const int Rb = Epi::PERM ? ((R & ~31) + perm32(R & 31)) : R;
        voffA[i] = (unsigned)(R * K + C) * 2u; voffB[i] = (unsigned)(Rb * K + C) * 2u; }
    const size_t kstep = (size_t)(BK * 2);
    const size_t hstep = (size_t)HALF * K * 2;
    const size_t tstep = 2 * hstep;
    const unsigned ldsw = (unsigned)wid * 1024u;
    const int aoff = lds_byte(wr * 64 + fr, fq * 8), boff = lds_byte(wc * 32 + fr, fq * 8);
#define PG8_SA(b, h) (((b) * 2 + (h)) * HTB)
#define PG8_SB(b, h) ((4 + (b) * 2 + (h)) * HTB)
#define PG8_STAGE(bufoff, gbase, voff) do { _Pragma("unroll") for (int _i = 0; _i < 2; ++_i) \
        __builtin_amdgcn_global_load_lds((const unsigned*)((const char*)(gbase) + (voff)[_i]), (PG8_LAS unsigned*)(lds + (bufoff) + ldsw + _i * 8192), 16, 0, 0); } while (0)
#define PG8_LDA(dst, b, h) do { _Pragma("unroll") for (int m = 0; m < 4; ++m) _Pragma("unroll") for (int k = 0; k < 2; ++k) dst[m][k] = *(const PG8_LAS bf16x8*)(lds + PG8_SA(b, h) + aoff + m * 2048 + k * 1024); } while (0)
#define PG8_LDB(dst, b, h) do { _Pragma("unroll") for (int n = 0; n < 2; ++n) _Pragma("unroll") for (int k = 0; k < 2; ++k) dst[n][k] = *(const PG8_LAS bf16x8*)(lds + PG8_SB(b, h) + boff + n * 2048 + k * 1024); } while (0)
#define PG8_MMA(ai, bj, At, Bt) do { __builtin_amdgcn_s_setprio(1); _Pragma("unroll") for (int m = 0; m < 4; ++m) _Pragma("unroll") for (int n = 0; n < 2; ++n) _Pragma("unroll") for (int k = 0; k < 2; ++k) \
        acc[ai][bj][m][n] = __builtin_amdgcn_mfma_f32_16x16x32_bf16(Bt[n][k], At[m][k], acc[ai][bj][m][n], 0, 0, 0); __builtin_amdgcn_s_setprio(0); } while (0)
#define PG8_WAIT_V(n) asm volatile("s_waitcnt vmcnt(" #n ")" ::: "memory")
#define PG8_WAIT_L(n) asm volatile("s_waitcnt lgkmcnt(" #n ")" ::: "memory")
#define PG8_BAR __builtin_amdgcn_s_barrier()
#define PG8_SCHED __builtin_amdgcn_sched_barrier(0)
    Unit cur, nxt; int ui = 0;
    if (!S.next(0, cur)) return;
    f32x4 acc[2][2][4][2];
#pragma unroll
    for (int a = 0; a < 2; ++a)
#pragma unroll
        for (int b = 0; b < 2; ++b)
#pragma unroll
            for (int m = 0; m < 4; ++m)
#pragma unroll
                for (int n = 0; n < 2; ++n) acc[a][b][m][n] = (f32x4){0.f, 0.f, 0.f, 0.f};
    bf16x8 At[4][2], B0[2][2], B1[2][2];
    const char* cA = (const char*)g.A + (size_t)cur.pm * tstep; const char* cB = (const char*)g.Bt + (size_t)cur.pn * tstep;
    S.a_ready(cur);
    if constexpr (SP2) {
        PG8_STAGE(PG8_SB(0, 0), cB, voffB); PG8_STAGE(PG8_SB(0, 1), cB + hstep, voffB); PG8_STAGE(PG8_SA(0, 0), cA, voffA); PG8_STAGE(PG8_SA(0, 1), cA + hstep, voffA);
        if (wr == 1) PG8_BAR;
        PG8_WAIT_V(2); PG8_BAR;
        PG8_STAGE(PG8_SB(1, 0), cB + kstep, voffB); PG8_STAGE(PG8_SA(1, 0), cA + kstep, voffA); PG8_STAGE(PG8_SB(1, 1), cB + hstep + kstep, voffB);
        PG8_WAIT_V(6); PG8_BAR;
    } else {
        PG8_STAGE(PG8_SB(0, 0), cB, voffB); PG8_STAGE(PG8_SA(0, 0), cA, voffA); PG8_STAGE(PG8_SB(0, 1), cB + hstep, voffB); PG8_STAGE(PG8_SA(0, 1), cA + hstep, voffA);
        if (wr == 1) PG8_BAR;
        PG8_WAIT_V(4); PG8_BAR;
        PG8_STAGE(PG8_SB(1, 0), cB + kstep, voffB); PG8_STAGE(PG8_SA(1, 0), cA + kstep, voffA); PG8_STAGE(PG8_SB(1, 1), cB + hstep + kstep, voffB);
        PG8_WAIT_V(6); PG8_BAR;
    }
    for (;;) {
        const bool has_next = S.next(ui + 1, nxt);
        const char* nA = has_next ? (const char*)g.A + (size_t)nxt.pm * tstep : cA; const char* nB = has_next ? (const char*)g.Bt + (size_t)nxt.pn * tstep : cB;
        for (int t = 0; t < nt; t += 2) {
            const bool last = (t == nt - 2);
            const char* a1 = cA + (size_t)(t + 1) * kstep;
            const char* a2 = last ? nA : cA + (size_t)(t + 2) * kstep; const char* b2 = last ? nB : cB + (size_t)(t + 2) * kstep;
            const char* a3 = a2 + kstep; const char* b3 = b2 + kstep;
            if (last && has_next) S.a_ready(nxt);
            if constexpr (SP2) {
            PG8_LDB(B0, 0, 0); PG8_LDB(B1, 0, 1); PG8_SCHED; PG8_LDA(At, 0, 0); PG8_STAGE(PG8_SA(1, 1), a1 + hstep, voffA);
            PG8_WAIT_V(8); PG8_WAIT_L(0); PG8_BAR; PG8_MMA(0, 0, At, B0); PG8_MMA(0, 1, At, B1); PG8_BAR; PG8_SCHED;
            PG8_LDA(At, 0, 1); PG8_STAGE(PG8_SB(0, 0), b2, voffB); PG8_STAGE(PG8_SB(0, 1), b2 + hstep, voffB); PG8_STAGE(PG8_SA(0, 0), a2, voffA);
            PG8_WAIT_V(8); PG8_WAIT_L(0); PG8_BAR; PG8_MMA(1, 0, At, B0); PG8_MMA(1, 1, At, B1); PG8_BAR; PG8_SCHED;
            PG8_LDB(B0, 1, 0); PG8_LDB(B1, 1, 1); PG8_SCHED; PG8_LDA(At, 1, 0); PG8_STAGE(PG8_SA(0, 1), a2 + hstep, voffA);
            PG8_WAIT_V(8); PG8_WAIT_L(0); PG8_BAR; PG8_MMA(0, 0, At, B0); PG8_MMA(0, 1, At, B1); PG8_BAR; PG8_SCHED;
            PG8_LDA(At, 1, 1); PG8_STAGE(PG8_SB(1, 0), b3, voffB); PG8_STAGE(PG8_SB(1, 1), b3 + hstep, voffB); PG8_STAGE(PG8_SA(1, 0), a3, voffA);
            PG8_WAIT_V(8); PG8_WAIT_L(0); PG8_BAR; PG8_MMA(1, 0, At, B0); PG8_MMA(1, 1, At, B1); PG8_BAR; PG8_SCHED;
            } else {
            PG8_LDB(B0, 0, 0); PG8_SCHED; PG8_LDA(At, 0, 0); PG8_STAGE(PG8_SA(1, 1), a1 + hstep, voffA);
            PG8_WAIT_L(8); PG8_BAR; PG8_WAIT_L(0); PG8_MMA(0, 0, At, B0); PG8_BAR; PG8_SCHED;
            PG8_LDB(B1, 0, 1); PG8_STAGE(PG8_SB(0, 0), b2, voffB);
            PG8_BAR; PG8_WAIT_L(0); PG8_MMA(0, 1, At, B1); PG8_BAR;
            PG8_LDA(At, 0, 1); PG8_STAGE(PG8_SA(0, 0), a2, voffA);
            PG8_BAR; PG8_WAIT_L(0); PG8_MMA(1, 0, At, B0); PG8_BAR; PG8_SCHED;
            PG8_STAGE(PG8_SB(0, 1), b2 + hstep, voffB);
            PG8_WAIT_V(6); PG8_BAR; PG8_MMA(1, 1, At, B1); PG8_BAR;
            PG8_LDB(B0, 1, 0); PG8_SCHED; PG8_LDA(At, 1, 0); PG8_STAGE(PG8_SA(0, 1), a2 + hstep, voffA);
            PG8_WAIT_L(8); PG8_BAR; PG8_WAIT_L(0); PG8_MMA(0, 0, At, B0); PG8_BAR; PG8_SCHED;
            PG8_LDB(B1, 1, 1); PG8_STAGE(PG8_SB(1, 0), b3, voffB);
            PG8_BAR; PG8_WAIT_L(0); PG8_MMA(0, 1, At, B1); PG8_BAR;
            PG8_LDA(At, 1, 1); PG8_STAGE(PG8_SA(1, 0), a3, voffA);
            PG8_BAR; PG8_WAIT_L(0); PG8_MMA(1, 0, At, B0); PG8_BAR; PG8_SCHED;
            PG8_STAGE(PG8_SB(1, 1), b3 + hstep, voffB);
            PG8_WAIT_V(6); PG8_BAR; PG8_MMA(1, 1, At, B1); PG8_BAR;
            }
        }
        if constexpr (ALIGN_EPI) { if (wr == 0) PG8_BAR; }
        if constexpr (!Epi::AFTER_DRAIN) { E(acc, cur, wr, wc, fr, fq); S.done(cur); }
        if (!has_next) break;
#pragma unroll
        for (int a = 0; a < 2; ++a)
#pragma unroll
            for (int b = 0; b < 2; ++b)
#pragma unroll
                for (int m = 0; m < 4; ++m)
#pragma unroll
                    for (int n = 0; n < 2; ++n) acc[a][b][m][n] = (f32x4){0.f, 0.f, 0.f, 0.f};
        cur = nxt; cA = nA; cB = nB; ++ui;
        if constexpr (ALIGN_EPI) { if (wr == 1) PG8_BAR; }
    }
    PG8_WAIT_V(0);
    if constexpr (!ALIGN_EPI) { if (wr == 0) PG8_BAR; }
    PG8_BAR;
    if constexpr (Epi::AFTER_DRAIN) { E.fused(acc, cur, wr, wc, fr, fq, lds, wid, lane); S.done(cur); }
#undef PG8_SA
#undef PG8_SB
#undef PG8_STAGE
#undef PG8_LDA
#undef PG8_LDB
#undef PG8_MMA
#undef PG8_WAIT_V
#undef PG8_WAIT_L
#undef PG8_BAR
#undef PG8_SCHED
}
}
#define XB_TMO      128
#define XB_XCNT(j)  (256  + 64 * (j))
#define XB_XSUB(j)  (1280 + 64 * (j))
#define XB_XGEN(j)  (2304 + 64 * (j))
#define XB_TOP      3328
#define XB_TOPGEN   3392
#define XCD_BAR_WORDS 3456
#define XB_SPIN_CAP (1u << 18)
#define LAS __attribute__((address_space(3)))

__device__ __forceinline__ unsigned xb_ld(unsigned* p)              { return __hip_atomic_load(p, __ATOMIC_RELAXED, __HIP_MEMORY_SCOPE_AGENT); }
__device__ __forceinline__ unsigned xb_add(unsigned* p, unsigned v) { return __hip_atomic_fetch_add(p, v, __ATOMIC_RELAXED, __HIP_MEMORY_SCOPE_AGENT); }
__device__ __forceinline__ unsigned xb_xcc_id() { return (unsigned)__builtin_amdgcn_s_getreg((3 << 11) | 20) & 0xFu; }
#define XB_SPIN(cond, bar) do { unsigned _sp = 0; while (cond) { __builtin_amdgcn_s_sleep(1); \
    if ((++_sp & 255u) == 0u) { if (xb_ld(&(bar)[XB_TMO])) break; if (_sp > XB_SPIN_CAP) { atomicAdd(&(bar)[XB_TMO], 1u); break; } } } } while (0)

struct XcdBarrier {
    unsigned* bar; unsigned x;
    volatile LAS unsigned* st;
};

__device__ __forceinline__ XcdBarrier xcd_barrier_post(unsigned* bar, volatile LAS unsigned* st) {
    XcdBarrier b; b.bar = bar; b.x = xb_xcc_id(); b.st = st;
    if (threadIdx.x == 0) (void)xb_add(&bar[XB_XCNT(b.x)], 1u);
    return b;
}
__device__ __forceinline__ void xcd_barrier_complete(unsigned* bar, unsigned x, unsigned& nloc, unsigned& nx) {
    const unsigned G = gridDim.x * gridDim.y * gridDim.z;
    unsigned sum, cnt, mine, sp = 0u;
    for (;;) {
        sum = 0u; cnt = 0u; mine = 0u;
#pragma unroll
        for (unsigned j = 0; j < 16; ++j) { const unsigned c = xb_ld(&bar[XB_XCNT(j)]); sum += c; cnt += (c > 0u) ? 1u : 0u; mine = (j == x) ? c : mine; }
        if (sum == G) break;
        __builtin_amdgcn_s_sleep(1);
        if ((++sp & 255u) == 0u) { if (xb_ld(&bar[XB_TMO])) break; if (sp > XB_SPIN_CAP) { atomicAdd(&bar[XB_TMO], 1u); break; } }
    }
    nloc = mine > 0u ? mine : 1u; nx = cnt > 0u ? cnt : 1u;
}

__device__ __forceinline__ void xcd_barrier(const XcdBarrier& b) {
    asm volatile("s_waitcnt vmcnt(0)" ::: "memory");
    __syncthreads();
    if (threadIdx.x == 0) {
        unsigned* bar = b.bar;
        __builtin_amdgcn_s_waitcnt(0);
        unsigned nloc = b.st[0], nx = b.st[1];
        if (nloc == 0u) { xcd_barrier_complete(bar, b.x, nloc, nx); b.st[0] = nloc; b.st[1] = nx; }
        const unsigned old = xb_add(&bar[XB_XSUB(b.x)], 1u);
        const unsigned gen = old / nloc;
        if (old + 1u == (gen + 1u) * nloc) {
            __builtin_amdgcn_fence(__ATOMIC_RELEASE, "agent");
            asm volatile("s_waitcnt vmcnt(0)" ::: "memory");
            const unsigned og = xb_add(&bar[XB_TOP], 1u);
            const unsigned tg = og / nx;
            if (og + 1u == (tg + 1u) * nx) xb_add(&bar[XB_TOPGEN], 1u);
            else XB_SPIN(xb_ld(&bar[XB_TOPGEN]) == tg, bar);
            __builtin_amdgcn_fence(__ATOMIC_ACQUIRE, "agent");
            xb_add(&bar[XB_XGEN(b.x)], 1u);
            asm volatile("s_waitcnt vmcnt(0)" ::: "memory");
        } else {
            XB_SPIN(xb_ld(&bar[XB_XGEN(b.x)]) == gen, bar);
            __builtin_amdgcn_fence(__ATOMIC_ACQUIRE, "agent");
            asm volatile("s_waitcnt vmcnt(0)" ::: "memory");
        }
    }
    __syncthreads();
}

constexpr int D = 1024, BATCH = 8, SEQ = 2048, NMETA = 16, LTOT = SEQ + NMETA;
constexpr int NREAL = BATCH * SEQ;
constexpr int MROWS = 16640;
constexpr int NROWS_D = NREAL + BATCH * NMETA;
constexpr int IN_W = 12320;
constexpr int RH = 4, RDK = 256, RDV = 512;
constexpr int DH = 8, DDK = 128, DDV = 128;
constexpr int NEXP = 16384, PH = 8, PK = 16;
constexpr int WT_ROWS = 12544, WT_A0 = 0, WT_A_N = 4096, WT_B0 = 4096, WT_B_N = 3328, WT_C0 = 7424, WT_C_N = 5120;
constexpr float LN_EPS = 1e-5f, RMS_EPS = 1e-6f;
constexpr float DN_ALPHA = 1.189207115f;

constexpr size_t MiB = 1u << 20;
constexpr size_t WS_CTL = 0, CTL_ZERO_BYTES = 1 * MiB;
constexpr size_t WS_HB = 1 * MiB;
constexpr size_t WS_WT = WS_HB + (size_t)MROWS * D * 2;
constexpr size_t WS_AR = 58 * MiB;
constexpr size_t WS_END = 264 * MiB;
static_assert(WS_WT + (size_t)WT_ROWS * D * 2 <= WS_AR, "map");
constexpr size_t AR_QKVR = WS_AR;
constexpr size_t AR_RAWD = WS_AR;
constexpr size_t AR_GBETA = WS_AR + 97 * MiB + 512 * 1024;
constexpr size_t AR_QKVD = WS_AR + 100 * MiB;
constexpr size_t AR_OD = WS_AR;
constexpr size_t AR_GRG = WS_AR + 32 * MiB, AR_GDZ = WS_AR + 96 * MiB, AR_GGA = WS_AR + 128 * MiB, AR_GGB = WS_AR + 160 * MiB;
constexpr size_t AR_PRETT = WS_AR + 192 * MiB, AR_PDNT = WS_AR + 196 * MiB, AR_WOUTT = WS_AR + 198 * MiB, AR_W2T = WS_AR + 200 * MiB;
constexpr size_t AR_M1 = WS_AR + 32 * MiB, AR_MERGED = WS_AR + 64 * MiB, AR_PRE = WS_AR + 96 * MiB;
constexpr size_t AR_H1 = WS_AR;
constexpr size_t WS_UB = 1 * MiB, AR_VB = WS_AR + 160 * MiB;
constexpr size_t AR_SCORES = WS_AR + 32 * MiB;
constexpr size_t WS_EXP = WS_WT, WS_GATE = WS_WT + 8 * MiB;
static_assert(AR_QKVD + (size_t)NROWS_D * 3072 * 2 <= WS_END && AR_W2T + 4 * MiB <= WS_END && AR_GBETA + (size_t)MROWS * 32 * 4 <= AR_QKVD, "map");
constexpr int CW_BAR = 4096;

constexpr int RING_BYTES = 131072, MISC_OFF = RING_BYTES + 320, LDS_BYTES = 147456;
constexpr int NWAVES = 8, NTHREADS = 512;

#define GAS __attribute__((address_space(1)))
#define LAS __attribute__((address_space(3)))
typedef unsigned short bf16;
typedef unsigned v4u __attribute__((ext_vector_type(4)));
typedef unsigned v2u __attribute__((ext_vector_type(2)));
typedef float f32x4 __attribute__((ext_vector_type(4)));
#define RLX_AGENT __ATOMIC_RELAXED, __HIP_MEMORY_SCOPE_AGENT

typedef __bf16 bf2_t __attribute__((ext_vector_type(2)));
typedef float f2_t __attribute__((ext_vector_type(2)));
__device__ __forceinline__ unsigned pk2(float lo, float hi) { const f2_t f = {lo, hi}; return __builtin_bit_cast(unsigned, __builtin_convertvector(f, bf2_t)); }
__device__ __forceinline__ unsigned f2bf(float f) { return pk2(f, 0.f) & 0xffffu; }
__device__ __forceinline__ float bflo(unsigned u) { return __builtin_bit_cast(float, u << 16); }
__device__ __forceinline__ float bfhi(unsigned u) { return __builtin_bit_cast(float, u & 0xffff0000u); }
__device__ __forceinline__ float bf2f(bf16 h) { return __builtin_bit_cast(float, ((unsigned)h) << 16); }
__device__ __forceinline__ float sigmoidf_(float x) { return 1.0f / (1.0f + __expf(-x)); }
__device__ __forceinline__ float siluf_(float x) { return x / (1.0f + __expf(-x)); }
__device__ __forceinline__ float wave_sum(float v) {
#pragma unroll
    for (int o = 1; o < 64; o <<= 1) v += __shfl_xor(v, o);
    return v;
}
__device__ __forceinline__ int row_of(int b, int p) { return p < NMETA ? NREAL + p : b * SEQ + (p - NMETA); }
__device__ __forceinline__ int rowd_of(int b, int p) { return p < NMETA ? NREAL + b * NMETA + p : b * SEQ + (p - NMETA); }

struct Args {
    const float *x, *meta, *emb_g, *emb_b, *w_in, *ret_decay, *dn_conv, *dn_a_log, *dn_dt_bias, *dn_norm_g, *p_ret, *p_dn, *w_out, *ln1_g, *ln1_b,
                *peer_wq, *peer_keys, *peer_u, *peer_v, *ln2_g, *ln2_b;
    float* out; unsigned char* ws; int ph_lo, ph_hi, variant, pad_;
};

struct Frame {
    LAS unsigned char* lds;
    int tid, lane, wave, G, gw, NGW;
};

namespace ep {
using pg8::f32x4; using pg8::Unit; using pg8::u32x4; using pg8::cvt_pk_bf16;
__device__ __forceinline__ u32x4 pack8(f32x4 a, f32x4 b) { u32x4 w; w.x = cvt_pk_bf16(a[0], a[1]); w.y = cvt_pk_bf16(a[2], a[3]); w.z = cvt_pk_bf16(b[0], b[1]); w.w = cvt_pk_bf16(b[2], b[3]); return w; }
__device__ __forceinline__ void unpack8(u32x4 w, f32x4& a, f32x4& b) { a = (f32x4){bflo(w.x), bfhi(w.x), bflo(w.y), bfhi(w.y)}; b = (f32x4){bflo(w.z), bfhi(w.z), bflo(w.w), bfhi(w.w)}; }

struct EpiRot {
    static constexpr bool PERM = true, AFTER_DRAIN = false;
    bf16* O;
    __device__ __forceinline__ void operator()(const f32x4 (&acc)[2][2][4][2], const Unit& u, int wr, int wc, int fr, int fq) const {
        const int row0 = u.pm * 256 + wr * 64 + fr, colb = wc * 32 + 8 * fq;
        if (u.pn < 8) {
            const float sc = (u.pn >= 4) ? 0.0625f : 1.0f;
            float rev[8];
#pragma unroll
            for (int e = 0; e < 8; ++e) rev[e] = exp2f(-(float)(colb + e) * (13.287712379549449f / 128.0f)) * 0.15915494309189535f;
#pragma unroll
            for (int ai = 0; ai < 2; ++ai)
#pragma unroll
                for (int m = 0; m < 4; ++m) {
                    const int r = row0 + ai * 128 + m * 16;
                    const float pos = (float)(r < NREAL ? (r & (SEQ - 1)) + NMETA : r - NREAL);
                    f32x4 o1[2], o2[2];
#pragma unroll
                    for (int n = 0; n < 2; ++n)
#pragma unroll
                        for (int e = 0; e < 4; ++e) {
                            float t = pos * rev[n * 4 + e]; t = t - floorf(t);
                            const float s = __builtin_amdgcn_sinf(t), c = __builtin_amdgcn_cosf(t);
                            const float x1 = acc[ai][0][m][n][e], x2 = acc[ai][1][m][n][e];
                            o1[n][e] = (x1 * c - x2 * s) * sc; o2[n][e] = (x1 * s + x2 * c) * sc;
                        }
                    bf16* rowp = O + (size_t)r * 4096 + u.pn * 256 + colb;
                    *(u32x4*)(rowp) = pack8(o1[0], o1[1]);
                    *(u32x4*)(rowp + 128) = pack8(o2[0], o2[1]);
                }
        } else {
#pragma unroll
            for (int ai = 0; ai < 2; ++ai)
#pragma unroll
                for (int m = 0; m < 4; ++m) {
                    bf16* rowp = O + (size_t)(row0 + ai * 128 + m * 16) * 4096 + u.pn * 256 + colb;
#pragma unroll
                    for (int bj = 0; bj < 2; ++bj) *(u32x4*)(rowp + bj * 128) = pack8(acc[ai][bj][m][0], acc[ai][bj][m][1]);
                }
        }
    }
};
struct EpiDn {
    static constexpr bool PERM = true, AFTER_DRAIN = false;
    bf16* O; float* GB; const float* a_log; const float* dt_bias;
    __device__ __forceinline__ void operator()(const f32x4 (&acc)[2][2][4][2], const Unit& u, int wr, int wc, int fr, int fq) const {
        const int row0 = u.pm * 256 + wr * 64 + fr, colb = wc * 32 + 8 * fq;
        if (u.pn < 12) {
#pragma unroll
            for (int ai = 0; ai < 2; ++ai)
#pragma unroll
                for (int m = 0; m < 4; ++m) {
                    bf16* rowp = O + (size_t)(row0 + ai * 128 + m * 16) * 3072 + u.pn * 256 + colb;
#pragma unroll
                    for (int bj = 0; bj < 2; ++bj) *(u32x4*)(rowp + bj * 128) = pack8(acc[ai][bj][m][0], acc[ai][bj][m][1]);
                }
        } else if (wc == 0) {
            float ea[8], db[8];
#pragma unroll
            for (int e = 0; e < 8; ++e) { const int c = (colb + e) & 15; ea[e] = -__expf(a_log[c]); db[e] = dt_bias[c]; }
#pragma unroll
            for (int ai = 0; ai < 2; ++ai)
#pragma unroll
                for (int m = 0; m < 4; ++m) {
                    float* rowp = GB + (size_t)(row0 + ai * 128 + m * 16) * 32 + colb;
                    f32x4 o[2];
#pragma unroll
                    for (int n = 0; n < 2; ++n)
#pragma unroll
                        for (int e = 0; e < 4; ++e) {
                            const float v = acc[ai][0][m][n][e];
                            if (colb < 16) { const float z = v + db[n * 4 + e]; const float sp = z > 20.f ? z : log1pf(__expf(z)); o[n][e] = ea[n * 4 + e] * sp; }
                            else o[n][e] = sigmoidf_(v);
                        }
                    *(f32x4*)(rowp) = o[0]; *(f32x4*)(rowp + 4) = o[1];
                }
        }
    }
};
struct EpiGates {
    static constexpr bool PERM = true, AFTER_DRAIN = false;
    bf16 *rg, *dz, *ga, *gb;
    __device__ __forceinline__ void operator()(const f32x4 (&acc)[2][2][4][2], const Unit& u, int wr, int wc, int fr, int fq) const {
        const int row0 = u.pm * 256 + wr * 64 + fr, colb = wc * 32 + 8 * fq;
        bf16* base; int ld, ct;
        if (u.pn < 8) { base = rg; ld = 2048; ct = u.pn; } else if (u.pn < 12) { base = dz; ld = 1024; ct = u.pn - 8; } else if (u.pn < 16) { base = ga; ld = 1024; ct = u.pn - 12; } else { base = gb; ld = 1024; ct = u.pn - 16; }
#pragma unroll
        for (int ai = 0; ai < 2; ++ai)
#pragma unroll
            for (int m = 0; m < 4; ++m) {
                bf16* rowp = base + (size_t)(row0 + ai * 128 + m * 16) * ld + ct * 256 + colb;
#pragma unroll
                for (int bj = 0; bj < 2; ++bj) *(u32x4*)(rowp + bj * 128) = pack8(acc[ai][bj][m][0], acc[ai][bj][m][1]);
            }
    }
};
template <bool ADD> struct EpiMerge {
    static constexpr bool PERM = true, AFTER_DRAIN = false;
    const bf16* gate; const bf16* prev; bf16* O;
    __device__ __forceinline__ void operator()(const f32x4 (&acc)[2][2][4][2], const Unit& u, int wr, int wc, int fr, int fq) const {
        const int row0 = u.pm * 256 + wr * 64 + fr, colb = u.pn * 256 + wc * 32 + 8 * fq;
#pragma unroll
        for (int ai = 0; ai < 2; ++ai)
#pragma unroll
            for (int m = 0; m < 4; ++m) {
                const size_t off = (size_t)(row0 + ai * 128 + m * 16) * 1024 + colb;
#pragma unroll
                for (int bj = 0; bj < 2; ++bj) {
                    f32x4 g0, g1; unpack8(*(const u32x4*)(gate + off + bj * 128), g0, g1);
                    f32x4 o0, o1;
#pragma unroll
                    for (int e = 0; e < 4; ++e) { o0[e] = sigmoidf_(g0[e]) * acc[ai][bj][m][0][e]; o1[e] = sigmoidf_(g1[e]) * acc[ai][bj][m][1][e]; }
                    if (ADD) { f32x4 p0, p1; unpack8(*(const u32x4*)(prev + off + bj * 128), p0, p1); o0 += p0; o1 += p1; }
                    *(u32x4*)(O + off + bj * 128) = pack8(o0, o1);
                }
            }
    }
};
struct EpiRes {
    static constexpr bool PERM = true, AFTER_DRAIN = false;
    const bf16* H; float* O;
    __device__ __forceinline__ void operator()(const f32x4 (&acc)[2][2][4][2], const Unit& u, int wr, int wc, int fr, int fq) const {
        const int row0 = u.pm * 256 + wr * 64 + fr, colb = u.pn * 256 + wc * 32 + 8 * fq;
#pragma unroll
        for (int ai = 0; ai < 2; ++ai)
#pragma unroll
            for (int m = 0; m < 4; ++m) {
                const size_t off = (size_t)(row0 + ai * 128 + m * 16) * 1024 + colb;
#pragma unroll
                for (int bj = 0; bj < 2; ++bj) {
                    f32x4 h0, h1; unpack8(*(const u32x4*)(H + off + bj * 128), h0, h1);
                    *(f32x4*)(O + off + bj * 128) = h0 * DN_ALPHA + acc[ai][bj][m][0];
                    *(f32x4*)(O + off + bj * 128 + 4) = h1 * DN_ALPHA + acc[ai][bj][m][1];
                }
            }
    }
};
struct EpiF32 {
    static constexpr bool PERM = true, AFTER_DRAIN = false;
    float* O; int ld;
    __device__ __forceinline__ void operator()(const f32x4 (&acc)[2][2][4][2], const Unit& u, int wr, int wc, int fr, int fq) const {
        const int row0 = u.pm * 256 + wr * 64 + fr, colb = u.pn * 256 + wc * 32 + 8 * fq;
#pragma unroll
        for (int ai = 0; ai < 2; ++ai)
#pragma unroll
            for (int m = 0; m < 4; ++m) {
                float* rowp = O + (size_t)(row0 + ai * 128 + m * 16) * ld + colb;
#pragma unroll
                for (int bj = 0; bj < 2; ++bj) { *(f32x4*)(rowp + bj * 128) = acc[ai][bj][m][0]; *(f32x4*)(rowp + bj * 128 + 4) = acc[ai][bj][m][1]; }
            }
    }
};
}

__device__ __forceinline__ void transpose_item(const float* W, int ldsrc, int K, bf16* WT, int k0, int srcn0, int dstn0, LAS float* scr, int lane) {
    if (srcn0 >= 0) {
#pragma unroll 8
        for (int i = 0; i < 32; ++i) { const int kk = 2 * i + (lane >> 5); scr[kk * 33 + (lane & 31)] = W[(size_t)(k0 + kk) * ldsrc + srcn0 + (lane & 31)]; }
    } else {
#pragma unroll 8
        for (int i = 0; i < 32; ++i) { const int kk = 2 * i + (lane >> 5); scr[kk * 33 + (lane & 31)] = 0.f; }
    }
    asm volatile("s_waitcnt lgkmcnt(0)" ::: "memory");
    const int c = lane & 7;
#pragma unroll
    for (int j = 0; j < 4; ++j) { const int n = (lane >> 3) + 8 * j; const LAS float* s = scr + (8 * c) * 33 + n;
        v4u o; o.x = pk2(s[0 * 33], s[1 * 33]); o.y = pk2(s[2 * 33], s[3 * 33]); o.z = pk2(s[4 * 33], s[5 * 33]); o.w = pk2(s[6 * 33], s[7 * 33]);
        *(v4u*)(WT + (size_t)(dstn0 + n) * K + k0 + 8 * c) = o; }
    asm volatile("s_waitcnt lgkmcnt(0)" ::: "memory");
}
__device__ __forceinline__ int wt_src_col(int n0) {
    if (n0 < 4096) return n0;
    if (n0 < 7168) return n0 - 4096 + 6144;
    if (n0 < 7200) return n0 - 7168 + 10240;
    if (n0 < 7424) return -1;
    if (n0 < 9472) return n0 - 7424 + 4096;
    if (n0 < 10496) return n0 - 9472 + 9216;
    if (n0 < 11520) return n0 - 10496 + 10272;
    return n0 - 11520 + 11296;
}
__device__ __forceinline__ void ln_row_affine_bf16(const float* xrow, const float* g, const float* bb, bf16* orow, int lane) {
    const f32x4* xr = (const f32x4*)xrow + lane;
    f32x4 v[4]; float s = 0.f;
#pragma unroll
    for (int j = 0; j < 4; ++j) { v[j] = xr[64 * j]; s += (v[j][0] + v[j][1]) + (v[j][2] + v[j][3]); }
    const float mean = wave_sum(s) * (1.f / D); float s2 = 0.f;
#pragma unroll
    for (int j = 0; j < 4; ++j) { v[j] = v[j] - mean; s2 += (v[j][0] * v[j][0] + v[j][1] * v[j][1]) + (v[j][2] * v[j][2] + v[j][3] * v[j][3]); }
    const float rstd = 1.f / sqrtf(wave_sum(s2) * (1.f / D) + LN_EPS);
    v2u* o8 = (v2u*)orow + lane;
#pragma unroll
    for (int j = 0; j < 4; ++j) { const f32x4 gg = ((const f32x4*)g)[lane + 64 * j], b4 = ((const f32x4*)bb)[lane + 64 * j]; const f32x4 y = v[j] * rstd * gg + b4;
        v2u w; w.x = pk2(y[0], y[1]); w.y = pk2(y[2], y[3]); o8[64 * j] = w; }
}

__device__ __forceinline__ void p0_prologue(const Args& a, Frame& F) {
    LAS float* scr = (LAS float*)(F.lds + F.wave * 16384);
    bf16* HB = (bf16*)(a.ws + WS_HB); bf16* WT = (bf16*)(a.ws + WS_WT);
    constexpr int NB = WT_ROWS / 32, NITEMS = NB * (D / 64);
    for (int it = F.gw; it < NITEMS; it += F.NGW) { const int nb = it % NB, kb = it / NB; transpose_item(a.w_in, IN_W, D, WT, 64 * kb, wt_src_col(32 * nb), 32 * nb, scr, F.lane); }
    for (int r = F.gw; r < MROWS; r += F.NGW) {
        bf16* orow = HB + (size_t)r * D;
        if (r < NREAL) ln_row_affine_bf16(a.x + (size_t)r * D, a.emb_g, a.emb_b, orow, F.lane);
        else if (r < NREAL + NMETA) ln_row_affine_bf16(a.meta + (size_t)(r - NREAL) * D, a.emb_g, a.emb_b, orow, F.lane);
        else { v2u z; z.x = 0u; z.y = 0u; v2u* o8 = (v2u*)orow + F.lane;
#pragma unroll
            for (int j = 0; j < 4; ++j) o8[64 * j] = z; }
    }
}

__device__ __forceinline__ void p2_scan_ret_simple(const Args& a, Frame& F) {
    const bf16* QKV = (const bf16*)(a.ws + AR_QKVR); bf16* OR = (bf16*)a.out;
    constexpr int TG = 8;
    LAS bf16* qt = (LAS bf16*)F.lds; LAS bf16* kt = qt + TG * 256; LAS bf16* vt = kt + TG * 256;
    const int col = 16 * F.wave + (F.lane >> 2), qtr = F.lane & 3;
    for (int u = blockIdx.x; u < BATCH * RH * 4; u += F.G) {
        const int b = u >> 4, h = (u >> 2) & 3, dvb = u & 3;
        for (int pass = 0; pass < 2; ++pass) {
            const int dir = 1 - pass;
            const float gamma = sigmoidf_(a.ret_decay[dir * RH + h]);
            float S[64];
#pragma unroll
            for (int j = 0; j < 64; ++j) S[j] = 0.f;
            const int ntok = dir ? SEQ : LTOT;
            for (int t0 = 0; t0 < ntok; t0 += TG) {
                __syncthreads();
                for (int c = F.tid; c < TG * 80; c += NTHREADS) {
                    const int i = c / 80, w = c % 80; const int t = t0 + i, p = dir ? (LTOT - 1 - t) : t; const size_t rb = (size_t)row_of(b, p) * 4096;
                    if (w < 32) *(LAS v4u*)(qt + i * 256 + w * 8) = *(const v4u*)(QKV + rb + h * 256 + w * 8);
                    else if (w < 64) *(LAS v4u*)(kt + i * 256 + (w - 32) * 8) = *(const v4u*)(QKV + rb + 1024 + h * 256 + (w - 32) * 8);
                    else *(LAS v4u*)(vt + i * 128 + (w - 64) * 8) = *(const v4u*)(QKV + rb + 2048 + h * 512 + dvb * 128 + (w - 64) * 8);
                }
                __syncthreads();
                for (int i = 0; i < TG; ++i) {
                    const float v = bf2f(vt[i * 128 + col]);
                    float o = 0.f;
#pragma unroll
                    for (int j8 = 0; j8 < 8; ++j8) {
                        const v4u kw = *(const LAS v4u*)(kt + i * 256 + qtr * 64 + j8 * 8), qw = *(const LAS v4u*)(qt + i * 256 + qtr * 64 + j8 * 8);
                        const float kk[8] = {bflo(kw.x), bfhi(kw.x), bflo(kw.y), bfhi(kw.y), bflo(kw.z), bfhi(kw.z), bflo(kw.w), bfhi(kw.w)};
                        const float qq[8] = {bflo(qw.x), bfhi(qw.x), bflo(qw.y), bfhi(qw.y), bflo(qw.z), bfhi(qw.z), bflo(qw.w), bfhi(qw.w)};
#pragma unroll
                        for (int e = 0; e < 8; ++e) {
                            float s = S[j8 * 8 + e] * gamma;
                            if (dir == 0) { s += kk[e] * v; o += qq[e] * s; } else { o += qq[e] * s; s += kk[e] * v; }
                            S[j8 * 8 + e] = s;
                        }
                    }
                    o += __shfl_xor(o, 1); o += __shfl_xor(o, 2);
                    const float o2 = __shfl_down(o, 4);
                    const int t = t0 + i, p = dir ? (LTOT - 1 - t) : t;
                    if ((F.lane & 7) == 0 && p >= NMETA) {
                        unsigned* dst = (unsigned*)(OR + (size_t)(b * SEQ + p - NMETA) * 2048 + h * 512 + dvb * 128 + col);
                        float r0 = o, r1 = o2;
                        if (pass == 1) { const unsigned old = __hip_atomic_load(dst, RLX_AGENT); r0 += bflo(old); r1 += bfhi(old); }
                        *dst = pk2(r0, r1);
                    }
                }
            }
        }
    }
}

__device__ __forceinline__ void p4_conv(const Args& a, Frame& F) {
    const bf16* RAW = (const bf16*)(a.ws + AR_RAWD); bf16* QD = (bf16*)(a.ws + AR_QKVD);
    constexpr int NSEG = 65;
    for (int it = F.gw; it < BATCH * 24 * NSEG; it += F.NGW) {
        const int seg = it % NSEG, bs = it / NSEG, slab = bs % 24, b = bs / 24;
        const int p0 = seg * 32, ch = slab * 128 + 2 * F.lane;
        unsigned raw[36];
#pragma unroll
        for (int k = 0; k < 36; ++k) { const int pp = p0 - 2 + k; raw[k] = (pp >= 0 && pp < LTOT) ? *(const unsigned*)(RAW + (size_t)row_of(b, pp) * 3072 + ch) : 0u; }
        float w0[5], w1[5];
#pragma unroll
        for (int j = 0; j < 5; ++j) { const float2 cw = *(const float2*)(a.dn_conv + j * 3072 + ch); w0[j] = cw.x; w1[j] = cw.y; }
        const float qsc = (slab < 8) ? 0.08838834764831845f : 1.0f;
#pragma unroll
        for (int t = 0; t < 32; ++t) {
            float y0 = 0.f, y1 = 0.f;
#pragma unroll
            for (int j = 0; j < 5; ++j) { y0 += w0[j] * bflo(raw[t + j]); y1 += w1[j] * bfhi(raw[t + j]); }
            y0 = siluf_(y0); y1 = siluf_(y1);
            if (slab < 16) { const float ss = wave_sum(y0 * y0 + y1 * y1); const float sc = qsc / sqrtf(ss + RMS_EPS); y0 *= sc; y1 *= sc; }
            const int p = p0 + t;
            if (p < LTOT) *(unsigned*)(QD + (size_t)rowd_of(b, p) * 3072 + ch) = pk2(y0, y1);
        }
    }
}

__device__ __forceinline__ void p5_scan_dn_simple(const Args& a, Frame& F) {
    const bf16* QD = (const bf16*)(a.ws + AR_QKVD); const float* GB = (const float*)(a.ws + AR_GBETA); bf16* OD = (bf16*)(a.ws + AR_OD);
    constexpr int TG = 8;
    LAS bf16* qt = (LAS bf16*)F.lds; LAS bf16* kt = qt + TG * 128; LAS bf16* vt = kt + TG * 128; LAS float* gt = (LAS float*)(vt + TG * 64); LAS float* bt = gt + TG;
    const int cl = 8 * F.wave + (F.lane >> 3), sub = F.lane & 7;
    for (int u = blockIdx.x; u < BATCH * DH * 2; u += F.G) {
        const int b = u >> 4, h = (u >> 1) & 7, dvh = u & 1;
        for (int pass = 0; pass < 2; ++pass) {
            const int dir = 1 - pass;
            float S[16];
#pragma unroll
            for (int j = 0; j < 16; ++j) S[j] = 0.f;
            const int ntok = dir ? SEQ : LTOT;
            for (int t0 = 0; t0 < ntok; t0 += TG) {
                __syncthreads();
                for (int c = F.tid; c < TG * 40; c += NTHREADS) {
                    const int i = c / 40, w = c % 40; const int t = t0 + i, p = dir ? (LTOT - 1 - t) : t; const size_t rb = (size_t)rowd_of(b, p) * 3072;
                    if (w < 16) *(LAS v4u*)(qt + i * 128 + w * 8) = *(const v4u*)(QD + rb + h * 128 + w * 8);
                    else if (w < 32) *(LAS v4u*)(kt + i * 128 + (w - 16) * 8) = *(const v4u*)(QD + rb + 1024 + h * 128 + (w - 16) * 8);
                    else *(LAS v4u*)(vt + i * 64 + (w - 32) * 8) = *(const v4u*)(QD + rb + 2048 + h * 128 + dvh * 64 + (w - 32) * 8);
                }
                if (F.tid < TG) { const int t = t0 + F.tid, p = dir ? (LTOT - 1 - t) : t; const size_t rg = (size_t)row_of(b, p) * 32;
                    gt[F.tid] = GB[rg + dir * 8 + h]; bt[F.tid] = GB[rg + 16 + dir * 8 + h]; }
                __syncthreads();
                for (int i = 0; i < TG; ++i) {
                    const float v = bf2f(vt[i * 64 + cl]);
                    const float ag = __expf(gt[i]), beta = bt[i];
                    const v4u kw0 = *(const LAS v4u*)(kt + i * 128 + sub * 16), kw1 = *(const LAS v4u*)(kt + i * 128 + sub * 16 + 8);
                    const v4u qw0 = *(const LAS v4u*)(qt + i * 128 + sub * 16), qw1 = *(const LAS v4u*)(qt + i * 128 + sub * 16 + 8);
                    const float kk[16] = {bflo(kw0.x), bfhi(kw0.x), bflo(kw0.y), bfhi(kw0.y), bflo(kw0.z), bfhi(kw0.z), bflo(kw0.w), bfhi(kw0.w),
                                          bflo(kw1.x), bfhi(kw1.x), bflo(kw1.y), bfhi(kw1.y), bflo(kw1.z), bfhi(kw1.z), bflo(kw1.w), bfhi(kw1.w)};
                    const float qq[16] = {bflo(qw0.x), bfhi(qw0.x), bflo(qw0.y), bfhi(qw0.y), bflo(qw0.z), bfhi(qw0.z), bflo(qw0.w), bfhi(qw0.w),
                                          bflo(qw1.x), bfhi(qw1.x), bflo(qw1.y), bfhi(qw1.y), bflo(qw1.z), bfhi(qw1.z), bflo(qw1.w), bfhi(qw1.w)};
                    float r = 0.f;
#pragma unroll
                    for (int j = 0; j < 16; ++j) r += S[j] * kk[j];
                    r += __shfl_xor(r, 1); r += __shfl_xor(r, 2); r += __shfl_xor(r, 4);
                    const float vn = beta * (v - ag * r);
                    float o = 0.f;
#pragma unroll
                    for (int j = 0; j < 16; ++j) { S[j] = ag * S[j] + kk[j] * vn; o += S[j] * qq[j]; }
                    o += __shfl_xor(o, 1); o += __shfl_xor(o, 2); o += __shfl_xor(o, 4);
                    const float o2 = __shfl_down(o, 8);
                    const int t = t0 + i, p = dir ? (LTOT - 1 - t) : t;
                    if ((F.lane & 15) == 0 && p >= NMETA) {
                        unsigned* dst = (unsigned*)(OD + (size_t)(b * SEQ + p - NMETA) * 1024 + h * 128 + dvh * 64 + cl);
                        float r0 = o, r1 = o2;
                        if (pass == 1) { const unsigned old = __hip_atomic_load(dst, RLX_AGENT); r0 += bflo(old); r1 += bfhi(old); }
                        *dst = pk2(r0, r1);
                    }
                }
            }
        }
    }
}

__device__ __forceinline__ void p6_small_weights(const Args& a, Frame& F) {
    LAS float* scr = (LAS float*)(F.lds + F.wave * 16384);
    bf16* PRT = (bf16*)(a.ws + AR_PRETT); bf16* PDT = (bf16*)(a.ws + AR_PDNT); bf16* WOT = (bf16*)(a.ws + AR_WOUTT); bf16* W2T = (bf16*)(a.ws + AR_W2T);
    constexpr int I_PR = (2048 / 64) * (1024 / 32), I_PD = (1024 / 64) * (1024 / 32), I_WO = I_PD;
    for (int it = F.gw; it < I_PR + I_PD + I_WO; it += F.NGW) {
        int r = it;
        if (r < I_PR) { transpose_item(a.p_ret, 1024, 2048, PRT, 64 * (r / 32), 32 * (r % 32), 32 * (r % 32), scr, F.lane); continue; } r -= I_PR;
        if (r < I_PD) { transpose_item(a.p_dn, 1024, 1024, PDT, 64 * (r / 32), 32 * (r % 32), 32 * (r % 32), scr, F.lane); continue; } r -= I_PD;
        transpose_item(a.w_out, 1024, 1024, WOT, 64 * (r / 32), 32 * (r % 32), 32 * (r % 32), scr, F.lane);
    }
    for (int it = F.gw; it < 128 * 16; it += F.NGW) {
        const int nt = it >> 4, ks = it & 15, hp = nt >> 3, lane = F.lane, g = lane >> 4, l15 = lane & 15;
        typedef short bfx8_ __attribute__((ext_vector_type(8)));
        bfx8_ kf[4];
#pragma unroll
        for (int sx = 0; sx < 4; ++sx) { const f32x4* p = (const f32x4*)(a.peer_keys + (size_t)(nt * 16 + l15) * 128 + 32 * sx + 8 * g); const f32x4 x = p[0], y = p[1];
            const v4u w = {pk2(x[0], x[1]), pk2(x[2], x[3]), pk2(y[0], y[1]), pk2(y[2], y[3])}; kf[sx] = __builtin_bit_cast(bfx8_, w); }
#pragma unroll
        for (int kt = 0; kt < 4; ++kt) {
            const int k0 = ks * 64 + kt * 16;
            f32x4 acc = (f32x4){0.f, 0.f, 0.f, 0.f};
#pragma unroll
            for (int sx = 0; sx < 4; ++sx) { const f32x4* p = (const f32x4*)(a.peer_wq + (size_t)(k0 + l15) * 2048 + hp * 128 + 32 * sx + 8 * g); const f32x4 x = p[0], y = p[1];
                const v4u w = {pk2(x[0], x[1]), pk2(x[2], x[3]), pk2(y[0], y[1]), pk2(y[2], y[3])};
                acc = __builtin_amdgcn_mfma_f32_16x16x32_bf16(__builtin_bit_cast(bfx8_, w), kf[sx], acc, 0, 0, 0); }
            v2u o; o.x = pk2(acc[0], acc[1]); o.y = pk2(acc[2], acc[3]);
            *(v2u*)(W2T + (size_t)(nt * 16 + l15) * 1024 + k0 + 4 * g) = o;
        }
    }
}

__device__ __forceinline__ void p7_gate_norm(const Args& a, Frame& F) {
    bf16* OR = (bf16*)a.out; bf16* OD = (bf16*)(a.ws + AR_OD); const bf16* GRG = (const bf16*)(a.ws + AR_GRG); const bf16* GDZ = (const bf16*)(a.ws + AR_GDZ);
    for (int it = F.gw; it < NREAL * 5; it += F.NGW) {
        const int r = it / 5, part = it % 5;
        if (part < 4) {
            const size_t off = (size_t)r * 2048 + part * 512 + F.lane * 8;
            f32x4 v0, v1, g0, g1; ep::unpack8(*(const v4u*)(OR + off), v0, v1); ep::unpack8(*(const v4u*)(GRG + off), g0, g1);
            float s = (v0[0] + v0[1]) + (v0[2] + v0[3]) + (v1[0] + v1[1]) + (v1[2] + v1[3]);
            const float mean = wave_sum(s) * (1.f / 512.f);
            v0 = v0 - mean; v1 = v1 - mean;
            float s2 = (v0[0] * v0[0] + v0[1] * v0[1]) + (v0[2] * v0[2] + v0[3] * v0[3]) + (v1[0] * v1[0] + v1[1] * v1[1]) + (v1[2] * v1[2] + v1[3] * v1[3]);
            const float rstd = 1.f / sqrtf(wave_sum(s2) * (1.f / 512.f) + LN_EPS);
#pragma unroll
            for (int e = 0; e < 4; ++e) { v0[e] = v0[e] * rstd * siluf_(g0[e]); v1[e] = v1[e] * rstd * siluf_(g1[e]); }
            *(v4u*)(OR + off) = ep::pack8(v0, v1);
        } else {
#pragma unroll
            for (int hh = 0; hh < 2; ++hh) {
                const size_t off = (size_t)r * 1024 + hh * 512 + F.lane * 8;
                f32x4 v0, v1, g0, g1; ep::unpack8(*(const v4u*)(OD + off), v0, v1); ep::unpack8(*(const v4u*)(GDZ + off), g0, g1);
                float s2 = (v0[0] * v0[0] + v0[1] * v0[1]) + (v0[2] * v0[2] + v0[3] * v0[3]) + (v1[0] * v1[0] + v1[1] * v1[1]) + (v1[2] * v1[2] + v1[3] * v1[3]);
                s2 += __shfl_xor(s2, 1); s2 += __shfl_xor(s2, 2); s2 += __shfl_xor(s2, 4); s2 += __shfl_xor(s2, 8);
                const float rs = 1.f / sqrtf(s2 * (1.f / 128.f) + RMS_EPS);
                const int c = (F.lane & 15) * 8;
                const f32x4 n0 = *(const f32x4*)(a.dn_norm_g + c), n1 = *(const f32x4*)(a.dn_norm_g + c + 4);
#pragma unroll
                for (int e = 0; e < 4; ++e) { v0[e] = v0[e] * rs * n0[e] * siluf_(g0[e]); v1[e] = v1[e] * rs * n1[e] * siluf_(g1[e]); }
                *(v4u*)(OD + off) = ep::pack8(v0, v1);
            }
        }
    }
}

constexpr size_t WS_UB8 = 1 * MiB, WS_SCU = 17 * MiB, WS_SCV = 17 * MiB + 65536, AR_VB8 = WS_AR + 160 * MiB;
typedef __bf16 v32bf_t __attribute__((ext_vector_type(32)));
typedef float v32f_t __attribute__((ext_vector_type(32)));
typedef unsigned v6u_t __attribute__((ext_vector_type(6)));
typedef unsigned v4u_a8 __attribute__((ext_vector_type(4), aligned(8)));
__device__ __forceinline__ void p11_ln1_tables(const Args& a, Frame& F) {
    const float* PRE = (const float*)(a.ws + AR_PRE); bf16* H1 = (bf16*)(a.ws + AR_H1);
    for (int r = F.gw; r < NREAL; r += F.NGW) ln_row_affine_bf16(PRE + (size_t)r * D, a.ln1_g, a.ln1_b, H1 + (size_t)r * D, F.lane);
    const int lp = F.lane & 31, hf = F.lane >> 5;
    for (int it = F.gw; it < NEXP; it += F.NGW) {
        const int r = 2 * it + hf; const bool second = r >= NEXP; const int e = second ? r - NEXP : r;
        const f32x4* src = (const f32x4*)((second ? a.peer_v : a.peer_u) + (size_t)e * D + lp * 32);
        v32f_t x; float am = 0.f;
#pragma unroll
        for (int j = 0; j < 8; ++j) { const f32x4 t = src[j]; x[4 * j] = t[0]; x[4 * j + 1] = t[1]; x[4 * j + 2] = t[2]; x[4 * j + 3] = t[3];
            am = fmaxf(am, fmaxf(fmaxf(fabsf(t[0]), fabsf(t[1])), fmaxf(fabsf(t[2]), fabsf(t[3])))); }
#pragma unroll
        for (int o = 1; o < 32; o <<= 1) am = fmaxf(am, __shfl_xor(am, o));
        int ex = 0; float m = 0.5f; if (am > 0.f) m = frexpf(am, &ex); else ex = 3;
        const int sh = (m > 0.9375f) ? 2 - ex : 3 - ex;
        const float sc = ldexpf(1.0f, sh), isc = ldexpf(1.0f, -sh);
#pragma unroll
        for (int j = 0; j < 32; ++j) x[j] *= sc;
        const v32bf_t xb = __builtin_convertvector(x, v32bf_t);
        const v6u_t p = __builtin_amdgcn_cvt_scalef32_pk32_fp6_bf16(xb, 1.0f);
        unsigned char* dst = a.ws + (second ? AR_VB8 : WS_UB8) + (size_t)e * 768 + lp * 24;
        *(v4u_a8*)dst = (v4u){p[0], p[1], p[2], p[3]}; *(v2u*)(dst + 16) = (v2u){p[4], p[5]};
        if (lp == 0) ((float*)(a.ws + (second ? WS_SCV : WS_SCU)))[e] = isc;
    }
}

__device__ __forceinline__ unsigned ord_key(float v) { const unsigned u = __builtin_bit_cast(unsigned, v); return (u & 0x80000000u) ? ~u : (u | 0x80000000u); }
__device__ __forceinline__ float ord_val(unsigned k) { const unsigned u = (k & 0x80000000u) ? (k & 0x7fffffffu) : ~k; return __builtin_bit_cast(float, u); }
#define DPP_ROR(x, n) ((unsigned)__builtin_amdgcn_update_dpp(0, (int)(x), 0x120 + (n), 0xf, 0xf, false))
__device__ __forceinline__ unsigned row16_max(unsigned m) { m = max(m, DPP_ROR(m, 1)); m = max(m, DPP_ROR(m, 2)); m = max(m, DPP_ROR(m, 4)); m = max(m, DPP_ROR(m, 8)); return m; }
__device__ __forceinline__ float row16_sum(float s) {
    s += __builtin_bit_cast(float, DPP_ROR(__builtin_bit_cast(unsigned, s), 1)); s += __builtin_bit_cast(float, DPP_ROR(__builtin_bit_cast(unsigned, s), 2));
    s += __builtin_bit_cast(float, DPP_ROR(__builtin_bit_cast(unsigned, s), 4)); s += __builtin_bit_cast(float, DPP_ROR(__builtin_bit_cast(unsigned, s), 8)); return s;
}
__device__ __forceinline__ void p13_topk(const Args& a, Frame& F) {
    const float* SC = (const float*)(a.ws + AR_SCORES); int* EXP = (int*)(a.ws + WS_EXP); float* GATE = (float*)(a.ws + WS_GATE);
    LAS float* tops = (LAS float*)(F.lds + F.wave * 2048); LAS int* topi = (LAS int*)(F.lds + F.wave * 2048 + 1024);
    const int q4 = F.lane >> 4, li = F.lane & 15;
    int ci[4], cj[4];
#pragma unroll
    for (int k = 0; k < 4; ++k) { const int t = li * 4 + k; int cnt = 0; ci[k] = -1; cj[k] = 0;
        for (int i = 0; i < 16; ++i) { const int ni = 16 / (i + 1); if (ci[k] < 0 && t < cnt + ni) { ci[k] = i; cj[k] = t - cnt; } cnt += ni; } }
    f32x4 nx[4][2];
    { const float* srow = SC + (size_t)(F.gw < NREAL ? F.gw : 0) * 2048;
#pragma unroll
      for (int it = 0; it < 4; ++it) { nx[it][0] = *(const f32x4*)(srow + (it * 4 + q4) * 128 + li * 8); nx[it][1] = *(const f32x4*)(srow + (it * 4 + q4) * 128 + li * 8 + 4); } }
    for (int tok = F.gw; tok < NREAL; tok += F.NGW) {
        f32x4 cx[4][2];
#pragma unroll
        for (int it = 0; it < 4; ++it) { cx[it][0] = nx[it][0]; cx[it][1] = nx[it][1]; }
        { const int tn = tok + F.NGW < NREAL ? tok + F.NGW : tok; const float* srow = SC + (size_t)tn * 2048;
#pragma unroll
          for (int it = 0; it < 4; ++it) { nx[it][0] = *(const f32x4*)(srow + (it * 4 + q4) * 128 + li * 8); nx[it][1] = *(const f32x4*)(srow + (it * 4 + q4) * 128 + li * 8 + 4); } }
#pragma unroll
        for (int it = 0; it < 4; ++it) {
            const int grp = it * 4 + q4;
            const f32x4 x0 = cx[it][0], x1 = cx[it][1];
            unsigned key[8];
#pragma unroll
            for (int j = 0; j < 8; ++j) { const float v = j < 4 ? x0[j] : x1[j - 4]; key[j] = (ord_key(v) & ~127u) | (unsigned)(127 - (li * 8 + j)); }
            unsigned mine = 0u;
#pragma unroll 4
            for (int rnd = 0; rnd < 16; ++rnd) {
                unsigned m = max(max(max(key[0], key[1]), max(key[2], key[3])), max(max(key[4], key[5]), max(key[6], key[7])));
                m = row16_max(m);
#pragma unroll
                for (int j = 0; j < 8; ++j) key[j] = (key[j] == m) ? 0u : key[j];
                mine = (li == rnd) ? m : mine;
            }
            tops[grp * 16 + li] = ord_val((mine & ~127u) | 64u); topi[grp * 16 + li] = 127 - (int)(mine & 127u);
        }
        asm volatile("s_waitcnt lgkmcnt(0)" ::: "memory");
#pragma unroll 1
        for (int it = 0; it < 2; ++it) {
            const int hh = it * 4 + q4;
            unsigned key[4];
#pragma unroll
            for (int k = 0; k < 4; ++k) { const int i = ci[k] < 0 ? 0 : ci[k]; const float sum = tops[(2 * hh) * 16 + i] + tops[(2 * hh + 1) * 16 + cj[k]];
                key[k] = ci[k] < 0 ? 0u : ((ord_key(sum) & ~255u) | (unsigned)(255 - (i * 16 + cj[k]))); }
            unsigned mine = 0u;
#pragma unroll 4
            for (int rnd = 0; rnd < 16; ++rnd) {
                unsigned m = max(max(key[0], key[1]), max(key[2], key[3]));
                m = row16_max(m);
#pragma unroll
                for (int k = 0; k < 4; ++k) key[k] = (key[k] == m) ? 0u : key[k];
                mine = (li == rnd) ? m : mine;
            }
            const int flat = 255 - (int)(mine & 255u);
            const float best = ord_val((mine & ~255u) | 128u);
            const int i1 = topi[(2 * hh) * 16 + (flat >> 4)], i2 = topi[(2 * hh + 1) * 16 + (flat & 15)];
            const float bmax = __shfl(best, F.lane & 48);
            const float e = __expf(best - bmax);
            const float se = row16_sum(e);
            EXP[(size_t)tok * 128 + hh * 16 + li] = i1 * 128 + i2;
            GATE[(size_t)tok * 128 + hh * 16 + li] = e / se;
        }
        asm volatile("s_waitcnt lgkmcnt(0)" ::: "memory");
    }
}

__device__ __forceinline__ float gelu_exact(float x) { return 0.5f * x * (1.0f + erff(x * 0.70710678118654752f)); }
__device__ __forceinline__ v6u_t ld_fp6(const unsigned char* p) { const v4u a = *(const v4u_a8*)p; const v2u b = *(const v2u*)(p + 16); return (v6u_t){a.x, a.y, a.z, a.w, b.x, b.y}; }
__device__ __forceinline__ void p14_gather(const Args& a, Frame& F) {
    const bf16* H1 = (const bf16*)(a.ws + AR_H1); const int* EXP = (const int*)(a.ws + WS_EXP); const float* GATE = (const float*)(a.ws + WS_GATE);
    const unsigned char* UB = a.ws + WS_UB8; const unsigned char* VB = a.ws + AR_VB8; const float* SCU = (const float*)(a.ws + WS_SCU); const float* SCV = (const float*)(a.ws + WS_SCV);
    const int lane = F.lane, lp = lane & 31, hf = lane >> 5;
    for (int tok = F.gw; tok < NREAL; tok += F.NGW) {
        float x[32], y[32];
        { const v4u* hp = (const v4u*)(H1 + (size_t)tok * D + lp * 32);
#pragma unroll
          for (int q = 0; q < 4; ++q) { const v4u w = hp[q]; const unsigned ww[4] = {w.x, w.y, w.z, w.w};
#pragma unroll
              for (int j = 0; j < 4; ++j) { x[8 * q + 2 * j] = bflo(ww[j]); x[8 * q + 2 * j + 1] = bfhi(ww[j]); } }
#pragma unroll
          for (int j = 0; j < 32; ++j) y[j] = 0.f; }
        const int e0 = EXP[(size_t)tok * 128 + lane], e1 = EXP[(size_t)tok * 128 + 64 + lane];
        const float gv0 = GATE[(size_t)tok * 128 + lane] * SCV[e0], gv1 = GATE[(size_t)tok * 128 + 64 + lane] * SCV[e1];
        const float su0 = SCU[e0], su1 = SCU[e1];
        v6u_t ucur[4];
#pragma unroll 1
        for (int bt = 0; bt < 16; ++bt) {
            v6u_t vv[4];
#pragma unroll
            for (int k = 0; k < 4; ++k) { const int sa = bt * 8 + 2 * k; const int ea = __builtin_amdgcn_readlane(sa < 64 ? e0 : e1, sa & 63), eb = __builtin_amdgcn_readlane(sa < 64 ? e0 : e1, (sa + 1) & 63);
                ucur[k] = ld_fp6(UB + (size_t)(hf ? eb : ea) * 768 + lp * 24); }
#pragma unroll
            for (int k = 0; k < 4; ++k) { const int sa = bt * 8 + 2 * k; const int ea = __builtin_amdgcn_readlane(sa < 64 ? e0 : e1, sa & 63), eb = __builtin_amdgcn_readlane(sa < 64 ? e0 : e1, (sa + 1) & 63);
                vv[k] = ld_fp6(VB + (size_t)(hf ? eb : ea) * 768 + lp * 24); }
            float d[4];
#pragma unroll
            for (int k = 0; k < 4; ++k) {
                const v32f_t r = __builtin_amdgcn_cvt_scalef32_pk32_f32_fp6(ucur[k], 1.0f);
                float s0 = 0.f, s1 = 0.f;
#pragma unroll
                for (int j = 0; j < 16; ++j) { s0 += x[2 * j] * r[2 * j]; s1 += x[2 * j + 1] * r[2 * j + 1]; }
                d[k] = s0 + s1;
            }
            float r2[2], r1;
#pragma unroll
            for (int i = 0; i < 2; ++i) { const bool up = lp & 16; const float keep = up ? d[i + 2] : d[i], send = up ? d[i] : d[i + 2]; r2[i] = keep + __shfl_xor(send, 16); }
            { const bool up = lp & 8; const float keep = up ? r2[1] : r2[0], send = up ? r2[0] : r2[1]; r1 = keep + __shfl_xor(send, 8); }
            r1 += __shfl_xor(r1, 4); r1 += __shfl_xor(r1, 2); r1 += __shfl_xor(r1, 1);
            const int myslot = bt * 8 + 2 * (lp >> 3) + hf;
            const float su = __shfl(myslot < 64 ? su0 : su1, myslot & 63), gv = __shfl(myslot < 64 ? gv0 : gv1, myslot & 63);
            const float wmine = gv * gelu_exact(r1 * su);
#pragma unroll
            for (int k = 0; k < 4; ++k) {
                const float wgt = __shfl(wmine, hf * 32 + 8 * k);
                const v32f_t r = __builtin_amdgcn_cvt_scalef32_pk32_f32_fp6(vv[k], 1.0f);
#pragma unroll
                for (int j = 0; j < 32; ++j) y[j] += wgt * r[j];
            }
        }
        float s = 0.f;
#pragma unroll
        for (int j = 0; j < 32; ++j) { y[j] += __shfl_xor(y[j], 32); y[j] = DN_ALPHA * x[j] + y[j]; s += y[j]; }
#pragma unroll
        for (int o = 1; o < 32; o <<= 1) s += __shfl_xor(s, o);
        const float mean = s * (1.f / D); float s2 = 0.f;
#pragma unroll
        for (int j = 0; j < 32; ++j) { y[j] -= mean; s2 += y[j] * y[j]; }
#pragma unroll
        for (int o = 1; o < 32; o <<= 1) s2 += __shfl_xor(s2, o);
        const float rstd = 1.f / sqrtf(s2 * (1.f / D) + LN_EPS);
#pragma unroll
        for (int q = 0; q < 4; ++q) {
            const int col = lp * 32 + hf * 16 + q * 4;
            const f32x4 gg = *(const f32x4*)(a.ln2_g + col), bb = *(const f32x4*)(a.ln2_b + col);
            f32x4 o;
#pragma unroll
            for (int e = 0; e < 4; ++e) { const float yv = hf ? y[16 + q * 4 + e] : y[q * 4 + e]; o[e] = yv * rstd * gg[e] + bb[e]; }
            *(f32x4*)(a.out + (size_t)tok * D + col) = o;
        }
    }
}

typedef short s16x4 __attribute__((ext_vector_type(4)));
typedef short bfx8 __attribute__((ext_vector_type(8)));
#ifndef R2_STAGGER
#define R2_STAGGER 0
#endif
constexpr int R2_QS = 544, R2_VS = 144, R2_PS = 80;
constexpr int R2_Q = 0, R2_K = 32 * R2_QS, R2_V = 2 * 32 * R2_QS, R2_P = R2_V + 32 * R2_VS, R2_Q2 = R2_P + 32 * R2_PS, R2_GRP = R2_Q2 + 32 * R2_QS;
__device__ __forceinline__ bfx8 tr16_frag(const LAS unsigned char* p0, const LAS unsigned char* p1) {
    const s16x4 a = __builtin_amdgcn_ds_read_tr16_b64_v4i16((LAS s16x4*)p0), b = __builtin_amdgcn_ds_read_tr16_b64_v4i16((LAS s16x4*)p1);
    return (bfx8){a[0], a[1], a[2], a[3], b[0], b[1], b[2], b[3]};
}
__device__ __forceinline__ bfx8 ld2x8(const LAS unsigned char* p0, const LAS unsigned char* p1) {
    const v2u a = *(const LAS v2u*)p0, b = *(const LAS v2u*)p1; const v4u w = {a.x, a.y, b.x, b.y}; return __builtin_bit_cast(bfx8, w);
}
__device__ __forceinline__ bfx8 pack_acc2(f32x4 a, f32x4 b, float sc) {
    const v4u w = {pk2(a[0] * sc, a[1] * sc), pk2(a[2] * sc, a[3] * sc), pk2(b[0] * sc, b[1] * sc), pk2(b[2] * sc, b[3] * sc)}; return __builtin_bit_cast(bfx8, w);
}
#define MFMA16(a, b, c) __builtin_amdgcn_mfma_f32_16x16x32_bf16((a), (b), (c), 0, 0, 0)

template <int VAR> __device__ __forceinline__ void p2_scan_ret(const Args& a, Frame& F) {
    const bf16* QKV = (const bf16*)(a.ws + AR_QKVR); bf16* OR = (bf16*)a.out;
    const int grp = F.wave >> 2, wq = F.wave & 3, tg = F.tid & 255, lane = F.lane, g = lane >> 4, l15 = lane & 15, q4 = (lane & 15) >> 2, p4 = lane & 3;
    LAS unsigned char* L = F.lds + grp * R2_GRP;
    constexpr int NSTEP = 65;
    if (VAR == 9) return;
    for (int u = blockIdx.x; u < BATCH * RH * 8; u += F.G) {
        const int bh_ = (u & 7) * 4 + ((u >> 3) >> 3), dvs = (u >> 3) & 7, b = bh_ >> 2, h = bh_ & 3;
        for (int i_ = 0; i_ < dvs * R2_STAGGER; ++i_) __builtin_amdgcn_s_sleep(8);
        const float xl = a.ret_decay[grp * RH + h];
        const float lg2 = -log2f(1.0f + __expf(-xl));
        const float gC = exp2f(32.f * lg2);
        f32x4 S[16];
#pragma unroll
        for (int d = 0; d < 16; ++d) S[d] = (f32x4){0.f, 0.f, 0.f, 0.f};
        v4u rqA[4], rkA[4], rvA;
        unsigned long long oldA[2] = {0ull, 0ull};
        const float vscale = exp2f((float)(31 - (tg >> 3)) * lg2);
        const float rs0 = exp2f((float)(l15 - 31) * lg2), rs1 = exp2f((float)(l15 + 16 - 31) * lg2);
#define R2_ROW(st, i, row)    \
        do { if (grp == 0) { if ((st) == 0) row = (i) >= 16 ? NREAL + (i) - 16 : -1; else row = b * SEQ + 32 * ((st) - 1) + (i); } \
             else { if ((st) == 0) row = -1; else row = b * SEQ + 32 * (64 - (st)) + 31 - (i); } } while (0)
#define R2_LOADS(st, rq, rk, rv) do { \
        _Pragma("unroll") for (int i_ = 0; i_ < 4; ++i_) { const int cid = tg + 256 * i_, ti = cid >> 5, c16 = cid & 31; int row; R2_ROW(((VAR == 5 || VAR == 6) ? 1 : (st)), ti, row); \
            row = row < 0 ? NREAL + NMETA : row;        \
            { const bf16* src = QKV + (size_t)row * 4096 + h * 256 + c16 * 8; rq[i_] = *(const v4u*)src; rk[i_] = *(const v4u*)(src + 1024); } } \
        { const int ti = tg >> 3, c16 = tg & 7; int row; R2_ROW(((VAR == 5 || VAR == 6) ? 1 : (st)), ti, row); \
            row = row < 0 ? NREAL + NMETA : row; rv = *(const v4u*)(QKV + (size_t)row * 4096 + 2048 + h * 512 + dvs * 64 + c16 * 8); } } while (0)
#define R2_OLD(st, old) do { _Pragma("unroll") for (int mt_ = 0; mt_ < 2; ++mt_) { int row; R2_ROW(st, 16 * mt_ + l15, row); \
            old[mt_] = __hip_atomic_load((unsigned long long*)(OR + (size_t)row * 2048 + h * 512 + dvs * 64 + 16 * wq + 4 * g), RLX_AGENT); } } while (0)
#define R2_STEP(st, rq, rk, rv, old, oldn, DIST) do { \
              \
            if (VAR == 4 || VAR == 8) { asm volatile("" :: "v"(rq[0]), "v"(rq[1]), "v"(rq[2]), "v"(rq[3]), "v"(rk[0]), "v"(rk[1]), "v"(rk[2]), "v"(rk[3]), "v"(rv)); } \
            if (VAR != 4 && VAR != 8) _Pragma("unroll") for (int i_ = 0; i_ < 4; ++i_) { const int cid = tg + 256 * i_, ti = cid >> 5, c16 = cid & 31; \
                *(LAS v4u*)(L + R2_Q + ti * R2_QS + c16 * 16) = rq[i_]; *(LAS v4u*)(L + R2_K + ti * R2_QS + c16 * 16) = rk[i_]; \
                { const int cc = c16 & 3, pb = (c16 >> 2) * 64 + (16 * (cc & 1) + 4 * (cc >> 1)) * 2; \
                  *(LAS v2u*)(L + R2_Q2 + ti * R2_QS + pb) = (v2u){rq[i_].x, rq[i_].y}; *(LAS v2u*)(L + R2_Q2 + ti * R2_QS + pb + 16) = (v2u){rq[i_].z, rq[i_].w}; } } \
            if (VAR != 4 && VAR != 8) { const int ti = tg >> 3, c16 = tg & 7; v4u w; \
                w.x = pk2(bflo(rv.x) * vscale, bfhi(rv.x) * vscale); w.y = pk2(bflo(rv.y) * vscale, bfhi(rv.y) * vscale); \
                w.z = pk2(bflo(rv.z) * vscale, bfhi(rv.z) * vscale); w.w = pk2(bflo(rv.w) * vscale, bfhi(rv.w) * vscale); \
                *(LAS v4u*)(L + R2_V + ti * R2_VS + c16 * 16) = w; } \
            __syncthreads(); \
              \
            if (VAR != 1 && (st) >= 33) { R2_OLD(st, old); } \
            if (VAR != 2 && VAR != 7 && VAR != 8 && (st) + (DIST) < NSTEP) { R2_LOADS((st) + (DIST), rq, rk, rv); } \
              \
            if (VAR != 3 && VAR != 5 && VAR != 7 && VAR != 8 && VAR != 10) { \
                const int mi = wq >> 1, ni = wq & 1; \
                f32x4 pacc = (f32x4){0.f, 0.f, 0.f, 0.f}; \
                const LAS unsigned char* qa = L + R2_Q + (16 * mi + l15) * R2_QS + g * 16; const LAS unsigned char* kb = L + R2_K + (16 * ni + l15) * R2_QS + g * 16; \
                _Pragma("unroll") for (int s_ = 0; s_ < 8; ++s_) pacc = MFMA16(*(const LAS bfx8*)(qa + s_ * 64), *(const LAS bfx8*)(kb + s_ * 64), pacc); \
                const int j = 16 * ni + l15; \
                _Pragma("unroll") for (int r = 0; r < 4; ++r) { const int i = 16 * mi + 4 * g + r; const bool keep = grp == 0 ? (j <= i) : (j < i); \
                    *(LAS bf16*)(L + R2_P + i * R2_PS + j * 2) = (bf16)f2bf(keep ? pacc[r] : 0.f); } \
            } \
            __syncthreads(); \
              \
            if (VAR != 3 && VAR != 5 && VAR != 7 && VAR != 8 && VAR != 11) { \
            const bfx8 vdf = tr16_frag(L + R2_V + (8 * g + q4) * R2_VS + (16 * wq + 4 * p4) * 2, L + R2_V + (8 * g + 4 + q4) * R2_VS + (16 * wq + 4 * p4) * 2); \
            f32x4 oT[2] = {(f32x4){0.f, 0.f, 0.f, 0.f}, (f32x4){0.f, 0.f, 0.f, 0.f}}; \
            _Pragma("unroll") for (int d = 0; d < 16; ++d) S[d] = S[d] * gC; \
            _Pragma("unroll") for (int sh_ = 0; sh_ < 2; ++sh_) { \
                bfx8 qf[4][2]; \
                _Pragma("unroll") for (int s4 = 0; s4 < 4; ++s4) _Pragma("unroll") for (int mt = 0; mt < 2; ++mt) { \
                    qf[s4][mt] = *(const LAS bfx8*)(L + R2_Q2 + (16 * mt + l15) * R2_QS + (32 * (4 * sh_ + s4) + 8 * g) * 2); } \
                __builtin_amdgcn_sched_barrier(0); \
                _Pragma("unroll") for (int s4 = 0; s4 < 4; ++s4) { const int s_ = 4 * sh_ + s4; \
                    const bfx8 sf = pack_acc2(S[2 * s_], S[2 * s_ + 1], 1.0f); \
                    oT[0] = MFMA16(sf, qf[s4][0], oT[0]); oT[1] = MFMA16(sf, qf[s4][1], oT[1]); } \
            } \
            _Pragma("unroll") for (int mt = 0; mt < 2; ++mt) oT[mt] = MFMA16(vdf, *(const LAS bfx8*)(L + R2_P + (16 * mt + l15) * R2_PS + g * 16), oT[mt]); \
            _Pragma("unroll") for (int d = 0; d < 16; ++d) { \
                const bfx8 kf = tr16_frag(L + R2_K + (8 * g + q4) * R2_QS + (16 * d + 4 * p4) * 2, L + R2_K + (8 * g + 4 + q4) * R2_QS + (16 * d + 4 * p4) * 2); \
                S[d] = MFMA16(kf, vdf, S[d]); \
            } \
              \
            if (VAR == 1) { asm volatile("" :: "v"(oT[0]), "v"(oT[1])); } \
            if (VAR != 1 && (st) >= 1) { \
                _Pragma("unroll") for (int mt = 0; mt < 2; ++mt) { \
                    int row; R2_ROW(st, 16 * mt + l15, row); \
                    unsigned long long* dst = (unsigned long long*)(OR + (size_t)row * 2048 + h * 512 + dvs * 64 + 16 * wq + 4 * g); \
                    const float rs = mt ? rs1 : rs0; \
                    float o0 = oT[mt][0] * rs, o1 = oT[mt][1] * rs, o2 = oT[mt][2] * rs, o3 = oT[mt][3] * rs; \
                    if ((st) >= 33) { const unsigned lo = (unsigned)old[mt], hi = (unsigned)(old[mt] >> 32); \
                        o0 += bflo(lo); o1 += bfhi(lo); o2 += bflo(hi); o3 += bfhi(hi); } \
                    *dst = (unsigned long long)pk2(o0, o1) | ((unsigned long long)pk2(o2, o3) << 32); \
                } \
            } \
            } \
            if ((st) == 32) asm volatile("s_waitcnt vmcnt(0)" ::: "memory");       \
            __syncthreads(); \
        } while (0)
        R2_LOADS(0, rqA, rkA, rvA);
#pragma unroll 1
        for (int st = 0; st < NSTEP; ++st) { R2_STEP(st, rqA, rkA, rvA, oldA, oldA, 1); }
#undef R2_STEP
#undef R2_OLD
#undef R2_ROW
#undef R2_LOADS
    }
}

constexpr size_t AR_TBUF = WS_AR + 32 * MiB;
constexpr int DN_REC = 4608, DN_NSTEP = 65;
static_assert(AR_TBUF + (size_t)BATCH * DH * 2 * DN_NSTEP * DN_REC <= AR_GBETA, "TBUF fits the dead RAW_D region");

__device__ __forceinline__ void dn_rows(int b, int dir, int st, int i, int& rq, int& rg) {
    if (dir == 0) { if (st == 0) { if (i >= 16) { rq = NREAL + b * NMETA + (i - 16); rg = NREAL + (i - 16); } else { rq = -1; rg = -1; } }
                    else { rq = b * SEQ + 32 * (st - 1) + i; rg = rq; } }
    else { if (st == 0) { rq = -1; rg = -1; } else { rq = b * SEQ + 32 * (64 - st) + 31 - i; rg = rq; } }
}

__device__ __forceinline__ void p4b_dn_tinv(const Args& a, Frame& F) {
    const bf16* QD = (const bf16*)(a.ws + AR_QKVD); const float* GB = (const float*)(a.ws + AR_GBETA); unsigned char* TB = a.ws + AR_TBUF;
    LAS float* Am = (LAS float*)(F.lds + F.wave * 4352);
    const int lane = F.lane, g = lane >> 4, l15 = lane & 15;
    for (int idx = F.gw; idx < BATCH * DH * 2 * DN_NSTEP; idx += F.NGW) {
        const int st = idx % DN_NSTEP, bhd = idx / DN_NSTEP, dir = bhd & 1, h = (bhd >> 1) & 7, b = bhd >> 4;
        if (dir == 1 && st == 0) continue;
        float gi = 0.f, bi = 0.f;
        { int rq, rg; dn_rows(b, dir, st, lane & 31, rq, rg); if (rg >= 0) { gi = GB[(size_t)rg * 32 + dir * 8 + h]; bi = GB[(size_t)rg * 32 + 16 + dir * 8 + h]; } }
        float bc = gi;
#pragma unroll
        for (int off = 1; off < 32; off <<= 1) { const float t = __shfl_up(bc, off); if ((lane & 31) >= off) bc += t; }
        bfx8 kf[2][4];
#pragma unroll
        for (int mi = 0; mi < 2; ++mi) { int rq, rg; dn_rows(b, dir, st, 16 * mi + l15, rq, rg);
#pragma unroll
            for (int s = 0; s < 4; ++s) { if (rq >= 0) kf[mi][s] = *(const bfx8*)(QD + (size_t)rq * 3072 + 1024 + h * 128 + 32 * s + 8 * g); else kf[mi][s] = (bfx8){0, 0, 0, 0, 0, 0, 0, 0}; } }
#pragma unroll
        for (int mi = 0; mi < 2; ++mi)
#pragma unroll
            for (int ni = 0; ni < 2; ++ni) {
                f32x4 acc = (f32x4){0.f, 0.f, 0.f, 0.f};
#pragma unroll
                for (int s = 0; s < 4; ++s) acc = MFMA16(kf[mi][s], kf[ni][s], acc);
                const int j = 16 * ni + l15; const float bj = __shfl(bc, j);
#pragma unroll
                for (int r = 0; r < 4; ++r) { const int i = 16 * mi + 4 * g + r; const float bi_ = __shfl(bc, i), be = __shfl(bi, i);
                    Am[i * 33 + j] = (i > j) ? be * acc[r] * __expf(bi_ - bj) : 0.f; }
            }
        asm volatile("s_waitcnt lgkmcnt(0)" ::: "memory");
        float T[32];
        const int c = lane & 31;
#pragma unroll
        for (int i = 0; i < 32; ++i) {
            float s0 = (i == c) ? 1.f : 0.f, s1 = 0.f;
#pragma unroll
            for (int j = 0; j < i; ++j) { const float av = Am[i * 33 + j]; if (j & 1) s1 -= av * T[j]; else s0 -= av * T[j]; }
            T[i] = s0 + s1;
        }
        unsigned char* rec = TB + (size_t)idx * DN_REC;
        const float csc = bi * __expf(bc);
        if (lane < 32) {
#pragma unroll
            for (int i = 0; i < 32; ++i) { ((bf16*)rec)[i * 32 + c] = (bf16)f2bf(T[i]); ((bf16*)(rec + 2048))[i * 32 + c] = (bf16)f2bf(T[i] * csc); }
            ((float*)(rec + 4096))[c] = bc; ((float*)(rec + 4224))[c] = bi;
        }
        asm volatile("s_waitcnt lgkmcnt(0)" ::: "memory");
    }
}

constexpr int D5_QS = 288, D5_VS = 144, D5_TS = 80;
constexpr int D5_Q = 0, D5_K = 9216, D5_V = 18432, D5_T = 23040, D5_T2 = 25600, D5_A = 28160, D5_W = 30720, D5_VEC = 39936, D5_Q2 = 40192, D5_GRP = 49408;
__device__ __forceinline__ void p5_scan_dn(const Args& a, Frame& F) {
    const bf16* QD = (const bf16*)(a.ws + AR_QKVD); const unsigned char* TB = a.ws + AR_TBUF; bf16* OD = (bf16*)(a.ws + AR_OD);
    const int grp = F.wave >> 2, wq = F.wave & 3, tg = F.tid & 255, lane = F.lane, g = lane >> 4, l15 = lane & 15, q4 = (lane & 15) >> 2, p4 = lane & 3;
    LAS unsigned char* L = F.lds + grp * D5_GRP;
    const LAS float* bcv = (const LAS float*)(L + D5_VEC);
    for (int u = blockIdx.x; u < BATCH * DH * 2; u += F.G) {
        const int bh_ = (u & 7) * 8 + ((u >> 3) >> 1), dvh = (u >> 3) & 1, b = bh_ >> 3, h = bh_ & 7;
        const unsigned char* recbase = TB + (size_t)(((b * DH + h) * 2 + grp) * DN_NSTEP) * DN_REC;
        f32x4 S[8];
#pragma unroll
        for (int d = 0; d < 8; ++d) S[d] = (f32x4){0.f, 0.f, 0.f, 0.f};
        v4u rqA[2], rkA[2], rvA, rtA, rvecA, rqB[2], rkB[2], rvB, rtB, rvecB; float rbetaA, rbetaB;
        unsigned long long oldA[2] = {0ull, 0ull}, oldB[2] = {0ull, 0ull};
#define D5_LOADS(st, rq, rk, rv, rt, rvec, rbeta) do { \
        _Pragma("unroll") for (int i_ = 0; i_ < 2; ++i_) { const int cid = tg + 256 * i_, ti = cid >> 4, c16 = cid & 15; int r_, rg_; dn_rows(b, grp, (st), ti, r_, rg_); \
            if (r_ >= 0) { const bf16* src = QD + (size_t)r_ * 3072 + h * 128 + c16 * 8; rq[i_] = *(const v4u*)src; rk[i_] = *(const v4u*)(src + 1024); } \
            else { rq[i_] = (v4u){0u, 0u, 0u, 0u}; rk[i_] = (v4u){0u, 0u, 0u, 0u}; } } \
        { const int ti = tg >> 3, c16 = tg & 7; int r_, rg_; dn_rows(b, grp, (st), ti, r_, rg_); \
            if (r_ >= 0) rv = *(const v4u*)(QD + (size_t)r_ * 3072 + 2048 + h * 128 + dvh * 64 + c16 * 8); else rv = (v4u){0u, 0u, 0u, 0u}; } \
        if (grp == 0 || (st) >= 1) { const unsigned char* rec = recbase + (size_t)(st) * DN_REC; rt = *(const v4u*)(rec + tg * 16); rbeta = *(const float*)(rec + 4224 + (tg >> 3) * 4); \
            if (tg < 16) rvec = *(const v4u*)(rec + 4096 + tg * 16); } \
        else { rt = (v4u){0u, 0u, 0u, 0u}; rbeta = 0.f; rvec = (v4u){0u, 0u, 0u, 0u}; } } while (0)
#define D5_OLD(st, old) do { _Pragma("unroll") for (int mt_ = 0; mt_ < 2; ++mt_) { int row, rg_; dn_rows(b, grp, (st), 16 * mt_ + l15, row, rg_); \
            old[mt_] = __hip_atomic_load((unsigned long long*)(OD + (size_t)row * 1024 + h * 128 + dvh * 64 + 16 * wq + 4 * g), RLX_AGENT); } } while (0)
#define D5_STEP(st, rq, rk, rv, rt, rvec, rbeta, old, oldn) do { \
              \
            _Pragma("unroll") for (int i_ = 0; i_ < 2; ++i_) { const int cid = tg + 256 * i_, ti = cid >> 4, c16 = cid & 15; \
                *(LAS v4u*)(L + D5_Q + ti * D5_QS + c16 * 16) = rq[i_]; *(LAS v4u*)(L + D5_K + ti * D5_QS + c16 * 16) = rk[i_]; \
                { const int cc = c16 & 3, pb = (c16 >> 2) * 64 + (16 * (cc & 1) + 4 * (cc >> 1)) * 2; \
                  *(LAS v2u*)(L + D5_Q2 + ti * D5_QS + pb) = (v2u){rq[i_].x, rq[i_].y}; *(LAS v2u*)(L + D5_Q2 + ti * D5_QS + pb + 16) = (v2u){rq[i_].z, rq[i_].w}; } } \
            { const int ti = tg >> 3, c16 = tg & 7; v4u w; \
                w.x = pk2(bflo(rv.x) * rbeta, bfhi(rv.x) * rbeta); w.y = pk2(bflo(rv.y) * rbeta, bfhi(rv.y) * rbeta); \
                w.z = pk2(bflo(rv.z) * rbeta, bfhi(rv.z) * rbeta); w.w = pk2(bflo(rv.w) * rbeta, bfhi(rv.w) * rbeta); \
                *(LAS v4u*)(L + D5_V + ti * D5_VS + c16 * 16) = w; } \
            { const int tsel = tg >> 7, c = tg & 127; *(LAS v4u*)(L + (tsel ? D5_T2 : D5_T) + (c >> 2) * D5_TS + (c & 3) * 16) = rt; } \
            if (tg < 16) *(LAS v4u*)(L + D5_VEC + tg * 16) = rvec; \
            __syncthreads(); \
            if ((st) == 33) { D5_OLD(33, old); } \
            if ((st) + 1 >= 34 && (st) + 1 < DN_NSTEP) { D5_OLD((st) + 1, oldn); } \
            if ((st) + 2 < DN_NSTEP) { D5_LOADS((st) + 2, rq, rk, rv, rt, rvec, rbeta); } \
              \
            { \
                const int mi = wq >> 1, ni = wq & 1; \
                f32x4 pacc = (f32x4){0.f, 0.f, 0.f, 0.f}; \
                const LAS unsigned char* qa = L + D5_Q + (16 * mi + l15) * D5_QS + g * 16; const LAS unsigned char* kb = L + D5_K + (16 * ni + l15) * D5_QS + g * 16; \
                _Pragma("unroll") for (int s_ = 0; s_ < 4; ++s_) pacc = MFMA16(*(const LAS bfx8*)(qa + s_ * 64), *(const LAS bfx8*)(kb + s_ * 64), pacc); \
                const int j = 16 * ni + l15; const float bj = bcv[j]; \
                _Pragma("unroll") for (int r = 0; r < 4; ++r) { const int i = 16 * mi + 4 * g + r; \
                    *(LAS bf16*)(L + D5_A + i * D5_TS + (8 * ((j & 15) >> 2) + 4 * (j >> 4) + (j & 3)) * 2) = (bf16)f2bf((j <= i) ? pacc[r] * __expf(bcv[i] - bj) : 0.f); } \
                _Pragma("unroll") for (int dd = 0; dd < 2; ++dd) { const int d = 2 * wq + dd; \
                    const bfx8 kf = tr16_frag(L + D5_K + (8 * g + q4) * D5_QS + (16 * d + 4 * p4) * 2, L + D5_K + (8 * g + 4 + q4) * D5_QS + (16 * d + 4 * p4) * 2); \
                    _Pragma("unroll") for (int mt = 0; mt < 2; ++mt) { \
                        f32x4 wacc = MFMA16(kf, *(const LAS bfx8*)(L + D5_T2 + (16 * mt + l15) * D5_TS + g * 16), ((f32x4){0.f, 0.f, 0.f, 0.f})); \
                        v2u w; w.x = pk2(-wacc[0], -wacc[1]); w.y = pk2(-wacc[2], -wacc[3]); \
                        *(LAS v2u*)(L + D5_W + (16 * mt + l15) * D5_QS + (32 * (d >> 1) + 8 * g + 4 * (d & 1)) * 2) = w; \
                    } \
                } \
            } \
            __syncthreads(); \
              \
            const float blast = bcv[31], eL = __expf(blast); \
            const bfx8 vf = tr16_frag(L + D5_V + (8 * g + q4) * D5_VS + (16 * wq + 4 * p4) * 2, L + D5_V + (8 * g + 4 + q4) * D5_VS + (16 * wq + 4 * p4) * 2); \
            f32x4 vn[2], o1[2]; \
            _Pragma("unroll") for (int mt = 0; mt < 2; ++mt) { vn[mt] = MFMA16(*(const LAS bfx8*)(L + D5_T + (16 * mt + l15) * D5_TS + g * 16), vf, ((f32x4){0.f, 0.f, 0.f, 0.f})); o1[mt] = (f32x4){0.f, 0.f, 0.f, 0.f}; } \
            _Pragma("unroll") for (int s_ = 0; s_ < 4; ++s_) { \
                const bfx8 sf = pack_acc2(S[2 * s_], S[2 * s_ + 1], 1.0f); \
                _Pragma("unroll") for (int mt = 0; mt < 2; ++mt) { \
                    vn[mt] = MFMA16(*(const LAS bfx8*)(L + D5_W + (16 * mt + l15) * D5_QS + (32 * s_ + 8 * g) * 2), sf, vn[mt]); \
                    o1[mt] = MFMA16(sf, *(const LAS bfx8*)(L + D5_Q2 + (16 * mt + l15) * D5_QS + (32 * s_ + 8 * g) * 2), o1[mt]); \
                } \
            } \
            const bfx8 vnf = pack_acc2(vn[0], vn[1], 1.0f); \
            f32x4 vs0, vs1; \
            _Pragma("unroll") for (int r = 0; r < 4; ++r) { vs0[r] = vn[0][r] * __expf(blast - bcv[4 * g + r]); vs1[r] = vn[1][r] * __expf(blast - bcv[16 + 4 * g + r]); } \
            const bfx8 vnsf = pack_acc2(vs0, vs1, 1.0f); \
            f32x4 o2[2]; \
            _Pragma("unroll") for (int mt = 0; mt < 2; ++mt) o2[mt] = MFMA16(vnf, *(const LAS bfx8*)(L + D5_A + (16 * mt + l15) * D5_TS + g * 16), ((f32x4){0.f, 0.f, 0.f, 0.f})); \
            _Pragma("unroll") for (int d = 0; d < 8; ++d) { \
                const bfx8 kp = tr16_frag(L + D5_K + (4 * g + q4) * D5_QS + (16 * d + 4 * p4) * 2, L + D5_K + (16 + 4 * g + q4) * D5_QS + (16 * d + 4 * p4) * 2); \
                S[d] = MFMA16(kp, vnsf, S[d] * eL); \
            } \
              \
            if ((st) >= 1) { \
                _Pragma("unroll") for (int mt = 0; mt < 2; ++mt) { \
                    const int i = 16 * mt + l15; int row, rg_; dn_rows(b, grp, (st), i, row, rg_); \
                    unsigned long long* dst = (unsigned long long*)(OD + (size_t)row * 1024 + h * 128 + dvh * 64 + 16 * wq + 4 * g); \
                    const float ei = __expf(bcv[i]); \
                    float x0 = o1[mt][0] * ei + o2[mt][0], x1 = o1[mt][1] * ei + o2[mt][1], x2 = o1[mt][2] * ei + o2[mt][2], x3 = o1[mt][3] * ei + o2[mt][3]; \
                    if ((st) >= 33) { const unsigned lo = (unsigned)old[mt], hi = (unsigned)(old[mt] >> 32); \
                        x0 += bflo(lo); x1 += bfhi(lo); x2 += bflo(hi); x3 += bfhi(hi); } \
                    *dst = (unsigned long long)pk2(x0, x1) | ((unsigned long long)pk2(x2, x3) << 32); \
                } \
            } \
            if ((st) == 32) asm volatile("s_waitcnt vmcnt(0)" ::: "memory"); \
            __syncthreads(); \
        } while (0)
        D5_LOADS(0, rqA, rkA, rvA, rtA, rvecA, rbetaA);
        D5_LOADS(1, rqB, rkB, rvB, rtB, rvecB, rbetaB);
#pragma unroll 1
        for (int st = 0; st < DN_NSTEP; st += 2) {
            D5_STEP(st, rqA, rkA, rvA, rtA, rvecA, rbetaA, oldA, oldB);
            if (st + 1 < DN_NSTEP) { D5_STEP(st + 1, rqB, rkB, rvB, rtB, rvecB, rbetaB, oldB, oldA); }
        }
#undef D5_STEP
#undef D5_OLD
#undef D5_LOADS
    }
}

#ifndef PROBE_VARIANT
#define PROBE_VARIANT 0
#endif
#ifndef PROBE_PHASE
#define PROBE_PHASE -1
#endif

constexpr int NPHASES = 16;
__global__ void __launch_bounds__(NTHREADS, 2) fwd_kernel(Args args) {
    extern __shared__ __attribute__((aligned(16))) unsigned char lds_raw[];
    Frame F;
    F.lds = (LAS unsigned char*)lds_raw;
    F.tid = threadIdx.x; F.lane = F.tid & 63; F.wave = __builtin_amdgcn_readfirstlane(F.tid >> 6);
    F.G = gridDim.x; F.gw = blockIdx.x * NWAVES + F.wave; F.NGW = F.G * NWAVES;
    volatile LAS unsigned* MISC = (volatile LAS unsigned*)(F.lds + MISC_OFF);
    for (int u = F.tid; u < (LDS_BYTES - RING_BYTES) / 4; u += NTHREADS) ((LAS unsigned*)(F.lds + RING_BYTES))[u] = 0u;
    __syncthreads();
    unsigned* ctl = (unsigned*)(args.ws + WS_CTL);
    const int lo = args.ph_lo, hi = args.ph_hi;
    XcdBarrier bar; bar.bar = ctl + CW_BAR; bar.x = 0; bar.st = nullptr;
    if (hi - lo > 1) bar = xcd_barrier_post(ctl + CW_BAR, MISC + 8);
#define IN(k) (lo <= (k) && (k) < hi)
#define SEAM(k) do { if (IN(k) && IN((k) + 1)) xcd_barrier(bar); } while (0)
    unsigned char* ws = args.ws;
    bf16* HB = (bf16*)(ws + WS_HB); bf16* WT = (bf16*)(ws + WS_WT);

    if (IN(0)) { p0_prologue(args, F); } SEAM(0);
    if (IN(1)) {
        pg8::Gemm g{HB, WT + (size_t)WT_A0 * D, MROWS, WT_A_N, D}; pg8::StaticOrder S; S.init(MROWS, WT_A_N, F.G, (int)blockIdx.x);
        ep::EpiRot E{(bf16*)(ws + AR_QKVR)};
        pg8::gemm_phase<ep::EpiRot, pg8::StaticOrder, true, true>(F.lds, g, S, E);
    } SEAM(1);
    if (IN(2)) { if (args.variant == 0) p2_scan_ret<0>(args, F); else p2_scan_ret<PROBE_VARIANT>(args, F); } SEAM(2);
    if (IN(3)) {
        pg8::Gemm g{HB, WT + (size_t)WT_B0 * D, MROWS, WT_B_N, D}; pg8::StaticOrder S; S.init(MROWS, WT_B_N, F.G, (int)blockIdx.x);
        ep::EpiDn E{(bf16*)(ws + AR_RAWD), (float*)(ws + AR_GBETA), args.dn_a_log, args.dn_dt_bias};
        pg8::gemm_phase<ep::EpiDn, pg8::StaticOrder, true, true>(F.lds, g, S, E);
    } SEAM(3);
    if (IN(4)) { p4_conv(args, F); } SEAM(4);
    if (IN(5)) { p4b_dn_tinv(args, F); } SEAM(5);
    if (IN(6)) { p5_scan_dn(args, F); } SEAM(6);
    if (IN(7)) {
        p6_small_weights(args, F);
        __syncthreads();
        pg8::Gemm g{HB, WT + (size_t)WT_C0 * D, NREAL, WT_C_N, D}; pg8::StaticOrder S; S.init(NREAL, WT_C_N, F.G, (int)blockIdx.x);
        ep::EpiGates E{(bf16*)(ws + AR_GRG), (bf16*)(ws + AR_GDZ), (bf16*)(ws + AR_GGA), (bf16*)(ws + AR_GGB)};
        pg8::gemm_phase<ep::EpiGates, pg8::StaticOrder, true, true>(F.lds, g, S, E);
    } SEAM(7);
    if (IN(8)) { p7_gate_norm(args, F); } SEAM(8);
    if (IN(9)) {
        pg8::Gemm g{(const bf16*)args.out, (const bf16*)(ws + AR_PRETT), NREAL, 1024, 2048}; pg8::StaticOrder S; S.init(NREAL, 1024, F.G, (int)blockIdx.x);
        ep::EpiMerge<false> E{(const bf16*)(ws + AR_GGA), nullptr, (bf16*)(ws + AR_M1)};
        pg8::gemm_phase<ep::EpiMerge<false>, pg8::StaticOrder, true, true>(F.lds, g, S, E);
    } SEAM(9);
    if (IN(10)) {
        pg8::Gemm g{(const bf16*)(ws + AR_OD), (const bf16*)(ws + AR_PDNT), NREAL, 1024, 1024}; pg8::StaticOrder S; S.init(NREAL, 1024, F.G, (int)blockIdx.x);
        ep::EpiMerge<true> E{(const bf16*)(ws + AR_GGB), (const bf16*)(ws + AR_M1), (bf16*)(ws + AR_MERGED)};
        pg8::gemm_phase<ep::EpiMerge<true>, pg8::StaticOrder, true, true>(F.lds, g, S, E);
    } SEAM(10);
    if (IN(11)) {
        pg8::Gemm g{(const bf16*)(ws + AR_MERGED), (const bf16*)(ws + AR_WOUTT), NREAL, 1024, 1024}; pg8::StaticOrder S; S.init(NREAL, 1024, F.G, (int)blockIdx.x);
        ep::EpiRes E{HB, (float*)(ws + AR_PRE)};
        pg8::gemm_phase<ep::EpiRes, pg8::StaticOrder, true, true>(F.lds, g, S, E);
    } SEAM(11);
    if (IN(12)) { p11_ln1_tables(args, F); } SEAM(12);
    if (IN(13)) {
        pg8::Gemm g{(const bf16*)(ws + AR_H1), (const bf16*)(ws + AR_W2T), NREAL, 2048, 1024}; pg8::StaticOrder S; S.init(NREAL, 2048, F.G, (int)blockIdx.x);
        ep::EpiF32 E{(float*)(ws + AR_SCORES), 2048};
        pg8::gemm_phase<ep::EpiF32, pg8::StaticOrder, true, true>(F.lds, g, S, E);
    } SEAM(13);
    if (IN(14)) { p13_topk(args, F); } SEAM(14);
    if (IN(15)) { p14_gather(args, F); }
#undef IN
#undef SEAM
}

#ifndef N_LAUNCH_MODE
#define N_LAUNCH_MODE 1
#endif
extern "C" void kernel_launch(void* const* d_in, const int* in_sizes, int n_in, void* d_out, int out_size, void* d_ws, size_t ws_size, hipStream_t stream) {
    static int grid = 0;
    if (grid == 0) {
        if (n_in != 21 || out_size != NREAL * D || ws_size < WS_END) { fprintf(stderr, "kernel_launch: unexpected shapes (n_in %d, out %d, ws %zu)\n", n_in, out_size, ws_size); grid = -1; return; }
        int dev = 0, cus = 0;
        if (hipGetDevice(&dev) != hipSuccess || hipDeviceGetAttribute(&cus, hipDeviceAttributeMultiprocessorCount, dev) != hipSuccess) { grid = -1; return; }
        if (hipFuncSetAttribute((const void*)fwd_kernel, hipFuncAttributeMaxDynamicSharedMemorySize, LDS_BYTES) != hipSuccess) { grid = -1; return; }
        int per_cu = 0;
        (void)hipOccupancyMaxActiveBlocksPerMultiprocessor(&per_cu, (const void*)fwd_kernel, NTHREADS, LDS_BYTES);
        (void)hipGetLastError();
        grid = cus;
    }
    if (grid < 0) return;
    (void)hipMemsetAsync((char*)d_ws + WS_CTL, 0, CTL_ZERO_BYTES, stream);
    Args a{};
    const float** fp = (const float**)&a;
    for (int i = 0; i < 21; ++i) fp[i] = (const float*)d_in[i];
    a.out = (float*)d_out; a.ws = (unsigned char*)d_ws;
    if (N_LAUNCH_MODE == 1) {
#if PROBE_PHASE >= 0 && PROBE_PHASE < 13
        a.ph_lo = PROBE_PHASE; a.ph_hi = PROBE_PHASE + 1; a.variant = 1;
        hipLaunchKernelGGL(fwd_kernel, dim3(grid), dim3(NTHREADS), LDS_BYTES, stream, a);
        a.variant = 0;
#endif
        a.ph_lo = 0; a.ph_hi = NPHASES;
        hipLaunchKernelGGL(fwd_kernel, dim3(grid), dim3(NTHREADS), LDS_BYTES, stream, a);
#if PROBE_PHASE >= 13
        a.ph_lo = PROBE_PHASE; a.ph_hi = PROBE_PHASE + 1;
        hipLaunchKernelGGL(fwd_kernel, dim3(grid), dim3(NTHREADS), LDS_BYTES, stream, a);
#endif
    } else {
        for (int p = 0; p < NPHASES; ++p) { a.ph_lo = p; a.ph_hi = p + 1; hipLaunchKernelGGL(fwd_kernel, dim3(grid), dim3(NTHREADS), LDS_BYTES, stream, a); }
    }
}
```

```cpp
#include <hip/hip_runtime.h>
#include <cstdio>
#include <cstdint>
namespace pg8 {
#define PG8_LAS __attribute__((address_space(3)))
typedef unsigned short bf16_t;
typedef short bf16x8 __attribute__((ext_vector_type(8)));
typedef float f32x4 __attribute__((ext_vector_type(4)));
typedef unsigned u32x4 __attribute__((ext_vector_type(4)));
constexpr int BM = 256, BK = 64, HALF = 128, HTB = HALF * BK * 2  , STAGE_BYTES = 8 * HTB, NXCD = 8, WGM = 8;

__host__ __device__ __forceinline__ int lds_byte(int r, int c) { const int st = (r >> 4) * 2 + (c >> 5), rr = r & 15, cc = c & 31, ob = rr * 64 + cc * 2; return st * 1024 + (ob ^ (((ob >> 9) & 1) << 5)); }
__host__ __device__ __forceinline__ void stage_rc(int b, int& R, int& C) { const int st = b / 1024, sb = b % 1024, swz = sb ^ (((sb >> 9) & 1) << 5); R = (st >> 1) * 16 + swz / 64; C = (st & 1) * 32 + (swz % 64) / 2; }
__host__ __device__ __forceinline__ int perm32(int rho) { const int n = rho >> 4, i = rho & 15; return 8 * (i >> 2) + 4 * n + (i & 3); }

struct Unit { int pm, pn; };
struct Gemm { const bf16_t* A; const bf16_t* Bt; int M, N, K; };

struct StaticOrder {
    int nM, nN, nwg, G, c;
    __host__ __device__ void init(int M, int N, int G_, int c_) { nM = M / BM; nN = N / BM; nwg = nM * nN; G = G_; c = c_; }
    __host__ __device__ bool next(int i, Unit& u) const {
        const long L = (long)i * G + c; if (L >= nwg) return false;
        int wgid = (int)L; { const int q = nwg / NXCD, r = nwg % NXCD, xcd = wgid % NXCD, off = wgid / NXCD; wgid = (xcd < r ? xcd * (q + 1) : r * (q + 1) + (xcd - r) * q) + off; }
        const int nig = WGM * nN, gid = wgid / nig, fm = gid * WGM, gsz = (nM - fm) < WGM ? (nM - fm) : WGM;
        u.pm = fm + ((wgid % nig) % gsz); u.pn = (wgid % nig) / gsz; return true;
    }
    __device__ __forceinline__ void a_ready(const Unit&) const {}
    __device__ __forceinline__ void done(const Unit&) const {}
};
__device__ __forceinline__ unsigned cvt_pk_bf16(float lo, float hi) { unsigned r; asm volatile("v_cvt_pk_bf16_f32 %0, %1, %2" : "=v"(r) : "v"(lo), "v"(hi)); return r; }
template <class Epi, class Sched, bool ALIGN_EPI = false, bool SP2 = false>
__device__ __forceinline__ void gemm_phase(PG8_LAS unsigned char* lds, const Gemm g, const Sched& S, const Epi& E) {
    const int tid = threadIdx.x, wid = __builtin_amdgcn_readfirstlane(tid >> 6), lane = tid & 63, wr = wid >> 2, wc = wid & 3, fr = lane & 15, fq = lane >> 4;
    const int K = g.K, nt = K / BK;
    unsigned voffA[2], voffB[2];
#pragma unroll
    for (int i = 0; i < 2; ++i) { int R, C; stage_rc(tid * 16 + i * 8192, R, C); const int Rb = Epi::PERM ? ((R & ~31) + perm32(R & 31)) : R;
        voffA[i] = (unsigned)(R * K + C) * 2u; voffB[i] = (unsigned)(Rb * K + C) * 2u; }
    const size_t kstep = (size_t)(BK * 2);
    const size_t hstep = (size_t)HALF * K * 2;
    const size_t tstep = 2 * hstep;
    const unsigned ldsw = (unsigned)wid * 1024u;
    const int aoff = lds_byte(wr * 64 + fr, fq * 8), boff = lds_byte(wc * 32 + fr, fq * 8);
#define PG8_SA(b, h) (((b) * 2 + (h)) * HTB)
#define PG8_SB(b, h) ((4 + (b) * 2 + (h)) * HTB)
#define PG8_STAGE(bufoff, gbase, voff) do { _Pragma("unroll") for (int _i = 0; _i < 2; ++_i) \
        __builtin_amdgcn_global_load_lds((const unsigned*)((const char*)(gbase) + (voff)[_i]), (PG8_LAS unsigned*)(lds + (bufoff) + ldsw + _i * 8192), 16, 0, 0); } while (0)
#define PG8_LDA(dst, b, h) do { _Pragma("unroll") for (int m = 0; m < 4; ++m) _Pragma("unroll") for (int k = 0; k < 2; ++k) dst[m][k] = *(const PG8_LAS bf16x8*)(lds + PG8_SA(b, h) + aoff + m * 2048 + k * 1024); } while (0)
#define PG8_LDB(dst, b, h) do { _Pragma("unroll") for (int n = 0; n < 2; ++n) _Pragma("unroll") for (int k = 0; k < 2; ++k) dst[n][k] = *(const PG8_LAS bf16x8*)(lds + PG8_SB(b, h) + boff + n * 2048 + k * 1024); } while (0)
#define PG8_MMA(ai, bj, At, Bt) do { __builtin_amdgcn_s_setprio(1); _Pragma("unroll") for (int m = 0; m < 4; ++m) _Pragma("unroll") for (int n = 0; n < 2; ++n) _Pragma("unroll") for (int k = 0; k < 2; ++k) \
        acc[ai][bj][m][n] = __builtin_amdgcn_mfma_f32_16x16x32_bf16(Bt[n][k], At[m][k], acc[ai][bj][m][n], 0, 0, 0); __builtin_amdgcn_s_setprio(0); } while (0)
#define PG8_WAIT_V(n) asm volatile("s_waitcnt vmcnt(" #n ")" ::: "memory")
#define PG8_WAIT_L(n) asm volatile("s_waitcnt lgkmcnt(" #n ")" ::: "memory")
#define PG8_BAR __builtin_amdgcn_s_barrier()
#define PG8_SCHED __builtin_amdgcn_sched_barrier(0)
    Unit cur, nxt; int ui = 0;
    if (!S.next(0, cur)) return;
    f32x4 acc[2][2][4][2];
#pragma unroll
    for (int a = 0; a < 2; ++a)
#pragma unroll
        for (int b = 0; b < 2; ++b)
#pragma unroll
            for (int m = 0; m < 4; ++m)
#pragma unroll
                for (int n = 0; n < 2; ++n) acc[a][b][m][n] = (f32x4){0.f, 0.f, 0.f, 0.f};
    bf16x8 At[4][2], B0[2][2], B1[2][2];
    const char* cA = (const char*)g.A + (size_t)cur.pm * tstep; const char* cB = (const char*)g.Bt + (size_t)cur.pn * tstep;
    S.a_ready(cur);
    if constexpr (SP2) {
        PG8_STAGE(PG8_SB(0, 0), cB, voffB); PG8_STAGE(PG8_SB(0, 1), cB + hstep, voffB); PG8_STAGE(PG8_SA(0, 0), cA, voffA); PG8_STAGE(PG8_SA(0, 1), cA + hstep, voffA);
        if (wr == 1) PG8_BAR;
        PG8_WAIT_V(2); PG8_BAR;
        PG8_STAGE(PG8_SB(1, 0), cB + kstep, voffB); PG8_STAGE(PG8_SA(1, 0), cA + kstep, voffA); PG8_STAGE(PG8_SB(1, 1), cB + hstep + kstep, voffB);
        PG8_WAIT_V(6); PG8_BAR;
    } else {
        PG8_STAGE(PG8_SB(0, 0), cB, voffB); PG8_STAGE(PG8_SA(0, 0), cA, voffA); PG8_STAGE(PG8_SB(0, 1), cB + hstep, voffB); PG8_STAGE(PG8_SA(0, 1), cA + hstep, voffA);
        if (wr == 1) PG8_BAR;
        PG8_WAIT_V(4); PG8_BAR;
        PG8_STAGE(PG8_SB(1, 0), cB + kstep, voffB); PG8_STAGE(PG8_SA(1, 0), cA + kstep, voffA); PG8_STAGE(PG8_SB(1, 1), cB + hstep + kstep, voffB);
        PG8_WAIT_V(6); PG8_BAR;
    }
    for (;;) {
        const bool has_next = S.next(ui + 1, nxt);
        const char* nA = has_next ? (const char*)g.A + (size_t)nxt.pm * tstep : cA; const char* nB = has_next ? (const char*)g.Bt + (size_t)nxt.pn * tstep : cB;
        for (int t = 0; t < nt; t += 2) {
            const bool last = (t == nt - 2);
            const char* a1 = cA + (size_t)(t + 1) * kstep;
            const char* a2 = last ? nA : cA + (size_t)(t + 2) * kstep; const char* b2 = last ? nB : cB + (size_t)(t + 2) * kstep;
            const char* a3 = a2 + kstep; const char* b3 = b2 + kstep;
            if (last && has_next) S.a_ready(nxt);
            if constexpr (SP2) {
            PG8_LDB(B0, 0, 0); PG8_LDB(B1, 0, 1); PG8_SCHED; PG8_LDA(At, 0, 0); PG8_STAGE(PG8_SA(1, 1), a1 + hstep, voffA);
            PG8_WAIT_V(8); PG8_WAIT_L(0); PG8_BAR; PG8_MMA(0, 0, At, B0); PG8_MMA(0, 1, At, B1); PG8_BAR; PG8_SCHED;
            PG8_LDA(At, 0, 1); PG8_STAGE(PG8_SB(0, 0), b2, voffB); PG8_STAGE(PG8_SB(0, 1), b2 + hstep, voffB); PG8_STAGE(PG8_SA(0, 0), a2, voffA);
            PG8_WAIT_V(8); PG8_WAIT_L(0); PG8_BAR; PG8_MMA(1, 0, At, B0); PG8_MMA(1, 1, At, B1); PG8_BAR; PG8_SCHED;
            PG8_LDB(B0, 1, 0); PG8_LDB(B1, 1, 1); PG8_SCHED; PG8_LDA(At, 1, 0); PG8_STAGE(PG8_SA(0, 1), a2 + hstep, voffA);
            PG8_WAIT_V(8); PG8_WAIT_L(0); PG8_BAR; PG8_MMA(0, 0, At, B0); PG8_MMA(0, 1, At, B1); PG8_BAR; PG8_SCHED;
            PG8_LDA(At, 1, 1); PG8_STAGE(PG8_SB(1, 0), b3, voffB); PG8_STAGE(PG8_SB(1, 1), b3 + hstep, voffB); PG8_STAGE(PG8_SA(1, 0), a3, voffA);
            PG8_WAIT_V(8); PG8_WAIT_L(0); PG8_BAR; PG8_MMA(1, 0, At, B0); PG8_MMA(1, 1, At, B1); PG8_BAR; PG8_SCHED;
            } else {
            PG8_LDB(B0, 0, 0); PG8_SCHED; PG8_LDA(At, 0, 0); PG8_STAGE(PG8_SA(1, 1), a1 + hstep, voffA);
            PG8_WAIT_L(8); PG8_BAR; PG8_WAIT_L(0); PG8_MMA(0, 0, At, B0); PG8_BAR; PG8_SCHED;
            PG8_LDB(B1, 0, 1); PG8_STAGE(PG8_SB(0, 0), b2, voffB);
            PG8_BAR; PG8_WAIT_L(0); PG8_MMA(0, 1, At, B1); PG8_BAR;
            PG8_LDA(At, 0, 1); PG8_STAGE(PG8_SA(0, 0), a2, voffA);
            PG8_BAR; PG8_WAIT_L(0); PG8_MMA(1, 0, At, B0); PG8_BAR; PG8_SCHED;
            PG8_STAGE(PG8_SB(0, 1), b2 + hstep, voffB);
            PG8_WAIT_V(6); PG8_BAR; PG8_MMA(1, 1, At, B1); PG8_BAR;
            PG8_LDB(B0, 1, 0); PG8_SCHED; PG8_LDA(At, 1, 0); PG8_STAGE(PG8_SA(0, 1), a2 + hstep, voffA);
            PG8_WAIT_L(8); PG8_BAR; PG8_WAIT_L(0); PG8_MMA(0, 0, At, B0); PG8_BAR; PG8_SCHED;
            PG8_LDB(B1, 1, 1); PG8_STAGE(PG8_SB(1, 0), b3, voffB);
            PG8_BAR; PG8_WAIT_L(0); PG8_MMA(0, 1, At, B1); PG8_BAR;
            PG8_LDA(At, 1, 1); PG8_STAGE(PG8_SA(1, 0), a3, voffA);
            PG8_BAR; PG8_WAIT_L(0); PG8_MMA(1, 0, At, B0); PG8_BAR; PG8_SCHED;
            PG8_STAGE(PG8_SB(1, 1), b3 + hstep, voffB);
            PG8_WAIT_V(6); PG8_BAR; PG8_MMA(1, 1, At, B1); PG8_BAR;
            }
        }
        if constexpr (ALIGN_EPI) { if (wr == 0) PG8_BAR; }
        if constexpr (!Epi::AFTER_DRAIN) { E(acc, cur, wr, wc, fr, fq); S.done(cur); }
        if (!has_next) break;
#pragma unroll
        for (int a = 0; a < 2; ++a)
#pragma unroll
            for (int b = 0; b < 2; ++b)
#pragma unroll
                for (int m = 0; m < 4; ++m)
#pragma unroll
                    for (int n = 0; n < 2; ++n) acc[a][b][m][n] = (f32x4){0.f, 0.f, 0.f, 0.f};
        cur = nxt; cA = nA; cB = nB; ++ui;
        if constexpr (ALIGN_EPI) { if (wr == 1) PG8_BAR; }
    }
    PG8_WAIT_V(0);
    if constexpr (!ALIGN_EPI) { if (wr == 0) PG8_BAR; }
    PG8_BAR;
    if constexpr (Epi::AFTER_DRAIN) { E.fused(acc, cur, wr, wc, fr, fq, lds, wid, lane); S.done(cur); }
#undef PG8_SA
#undef PG8_SB
#undef PG8_STAGE
#undef PG8_LDA
#undef PG8_LDB
#undef PG8_MMA
#undef PG8_WAIT_V
#undef PG8_WAIT_L
#undef PG8_BAR
#undef PG8_SCHED
}
}
#define XB_TMO      128
#define XB_XCNT(j)  (256  + 64 * (j))
#define XB_XSUB(j)  (1280 + 64 * (j))
#define XB_XGEN(j)  (2304 + 64 * (j))
#define XB_TOP      3328
#define XB_TOPGEN   3392
#define XCD_BAR_WORDS 3456
#define XB_SPIN_CAP (1u << 18)
#define LAS __attribute__((address_space(3)))

__device__ __forceinline__ unsigned xb_ld(unsigned* p)              { return __hip_atomic_load(p, __ATOMIC_RELAXED, __HIP_MEMORY_SCOPE_AGENT); }
__device__ __forceinline__ unsigned xb_add(unsigned* p, unsigned v) { return __hip_atomic_fetch_add(p, v, __ATOMIC_RELAXED, __HIP_MEMORY_SCOPE_AGENT); }
__device__ __forceinline__ unsigned xb_xcc_id() { return (unsigned)__builtin_amdgcn_s_getreg((3 << 11) | 20) & 0xFu; }
#define XB_SPIN(cond, bar) do { unsigned _sp = 0; while (cond) { __builtin_amdgcn_s_sleep(1); \
    if ((++_sp & 255u) == 0u) { if (xb_ld(&(bar)[XB_TMO])) break; if (_sp > XB_SPIN_CAP) { atomicAdd(&(bar)[XB_TMO], 1u); break; } } } } while (0)

struct XcdBarrier {
    unsigned* bar; unsigned x;
    volatile LAS unsigned* st;
};

__device__ __forceinline__ XcdBarrier xcd_barrier_post(unsigned* bar, volatile LAS unsigned* st) {
    XcdBarrier b; b.bar = bar; b.x = xb_xcc_id(); b.st = st;
    if (threadIdx.x == 0) (void)xb_add(&bar[XB_XCNT(b.x)], 1u);
    return b;
}
__device__ __forceinline__ void xcd_barrier_complete(unsigned* bar, unsigned x, unsigned& nloc, unsigned& nx) {
    const unsigned G = gridDim.x * gridDim.y * gridDim.z;
    unsigned sum, cnt, mine, sp = 0u;
    for (;;) {
        sum = 0u; cnt = 0u; mine = 0u;
#pragma unroll
        for (unsigned j = 0; j < 16; ++j) { const unsigned c = xb_ld(&bar[XB_XCNT(j)]); sum += c; cnt += (c > 0u) ? 1u : 0u; mine = (j == x) ? c : mine; }
        if (sum == G) break;
        __builtin_amdgcn_s_sleep(1);
        if ((++sp & 255u) == 0u) { if (xb_ld(&bar[XB_TMO])) break; if (sp > XB_SPIN_CAP) { atomicAdd(&bar[XB_TMO], 1u); break; } }
    }
    nloc = mine > 0u ? mine : 1u; nx = cnt > 0u ? cnt : 1u;
}

__device__ __forceinline__ void xcd_barrier(const XcdBarrier& b) {
    asm volatile("s_waitcnt vmcnt(0)" ::: "memory");
    __syncthreads();
    if (threadIdx.x == 0) {
        unsigned* bar = b.bar;
        __builtin_amdgcn_s_waitcnt(0);
        unsigned nloc = b.st[0], nx = b.st[1];
        if (nloc == 0u) { xcd_barrier_complete(bar, b.x, nloc, nx); b.st[0] = nloc; b.st[1] = nx; }
        const unsigned old = xb_add(&bar[XB_XSUB(b.x)], 1u);
        const unsigned gen = old / nloc;
        if (old + 1u == (gen + 1u) * nloc) {
            __builtin_amdgcn_fence(__ATOMIC_RELEASE, "agent");
            asm volatile("s_waitcnt vmcnt(0)" ::: "memory");
            const unsigned og = xb_add(&bar[XB_TOP], 1u);
            const unsigned tg = og / nx;
            if (og + 1u == (tg + 1u) * nx) xb_add(&bar[XB_TOPGEN], 1u);
            else XB_SPIN(xb_ld(&bar[XB_TOPGEN]) == tg, bar);
            __builtin_amdgcn_fence(__ATOMIC_ACQUIRE, "agent");
            xb_add(&bar[XB_XGEN(b.x)], 1u);
            asm volatile("s_waitcnt vmcnt(0)" ::: "memory");
        } else {
            XB_SPIN(xb_ld(&bar[XB_XGEN(b.x)]) == gen, bar);
            __builtin_amdgcn_fence(__ATOMIC_ACQUIRE, "agent");
            asm volatile("s_waitcnt vmcnt(0)" ::: "memory");
        }
    }
    __syncthreads();
}

constexpr int D = 1024, BATCH = 8, SEQ = 2048, NMETA = 16, LTOT = SEQ + NMETA;
constexpr int NREAL = BATCH * SEQ;
constexpr int MROWS = 16640;
constexpr int NROWS_D = NREAL + BATCH * NMETA;
constexpr int IN_W = 12320;
constexpr int RH = 4, RDK = 256, RDV = 512;
constexpr int DH = 8, DDK = 128, DDV = 128;
constexpr int NEXP = 16384, PH = 8, PK = 16;
constexpr int WT_ROWS = 12544, WT_A0 = 0, WT_A_N = 4096, WT_B0 = 4096, WT_B_N = 3328, WT_C0 = 7424, WT_C_N = 5120;
constexpr float LN_EPS = 1e-5f, RMS_EPS = 1e-6f;
constexpr float DN_ALPHA = 1.189207115f;

constexpr size_t MiB = 1u << 20;
constexpr size_t WS_CTL = 0, CTL_ZERO_BYTES = 1 * MiB;
constexpr size_t WS_HB = 1 * MiB;
constexpr size_t WS_WT = WS_HB + (size_t)MROWS * D * 2;
constexpr size_t WS_AR = 58 * MiB;
constexpr size_t WS_END = 264 * MiB;
static_assert(WS_WT + (size_t)WT_ROWS * D * 2 <= WS_AR, "map");
constexpr size_t AR_QKVR = WS_AR;
constexpr size_t AR_RAWD = WS_AR;
constexpr size_t AR_GBETA = WS_AR + 97 * MiB + 512 * 1024;
constexpr size_t AR_QKVD = WS_AR + 100 * MiB;
constexpr size_t AR_OD = WS_AR;
constexpr size_t AR_GRG = WS_AR + 32 * MiB, AR_GDZ = WS_AR + 96 * MiB, AR_GGA = WS_AR + 128 * MiB, AR_GGB = WS_AR + 160 * MiB;
constexpr size_t AR_PRETT = WS_AR + 192 * MiB, AR_PDNT = WS_AR + 196 * MiB, AR_WOUTT = WS_AR + 198 * MiB, AR_W2T = WS_AR + 200 * MiB;
constexpr size_t AR_M1 = WS_AR + 32 * MiB, AR_MERGED = WS_AR + 64 * MiB, AR_PRE = WS_AR + 96 * MiB;
constexpr size_t AR_H1 = WS_AR;
constexpr size_t WS_UB = 1 * MiB, AR_VB = WS_AR + 160 * MiB;
constexpr size_t AR_SCORES = WS_AR + 32 * MiB;
constexpr size_t WS_EXP = WS_WT, WS_GATE = WS_WT + 8 * MiB;
static_assert(AR_QKVD + (size_t)NROWS_D * 3072 * 2 <= WS_END && AR_W2T + 4 * MiB <= WS_END && AR_GBETA + (size_t)MROWS * 32 * 4 <= AR_QKVD, "map");
constexpr int CW_BAR = 4096;

constexpr int RING_BYTES = 131072, MISC_OFF = RING_BYTES + 320, LDS_BYTES = 147456;
constexpr int NWAVES = 8, NTHREADS = 512;

#define GAS __attribute__((address_space(1)))
#define LAS __attribute__((address_space(3)))
typedef unsigned short bf16;
typedef unsigned v4u __attribute__((ext_vector_type(4)));
typedef unsigned v2u __attribute__((ext_vector_type(2)));
typedef float f32x4 __attribute__((ext_vector_type(4)));
#define RLX_AGENT __ATOMIC_RELAXED, __HIP_MEMORY_SCOPE_AGENT

typedef __bf16 bf2_t __attribute__((ext_vector_type(2)));
typedef float f2_t __attribute__((ext_vector_type(2)));
__device__ __forceinline__ unsigned pk2(float lo, float hi) { const f2_t f = {lo, hi}; return __builtin_bit_cast(unsigned, __builtin_convertvector(f, bf2_t)); }
__device__ __forceinline__ unsigned f2bf(float f) { return pk2(f, 0.f) & 0xffffu; }
__device__ __forceinline__ float bflo(unsigned u) { return __builtin_bit_cast(float, u << 16); }
__device__ __forceinline__ float bfhi(unsigned u) { return __builtin_bit_cast(float, u & 0xffff0000u); }
__device__ __forceinline__ float bf2f(bf16 h) { return __builtin_bit_cast(float, ((unsigned)h) << 16); }
__device__ __forceinline__ float sigmoidf_(float x) { return 1.0f / (1.0f + __expf(-x)); }
__device__ __forceinline__ float siluf_(float x) { return x / (1.0f + __expf(-x)); }
__device__ __forceinline__ float wave_sum(float v) {
#pragma unroll
    for (int o = 1; o < 64; o <<= 1) v += __shfl_xor(v, o);
    return v;
}
__device__ __forceinline__ int row_of(int b, int p) { return p < NMETA ? NREAL + p : b * SEQ + (p - NMETA); }
__device__ __forceinline__ int rowd_of(int b, int p) { return p < NMETA ? NREAL + b * NMETA + p : b * SEQ + (p - NMETA); }

struct Args {
    const float *x, *meta, *emb_g, *emb_b, *w_in, *ret_decay, *dn_conv, *dn_a_log, *dn_dt_bias, *dn_norm_g, *p_ret, *p_dn, *w_out, *ln1_g, *ln1_b,
                *peer_wq, *peer_keys, *peer_u, *peer_v, *ln2_g, *ln2_b;
    float* out; unsigned char* ws; int ph_lo, ph_hi, variant, pad_;
};

struct Frame {
    LAS unsigned char* lds;
    int tid, lane, wave, G, gw, NGW;
};

namespace ep {
using pg8::f32x4; using pg8::Unit; using pg8::u32x4; using pg8::cvt_pk_bf16;
__device__ __forceinline__ u32x4 pack8(f32x4 a, f32x4 b) { u32x4 w; w.x = cvt_pk_bf16(a[0], a[1]); w.y = cvt_pk_bf16(a[2], a[3]); w.z = cvt_pk_bf16(b[0], b[1]); w.w = cvt_pk_bf16(b[2], b[3]); return w; }
__device__ __forceinline__ void unpack8(u32x4 w, f32x4& a, f32x4& b) { a = (f32x4){bflo(w.x), bfhi(w.x), bflo(w.y), bfhi(w.y)}; b = (f32x4){bflo(w.z), bfhi(w.z), bflo(w.w), bfhi(w.w)}; }

struct EpiRot {
    static constexpr bool PERM = true, AFTER_DRAIN = false;
    bf16* O;
    __device__ __forceinline__ void operator()(const f32x4 (&acc)[2][2][4][2], const Unit& u, int wr, int wc, int fr, int fq) const {
        const int row0 = u.pm * 256 + wr * 64 + fr, colb = wc * 32 + 8 * fq;
        if (u.pn < 8) {
            const float sc = (u.pn >= 4) ? 0.0625f : 1.0f;
            float rev[8];
#pragma unroll
            for (int e = 0; e < 8; ++e) rev[e] = exp2f(-(float)(colb + e) * (13.287712379549449f / 128.0f)) * 0.15915494309189535f;
#pragma unroll
            for (int ai = 0; ai < 2; ++ai)
#pragma unroll
                for (int m = 0; m < 4; ++m) {
                    const int r = row0 + ai * 128 + m * 16;
                    const float pos = (float)(r < NREAL ? (r & (SEQ - 1)) + NMETA : r - NREAL);
                    f32x4 o1[2], o2[2];
#pragma unroll
                    for (int n = 0; n < 2; ++n)
#pragma unroll
                        for (int e = 0; e < 4; ++e) {
                            float t = pos * rev[n * 4 + e]; t = t - floorf(t);
                            const float s = __builtin_amdgcn_sinf(t), c = __builtin_amdgcn_cosf(t);
                            const float x1 = acc[ai][0][m][n][e], x2 = acc[ai][1][m][n][e];
                            o1[n][e] = (x1 * c - x2 * s) * sc; o2[n][e] = (x1 * s + x2 * c) * sc;
                        }
                    bf16* rowp = O + (size_t)r * 4096 + u.pn * 256 + colb;
                    *(u32x4*)(rowp) = pack8(o1[0], o1[1]);
                    *(u32x4*)(rowp + 128) = pack8(o2[0], o2[1]);
                }
        } else {
#pragma unroll
            for (int ai = 0; ai < 2; ++ai)
#pragma unroll
                for (int m = 0; m < 4; ++m) {
                    bf16* rowp = O + (size_t)(row0 + ai * 128 + m * 16) * 4096 + u.pn * 256 + colb;
#pragma unroll
                    for (int bj = 0; bj < 2; ++bj) *(u32x4*)(rowp + bj * 128) = pack8(acc[ai][bj][m][0], acc[ai][bj][m][1]);
                }
        }
    }
};
struct EpiDn {
    static constexpr bool PERM = true, AFTER_DRAIN = false;
    bf16* O; float* GB; const float* a_log; const float* dt_bias;
    __device__ __forceinline__ void operator()(const f32x4 (&acc)[2][2][4][2], const Unit& u, int wr, int wc, int fr, int fq) const {
        const int row0 = u.pm * 256 + wr * 64 + fr, colb = wc * 32 + 8 * fq;
        if (u.pn < 12) {
#pragma unroll
            for (int ai = 0; ai < 2; ++ai)
#pragma unroll
                for (int m = 0; m < 4; ++m) {
                    bf16* rowp = O + (size_t)(row0 + ai * 128 + m * 16) * 3072 + u.pn * 256 + colb;
#pragma unroll
                    for (int bj = 0; bj < 2; ++bj) *(u32x4*)(rowp + bj * 128) = pack8(acc[ai][bj][m][0], acc[ai][bj][m][1]);
                }
        } else if (wc == 0) {
            float ea[8], db[8];
#pragma unroll
            for (int e = 0; e < 8; ++e) { const int c = (colb + e) & 15; ea[e] = -__expf(a_log[c]); db[e] = dt_bias[c]; }
#pragma unroll
            for (int ai = 0; ai < 2; ++ai)
#pragma unroll
                for (int m = 0; m < 4; ++m) {
                    float* rowp = GB + (size_t)(row0 + ai * 128 + m * 16) * 32 + colb;
                    f32x4 o[2];
#pragma unroll
                    for (int n = 0; n < 2; ++n)
#pragma unroll
                        for (int e = 0; e < 4; ++e) {
                            const float v = acc[ai][0][m][n][e];
                            if (colb < 16) { const float z = v + db[n * 4 + e]; const float sp = z > 20.f ? z : log1pf(__expf(z)); o[n][e] = ea[n * 4 + e] * sp; }
                            else o[n][e] = sigmoidf_(v);
                        }
                    *(f32x4*)(rowp) = o[0]; *(f32x4*)(rowp + 4) = o[1];
                }
        }
    }
};
struct EpiGates {
    static constexpr bool PERM = true, AFTER_DRAIN = false;
    bf16 *rg, *dz, *ga, *gb;
    __device__ __forceinline__ void operator()(const f32x4 (&acc)[2][2][4][2], const Unit& u, int wr, int wc, int fr, int fq) const {
        const int row0 = u.pm * 256 + wr * 64 + fr, colb = wc * 32 + 8 * fq;
        bf16* base; int ld, ct;
        if (u.pn < 8) { base = rg; ld = 2048; ct = u.pn; } else if (u.pn < 12) { base = dz; ld = 1024; ct = u.pn - 8; } else if (u.pn < 16) { base = ga; ld = 1024; ct = u.pn - 12; } else { base = gb; ld = 1024; ct = u.pn - 16; }
#pragma unroll
        for (int ai = 0; ai < 2; ++ai)
#pragma unroll
            for (int m = 0; m < 4; ++m) {
                bf16* rowp = base + (size_t)(row0 + ai * 128 + m * 16) * ld + ct * 256 + colb;
#pragma unroll
                for (int bj = 0; bj < 2; ++bj) *(u32x4*)(rowp + bj * 128) = pack8(acc[ai][bj][m][0], acc[ai][bj][m][1]);
            }
    }
};
template <bool ADD> struct EpiMerge {
    static constexpr bool PERM = true, AFTER_DRAIN = false;
    const bf16* gate; const bf16* prev; bf16* O;
    __device__ __forceinline__ void operator()(const f32x4 (&acc)[2][2][4][2], const Unit& u, int wr, int wc, int fr, int fq) const {
        const int row0 = u.pm * 256 + wr * 64 + fr, colb = u.pn * 256 + wc * 32 + 8 * fq;
#pragma unroll
        for (int ai = 0; ai < 2; ++ai)
#pragma unroll
            for (int m = 0; m < 4; ++m) {
                const size_t off = (size_t)(row0 + ai * 128 + m * 16) * 1024 + colb;
#pragma unroll
                for (int bj = 0; bj < 2; ++bj) {
                    f32x4 g0, g1; unpack8(*(const u32x4*)(gate + off + bj * 128), g0, g1);
                    f32x4 o0, o1;
#pragma unroll
                    for (int e = 0; e < 4; ++e) { o0[e] = sigmoidf_(g0[e]) * acc[ai][bj][m][0][e]; o1[e] = sigmoidf_(g1[e]) * acc[ai][bj][m][1][e]; }
                    if (ADD) { f32x4 p0, p1; unpack8(*(const u32x4*)(prev + off + bj * 128), p0, p1); o0 += p0; o1 += p1; }
                    *(u32x4*)(O + off + bj * 128) = pack8(o0, o1);
                }
            }
    }
};
struct EpiRes {
    static constexpr bool PERM = true, AFTER_DRAIN = false;
    const bf16* H; float* O;
    __device__ __forceinline__ void operator()(const f32x4 (&acc)[2][2][4][2], const Unit& u, int wr, int wc, int fr, int fq) const {
        const int row0 = u.pm * 256 + wr * 64 + fr, colb = u.pn * 256 + wc * 32 + 8 * fq;
#pragma unroll
        for (int ai = 0; ai < 2; ++ai)
#pragma unroll
            for (int m = 0; m < 4; ++m) {
                const size_t off = (size_t)(row0 + ai * 128 + m * 16) * 1024 + colb;
#pragma unroll
                for (int bj = 0; bj < 2; ++bj) {
                    f32x4 h0, h1; unpack8(*(const u32x4*)(H + off + bj * 128), h0, h1);
                    *(f32x4*)(O + off + bj * 128) = h0 * DN_ALPHA + acc[ai][bj][m][0];
                    *(f32x4*)(O + off + bj * 128 + 4) = h1 * DN_ALPHA + acc[ai][bj][m][1];
                }
            }
    }
};
struct EpiF32 {
    static constexpr bool PERM = true, AFTER_DRAIN = false;
    float* O; int ld;
    __device__ __forceinline__ void operator()(const f32x4 (&acc)[2][2][4][2], const Unit& u, int wr, int wc, int fr, int fq) const {
        const int row0 = u.pm * 256 + wr * 64 + fr, colb = u.pn * 256 + wc * 32 + 8 * fq;
#pragma unroll
        for (int ai = 0; ai < 2; ++ai)
#pragma unroll
            for (int m = 0; m < 4; ++m) {
                float* rowp = O + (size_t)(row0 + ai * 128 + m * 16) * ld + colb;
#pragma unroll
                for (int bj = 0; bj < 2; ++bj) { *(f32x4*)(rowp + bj * 128) = acc[ai][bj][m][0]; *(f32x4*)(rowp + bj * 128 + 4) = acc[ai][bj][m][1]; }
            }
    }
};
}

__device__ __forceinline__ void transpose_item(const float* W, int ldsrc, int K, bf16* WT, int k0, int srcn0, int dstn0, LAS float* scr, int lane) {
    if (srcn0 >= 0) {
#pragma unroll 8
        for (int i = 0; i < 32; ++i) { const int kk = 2 * i + (lane >> 5); scr[kk * 33 + (lane & 31)] = W[(size_t)(k0 + kk) * ldsrc + srcn0 + (lane & 31)]; }
    } else {
#pragma unroll 8
        for (int i = 0; i < 32; ++i) { const int kk = 2 * i + (lane >> 5); scr[kk * 33 + (lane & 31)] = 0.f; }
    }
    asm volatile("s_waitcnt lgkmcnt(0)" ::: "memory");
    const int c = lane & 7;
#pragma unroll
    for (int j = 0; j < 4; ++j) { const int n = (lane >> 3) + 8 * j; const LAS float* s = scr + (8 * c) * 33 + n;
        v4u o; o.x = pk2(s[0 * 33], s[1 * 33]); o.y = pk2(s[2 * 33], s[3 * 33]); o.z = pk2(s[4 * 33], s[5 * 33]); o.w = pk2(s[6 * 33], s[7 * 33]);
        *(v4u*)(WT + (size_t)(dstn0 + n) * K + k0 + 8 * c) = o; }
    asm volatile("s_waitcnt lgkmcnt(0)" ::: "memory");
}
__device__ __forceinline__ int wt_src_col(int n0) {
    if (n0 < 4096) return n0;
    if (n0 < 7168) return n0 - 4096 + 6144;
    if (n0 < 7200) return n0 - 7168 + 10240;
    if (n0 < 7424) return -1;
    if (n0 < 9472) return n0 - 7424 + 4096;
    if (n0 < 10496) return n0 - 9472 + 9216;
    if (n0 < 11520) return n0 - 10496 + 10272;
    return n0 - 11520 + 11296;
}
__device__ __forceinline__ void ln_row_affine_bf16(const float* xrow, const float* g, const float* bb, bf16* orow, int lane) {
    const f32x4* xr = (const f32x4*)xrow + lane;
    f32x4 v[4]; float s = 0.f;
#pragma unroll
    for (int j = 0; j < 4; ++j) { v[j] = xr[64 * j]; s += (v[j][0] + v[j][1]) + (v[j][2] + v[j][3]); }
    const float mean = wave_sum(s) * (1.f / D); float s2 = 0.f;
#pragma unroll
    for (int j = 0; j < 4; ++j) { v[j] = v[j] - mean; s2 += (v[j][0] * v[j][0] + v[j][1] * v[j][1]) + (v[j][2] * v[j][2] + v[j][3] * v[j][3]); }
    const float rstd = 1.f / sqrtf(wave_sum(s2) * (1.f / D) + LN_EPS);
    v2u* o8 = (v2u*)orow + lane;
#pragma unroll
    for (int j = 0; j < 4; ++j) { const f32x4 gg = ((const f32x4*)g)[lane + 64 * j], b4 = ((const f32x4*)bb)[lane + 64 * j]; const f32x4 y = v[j] * rstd * gg + b4;
        v2u w; w.x = pk2(y[0], y[1]); w.y = pk2(y[2], y[3]); o8[64 * j] = w; }
}

__device__ __forceinline__ void ln_rows2_affine_bf16(const float* xrow0, const float* xrow1, const float* g, const float* bb, bf16* orow0, bf16* orow1, int lane) {
    const f32x4* xr0 = (const f32x4*)xrow0 + lane; const f32x4* xr1 = (const f32x4*)xrow1 + lane;
    f32x4 v[2][4]; float s0 = 0.f, s1 = 0.f;
#pragma unroll
    for (int j = 0; j < 4; ++j) { v[0][j] = xr0[64 * j]; v[1][j] = xr1[64 * j]; }
#pragma unroll
    for (int j = 0; j < 4; ++j) { s0 += (v[0][j][0] + v[0][j][1]) + (v[0][j][2] + v[0][j][3]); s1 += (v[1][j][0] + v[1][j][1]) + (v[1][j][2] + v[1][j][3]); }
#pragma unroll
    for (int o = 1; o < 64; o <<= 1) { s0 += __shfl_xor(s0, o); s1 += __shfl_xor(s1, o); }
    const float m0 = s0 * (1.f / D), m1 = s1 * (1.f / D); float q0 = 0.f, q1 = 0.f;
#pragma unroll
    for (int j = 0; j < 4; ++j) { v[0][j] = v[0][j] - m0; v[1][j] = v[1][j] - m1;
        q0 += (v[0][j][0] * v[0][j][0] + v[0][j][1] * v[0][j][1]) + (v[0][j][2] * v[0][j][2] + v[0][j][3] * v[0][j][3]);
        q1 += (v[1][j][0] * v[1][j][0] + v[1][j][1] * v[1][j][1]) + (v[1][j][2] * v[1][j][2] + v[1][j][3] * v[1][j][3]); }
#pragma unroll
    for (int o = 1; o < 64; o <<= 1) { q0 += __shfl_xor(q0, o); q1 += __shfl_xor(q1, o); }
    const float r0 = 1.f / sqrtf(q0 * (1.f / D) + LN_EPS), r1 = 1.f / sqrtf(q1 * (1.f / D) + LN_EPS);
    v2u* o0 = (v2u*)orow0 + lane; v2u* o1 = (v2u*)orow1 + lane;
#pragma unroll
    for (int j = 0; j < 4; ++j) { const f32x4 gg = ((const f32x4*)g)[lane + 64 * j], b4 = ((const f32x4*)bb)[lane + 64 * j];
        const f32x4 y0 = v[0][j] * r0 * gg + b4, y1 = v[1][j] * r1 * gg + b4;
        v2u w0, w1; w0.x = pk2(y0[0], y0[1]); w0.y = pk2(y0[2], y0[3]); w1.x = pk2(y1[0], y1[1]); w1.y = pk2(y1[2], y1[3]); o0[64 * j] = w0; o1[64 * j] = w1; }
}

__device__ __forceinline__ void p0_prologue(const Args& a, Frame& F) {
    LAS float* scr = (LAS float*)(F.lds + F.wave * 16384);
    bf16* HB = (bf16*)(a.ws + WS_HB); bf16* WT = (bf16*)(a.ws + WS_WT);
    constexpr int NB = WT_ROWS / 32, NITEMS = NB * (D / 64);
    for (int it = F.gw; it < NITEMS; it += F.NGW) { const int nb = it % NB, kb = it / NB; transpose_item(a.w_in, IN_W, D, WT, 64 * kb, wt_src_col(32 * nb), 32 * nb, scr, F.lane); }
    for (int r = F.gw; r < NREAL / 2; r += F.NGW) ln_rows2_affine_bf16(a.x + (size_t)r * D, a.x + (size_t)(r + NREAL / 2) * D, a.emb_g, a.emb_b, HB + (size_t)r * D, HB + (size_t)(r + NREAL / 2) * D, F.lane);
    for (int r = NREAL + F.gw; r < MROWS; r += F.NGW) {
        bf16* orow = HB + (size_t)r * D;
        if (r < NREAL + NMETA) ln_row_affine_bf16(a.meta + (size_t)(r - NREAL) * D, a.emb_g, a.emb_b, orow, F.lane);
        else { v2u z; z.x = 0u; z.y = 0u; v2u* o8 = (v2u*)orow + F.lane;
#pragma unroll
            for (int j = 0; j < 4; ++j) o8[64 * j] = z; }
    }
}

__device__ __forceinline__ void p2_scan_ret_simple(const Args& a, Frame& F) {
    const bf16* QKV = (const bf16*)(a.ws + AR_QKVR); bf16* OR = (bf16*)a.out;
    constexpr int TG = 8;
    LAS bf16* qt = (LAS bf16*)F.lds; LAS bf16* kt = qt + TG * 256; LAS bf16* vt = kt + TG * 256;
    const int col = 16 * F.wave + (F.lane >> 2), qtr = F.lane & 3;
    for (int u = blockIdx.x; u < BATCH * RH * 4; u += F.G) {
        const int b = u >> 4, h = (u >> 2) & 3, dvb = u & 3;
        for (int pass = 0; pass < 2; ++pass) {
            const int dir = 1 - pass;
            const float gamma = sigmoidf_(a.ret_decay[dir * RH + h]);
            float S[64];
#pragma unroll
            for (int j = 0; j < 64; ++j) S[j] = 0.f;
            const int ntok = dir ? SEQ : LTOT;
            for (int t0 = 0; t0 < ntok; t0 += TG) {
                __syncthreads();
                for (int c = F.tid; c < TG * 80; c += NTHREADS) {
                    const int i = c / 80, w = c % 80; const int t = t0 + i, p = dir ? (LTOT - 1 - t) : t; const size_t rb = (size_t)row_of(b, p) * 4096;
                    if (w < 32) *(LAS v4u*)(qt + i * 256 + w * 8) = *(const v4u*)(QKV + rb + h * 256 + w * 8);
                    else if (w < 64) *(LAS v4u*)(kt + i * 256 + (w - 32) * 8) = *(const v4u*)(QKV + rb + 1024 + h * 256 + (w - 32) * 8);
                    else *(LAS v4u*)(vt + i * 128 + (w - 64) * 8) = *(const v4u*)(QKV + rb + 2048 + h * 512 + dvb * 128 + (w - 64) * 8);
                }
                __syncthreads();
                for (int i = 0; i < TG; ++i) {
                    const float v = bf2f(vt[i * 128 + col]);
                    float o = 0.f;
#pragma unroll
                    for (int j8 = 0; j8 < 8; ++j8) {
                        const v4u kw = *(const LAS v4u*)(kt + i * 256 + qtr * 64 + j8 * 8), qw = *(const LAS v4u*)(qt + i * 256 + qtr * 64 + j8 * 8);
                        const float kk[8] = {bflo(kw.x), bfhi(kw.x), bflo(kw.y), bfhi(kw.y), bflo(kw.z), bfhi(kw.z), bflo(kw.w), bfhi(kw.w)};
                        const float qq[8] = {bflo(qw.x), bfhi(qw.x), bflo(qw.y), bfhi(qw.y), bflo(qw.z), bfhi(qw.z), bflo(qw.w), bfhi(qw.w)};
#pragma unroll
                        for (int e = 0; e < 8; ++e) {
                            float s = S[j8 * 8 + e] * gamma;
                            if (dir == 0) { s += kk[e] * v; o += qq[e] * s; } else { o += qq[e] * s; s += kk[e] * v; }
                            S[j8 * 8 + e] = s;
                        }
                    }
                    o += __shfl_xor(o, 1); o += __shfl_xor(o, 2);
                    const float o2 = __shfl_down(o, 4);
                    const int t = t0 + i, p = dir ? (LTOT - 1 - t) : t;
                    if ((F.lane & 7) == 0 && p >= NMETA) {
                        unsigned* dst = (unsigned*)(OR + (size_t)(b * SEQ + p - NMETA) * 2048 + h * 512 + dvb * 128 + col);
                        float r0 = o, r1 = o2;
                        if (pass == 1) { const unsigned old = __hip_atomic_load(dst, RLX_AGENT); r0 += bflo(old); r1 += bfhi(old); }
                        *dst = pk2(r0, r1);
                    }
                }
            }
        }
    }
}

__device__ __forceinline__ void p4_conv(const Args& a, Frame& F) {
    const bf16* RAW = (const bf16*)(a.ws + AR_RAWD); bf16* QD = (bf16*)(a.ws + AR_QKVD);
    const int lp = F.lane & 31;
    for (int it = F.gw; it < BATCH * 12 * 65; it += F.NGW) {
        int seg, bs; if (it < BATCH * 12 * 64) { seg = it & 63; bs = it >> 6; } else { seg = 64; bs = it - BATCH * 12 * 64; }
        const int pair = bs % 12, b = bs / 12, slab = 2 * pair + (F.lane >> 5);
        const int p0 = seg < 64 ? NMETA + 32 * seg : 0, np = seg < 64 ? 32 : NMETA;
        const int ch = slab * 128 + 4 * lp;
        v2u raw[36];
#pragma unroll
        for (int k = 0; k < 36; ++k) { const int pp = p0 - 2 + k; raw[k] = (pp >= 0 && pp < LTOT && k < np + 4) ? *(const v2u*)(RAW + (size_t)row_of(b, pp) * 3072 + ch) : (v2u){0u, 0u}; }
        f32x4 w[5];
#pragma unroll
        for (int j = 0; j < 5; ++j) w[j] = *(const f32x4*)(a.dn_conv + j * 3072 + ch);
        const float qsc = (slab < 8) ? 0.08838834764831845f : 1.0f;
#pragma unroll
        for (int t = 0; t < 32; ++t) {
            f32x4 y = (f32x4){0.f, 0.f, 0.f, 0.f};
#pragma unroll
            for (int j = 0; j < 5; ++j) { y[0] += w[j][0] * bflo(raw[t + j].x); y[1] += w[j][1] * bfhi(raw[t + j].x); y[2] += w[j][2] * bflo(raw[t + j].y); y[3] += w[j][3] * bfhi(raw[t + j].y); }
#pragma unroll
            for (int e = 0; e < 4; ++e) y[e] = siluf_(y[e]);
            if (slab < 16) { float ss = (y[0] * y[0] + y[1] * y[1]) + (y[2] * y[2] + y[3] * y[3]);
#pragma unroll
                for (int o = 1; o < 32; o <<= 1) ss += __shfl_xor(ss, o);
                const float sc = qsc / sqrtf(ss + RMS_EPS); y = y * sc; }
            if (t < np) { v2u o; o.x = pk2(y[0], y[1]); o.y = pk2(y[2], y[3]); *(v2u*)(QD + (size_t)rowd_of(b, p0 + t) * 3072 + ch) = o; }
        }
    }
}

__device__ __forceinline__ void p5_scan_dn_simple(const Args& a, Frame& F) {
    const bf16* QD = (const bf16*)(a.ws + AR_QKVD); const float* GB = (const float*)(a.ws + AR_GBETA); bf16* OD = (bf16*)(a.ws + AR_OD);
    constexpr int TG = 8;
    LAS bf16* qt = (LAS bf16*)F.lds; LAS bf16* kt = qt + TG * 128; LAS bf16* vt = kt + TG * 128; LAS float* gt = (LAS float*)(vt + TG * 64); LAS float* bt = gt + TG;
    const int cl = 8 * F.wave + (F.lane >> 3), sub = F.lane & 7;
    for (int u = blockIdx.x; u < BATCH * DH * 2; u += F.G) {
        const int b = u >> 4, h = (u >> 1) & 7, dvh = u & 1;
        for (int pass = 0; pass < 2; ++pass) {
            const int dir = 1 - pass;
            float S[16];
#pragma unroll
            for (int j = 0; j < 16; ++j) S[j] = 0.f;
            const int ntok = dir ? SEQ : LTOT;
            for (int t0 = 0; t0 < ntok; t0 += TG) {
                __syncthreads();
                for (int c = F.tid; c < TG * 40; c += NTHREADS) {
                    const int i = c / 40, w = c % 40; const int t = t0 + i, p = dir ? (LTOT - 1 - t) : t; const size_t rb = (size_t)rowd_of(b, p) * 3072;
                    if (w < 16) *(LAS v4u*)(qt + i * 128 + w * 8) = *(const v4u*)(QD + rb + h * 128 + w * 8);
                    else if (w < 32) *(LAS v4u*)(kt + i * 128 + (w - 16) * 8) = *(const v4u*)(QD + rb + 1024 + h * 128 + (w - 16) * 8);
                    else *(LAS v4u*)(vt + i * 64 + (w - 32) * 8) = *(const v4u*)(QD + rb + 2048 + h * 128 + dvh * 64 + (w - 32) * 8);
                }
                if (F.tid < TG) { const int t = t0 + F.tid, p = dir ? (LTOT - 1 - t) : t; const size_t rg = (size_t)row_of(b, p) * 32;
                    gt[F.tid] = GB[rg + dir * 8 + h]; bt[F.tid] = GB[rg + 16 + dir * 8 + h]; }
                __syncthreads();
                for (int i = 0; i < TG; ++i) {
                    const float v = bf2f(vt[i * 64 + cl]);
                    const float ag = __expf(gt[i]), beta = bt[i];
                    const v4u kw0 = *(const LAS v4u*)(kt + i * 128 + sub * 16), kw1 = *(const LAS v4u*)(kt + i * 128 + sub * 16 + 8);
                    const v4u qw0 = *(const LAS v4u*)(qt + i * 128 + sub * 16), qw1 = *(const LAS v4u*)(qt + i * 128 + sub * 16 + 8);
                    const float kk[16] = {bflo(kw0.x), bfhi(kw0.x), bflo(kw0.y), bfhi(kw0.y), bflo(kw0.z), bfhi(kw0.z), bflo(kw0.w), bfhi(kw0.w),
                                          bflo(kw1.x), bfhi(kw1.x), bflo(kw1.y), bfhi(kw1.y), bflo(kw1.z), bfhi(kw1.z), bflo(kw1.w), bfhi(kw1.w)};
                    const float qq[16] = {bflo(qw0.x), bfhi(qw0.x), bflo(qw0.y), bfhi(qw0.y), bflo(qw0.z), bfhi(qw0.z), bflo(qw0.w), bfhi(qw0.w),
                                          bflo(qw1.x), bfhi(qw1.x), bflo(qw1.y), bfhi(qw1.y), bflo(qw1.z), bfhi(qw1.z), bflo(qw1.w), bfhi(qw1.w)};
                    float r = 0.f;
#pragma unroll
                    for (int j = 0; j < 16; ++j) r += S[j] * kk[j];
                    r += __shfl_xor(r, 1); r += __shfl_xor(r, 2); r += __shfl_xor(r, 4);
                    const float vn = beta * (v - ag * r);
                    float o = 0.f;
#pragma unroll
                    for (int j = 0; j < 16; ++j) { S[j] = ag * S[j] + kk[j] * vn; o += S[j] * qq[j]; }
                    o += __shfl_xor(o, 1); o += __shfl_xor(o, 2); o += __shfl_xor(o, 4);
                    const float o2 = __shfl_down(o, 8);
                    const int t = t0 + i, p = dir ? (LTOT - 1 - t) : t;
                    if ((F.lane & 15) == 0 && p >= NMETA) {
                        unsigned* dst = (unsigned*)(OD + (size_t)(b * SEQ + p - NMETA) * 1024 + h * 128 + dvh * 64 + cl);
                        float r0 = o, r1 = o2;
                        if (pass == 1) { const unsigned old = __hip_atomic_load(dst, RLX_AGENT); r0 += bflo(old); r1 += bfhi(old); }
                        *dst = pk2(r0, r1);
                    }
                }
            }
        }
    }
}

__device__ __forceinline__ void p6_small_weights(const Args& a, Frame& F) {
    LAS float* scr = (LAS float*)(F.lds + F.wave * 16384);
    bf16* PRT = (bf16*)(a.ws + AR_PRETT); bf16* PDT = (bf16*)(a.ws + AR_PDNT); bf16* WOT = (bf16*)(a.ws + AR_WOUTT); bf16* W2T = (bf16*)(a.ws + AR_W2T);
    constexpr int I_PR = (2048 / 64) * (1024 / 32), I_PD = (1024 / 64) * (1024 / 32), I_WO = I_PD;
    for (int it = F.gw; it < I_PR + I_PD + I_WO; it += F.NGW) {
        int r = it;
        if (r < I_PR) { transpose_item(a.p_ret, 1024, 2048, PRT, 64 * (r / 32), 32 * (r % 32), 32 * (r % 32), scr, F.lane); continue; } r -= I_PR;
        if (r < I_PD) { transpose_item(a.p_dn, 1024, 1024, PDT, 64 * (r / 32), 32 * (r % 32), 32 * (r % 32), scr, F.lane); continue; } r -= I_PD;
        transpose_item(a.w_out, 1024, 1024, WOT, 64 * (r / 32), 32 * (r % 32), 32 * (r % 32), scr, F.lane);
    }
    for (int it = F.gw; it < 128 * 16; it += F.NGW) {
        const int nt = it >> 4, ks = it & 15, hp = nt >> 3, lane = F.lane, g = lane >> 4, l15 = lane & 15;
        typedef short bfx8_ __attribute__((ext_vector_type(8)));
        bfx8_ kf[4];
#pragma unroll
        for (int sx = 0; sx < 4; ++sx) { const f32x4* p = (const f32x4*)(a.peer_keys + (size_t)(nt * 16 + l15) * 128 + 32 * sx + 8 * g); const f32x4 x = p[0], y = p[1];
            const v4u w = {pk2(x[0], x[1]), pk2(x[2], x[3]), pk2(y[0], y[1]), pk2(y[2], y[3])}; kf[sx] = __builtin_bit_cast(bfx8_, w); }
#pragma unroll
        for (int kt = 0; kt < 4; ++kt) {
            const int k0 = ks * 64 + kt * 16;
            f32x4 acc = (f32x4){0.f, 0.f, 0.f, 0.f};
#pragma unroll
            for (int sx = 0; sx < 4; ++sx) { const f32x4* p = (const f32x4*)(a.peer_wq + (size_t)(k0 + l15) * 2048 + hp * 128 + 32 * sx + 8 * g); const f32x4 x = p[0], y = p[1];
                const v4u w = {pk2(x[0], x[1]), pk2(x[2], x[3]), pk2(y[0], y[1]), pk2(y[2], y[3])};
                acc = __builtin_amdgcn_mfma_f32_16x16x32_bf16(__builtin_bit_cast(bfx8_, w), kf[sx], acc, 0, 0, 0); }
            v2u o; o.x = pk2(acc[0], acc[1]); o.y = pk2(acc[2], acc[3]);
            *(v2u*)(W2T + (size_t)(nt * 16 + l15) * 1024 + k0 + 4 * g) = o;
        }
    }
}

__device__ __forceinline__ void p7_gate_norm(const Args& a, Frame& F) {
    bf16* OR = (bf16*)a.out; bf16* OD = (bf16*)(a.ws + AR_OD); const bf16* GRG = (const bf16*)(a.ws + AR_GRG); const bf16* GDZ = (const bf16*)(a.ws + AR_GDZ);
    const int c = (F.lane & 15) * 8;
    const f32x4 n0 = *(const f32x4*)(a.dn_norm_g + c), n1 = *(const f32x4*)(a.dn_norm_g + c + 4);
    for (int r = F.gw; r < NREAL; r += F.NGW) {
        v4u wo[4], wg[4], wd[2], wz[2];
#pragma unroll
        for (int p = 0; p < 4; ++p) { const size_t off = (size_t)r * 2048 + p * 512 + F.lane * 8; wo[p] = *(const v4u*)(OR + off); wg[p] = *(const v4u*)(GRG + off); }
#pragma unroll
        for (int hh = 0; hh < 2; ++hh) { const size_t off = (size_t)r * 1024 + hh * 512 + F.lane * 8; wd[hh] = *(const v4u*)(OD + off); wz[hh] = *(const v4u*)(GDZ + off); }
#pragma unroll
        for (int p = 0; p < 4; ++p) {
            f32x4 v0, v1, g0, g1; ep::unpack8(wo[p], v0, v1); ep::unpack8(wg[p], g0, g1);
            float s = (v0[0] + v0[1]) + (v0[2] + v0[3]) + (v1[0] + v1[1]) + (v1[2] + v1[3]);
            const float mean = wave_sum(s) * (1.f / 512.f);
            v0 = v0 - mean; v1 = v1 - mean;
            float s2 = (v0[0] * v0[0] + v0[1] * v0[1]) + (v0[2] * v0[2] + v0[3] * v0[3]) + (v1[0] * v1[0] + v1[1] * v1[1]) + (v1[2] * v1[2] + v1[3] * v1[3]);
            const float rstd = 1.f / sqrtf(wave_sum(s2) * (1.f / 512.f) + LN_EPS);
#pragma unroll
            for (int e = 0; e < 4; ++e) { v0[e] = v0[e] * rstd * siluf_(g0[e]); v1[e] = v1[e] * rstd * siluf_(g1[e]); }
            *(v4u*)(OR + (size_t)r * 2048 + p * 512 + F.lane * 8) = ep::pack8(v0, v1);
        }
#pragma unroll
        for (int hh = 0; hh < 2; ++hh) {
            f32x4 v0, v1, g0, g1; ep::unpack8(wd[hh], v0, v1); ep::unpack8(wz[hh], g0, g1);
            float s2 = (v0[0] * v0[0] + v0[1] * v0[1]) + (v0[2] * v0[2] + v0[3] * v0[3]) + (v1[0] * v1[0] + v1[1] * v1[1]) + (v1[2] * v1[2] + v1[3] * v1[3]);
            s2 += __shfl_xor(s2, 1); s2 += __shfl_xor(s2, 2); s2 += __shfl_xor(s2, 4); s2 += __shfl_xor(s2, 8);
            const float rs = 1.f / sqrtf(s2 * (1.f / 128.f) + RMS_EPS);
#pragma unroll
            for (int e = 0; e < 4; ++e) { v0[e] = v0[e] * rs * n0[e] * siluf_(g0[e]); v1[e] = v1[e] * rs * n1[e] * siluf_(g1[e]); }
            *(v4u*)(OD + (size_t)r * 1024 + hh * 512 + F.lane * 8) = ep::pack8(v0, v1);
        }
    }
}

constexpr size_t WS_UB8 = 1 * MiB, WS_SCU = 17 * MiB, WS_SCV = 17 * MiB + 65536, AR_VB8 = WS_AR + 160 * MiB;
typedef __bf16 v32bf_t __attribute__((ext_vector_type(32)));
typedef float v32f_t __attribute__((ext_vector_type(32)));
typedef unsigned v6u_t __attribute__((ext_vector_type(6)));
typedef unsigned v4u_a8 __attribute__((ext_vector_type(4), aligned(8)));
__device__ __forceinline__ void p11_ln1_tables(const Args& a, Frame& F) {
    const float* PRE = (const float*)(a.ws + AR_PRE); bf16* H1 = (bf16*)(a.ws + AR_H1);
    for (int r = F.gw; r < NREAL / 2; r += F.NGW) ln_rows2_affine_bf16(PRE + (size_t)r * D, PRE + (size_t)(r + NREAL / 2) * D, a.ln1_g, a.ln1_b, H1 + (size_t)r * D, H1 + (size_t)(r + NREAL / 2) * D, F.lane);
    const int lp = F.lane & 31, hf = F.lane >> 5;
    for (int it = F.gw; it < NEXP; it += F.NGW) {
        const int r = 2 * it + hf; const bool second = r >= NEXP; const int e = second ? r - NEXP : r;
        const f32x4* src = (const f32x4*)((second ? a.peer_v : a.peer_u) + (size_t)e * D + lp * 32);
        v32f_t x; float am = 0.f;
#pragma unroll
        for (int j = 0; j < 8; ++j) { const f32x4 t = src[j]; x[4 * j] = t[0]; x[4 * j + 1] = t[1]; x[4 * j + 2] = t[2]; x[4 * j + 3] = t[3];
            am = fmaxf(am, fmaxf(fmaxf(fabsf(t[0]), fabsf(t[1])), fmaxf(fabsf(t[2]), fabsf(t[3])))); }
#pragma unroll
        for (int o = 1; o < 32; o <<= 1) am = fmaxf(am, __shfl_xor(am, o));
        int ex = 0; float m = 0.5f; if (am > 0.f) m = frexpf(am, &ex); else ex = 3;
        const int sh = (m > 0.9375f) ? 2 - ex : 3 - ex;
        const float sc = ldexpf(1.0f, sh), isc = ldexpf(1.0f, -sh);
#pragma unroll
        for (int j = 0; j < 32; ++j) x[j] *= sc;
        const v32bf_t xb = __builtin_convertvector(x, v32bf_t);
        const v6u_t p = __builtin_amdgcn_cvt_scalef32_pk32_fp6_bf16(xb, 1.0f);
        unsigned char* dst = a.ws + (second ? AR_VB8 : WS_UB8) + (size_t)e * 768 + lp * 24;
        *(v4u_a8*)dst = (v4u){p[0], p[1], p[2], p[3]}; *(v2u*)(dst + 16) = (v2u){p[4], p[5]};
        if (lp == 0) ((float*)(a.ws + (second ? WS_SCV : WS_SCU)))[e] = isc;
    }
}

__device__ __forceinline__ unsigned ord_key(float v) { const unsigned u = __builtin_bit_cast(unsigned, v); return (u & 0x80000000u) ? ~u : (u | 0x80000000u); }
__device__ __forceinline__ float ord_val(unsigned k) { const unsigned u = (k & 0x80000000u) ? (k & 0x7fffffffu) : ~k; return __builtin_bit_cast(float, u); }
#define DPP_ROR(x, n) ((unsigned)__builtin_amdgcn_update_dpp(0, (int)(x), 0x120 + (n), 0xf, 0xf, false))
__device__ __forceinline__ unsigned row16_max(unsigned m) { m = max(m, DPP_ROR(m, 1)); m = max(m, DPP_ROR(m, 2)); m = max(m, DPP_ROR(m, 4)); m = max(m, DPP_ROR(m, 8)); return m; }
__device__ __forceinline__ float row16_sum(float s) {
    s += __builtin_bit_cast(float, DPP_ROR(__builtin_bit_cast(unsigned, s), 1)); s += __builtin_bit_cast(float, DPP_ROR(__builtin_bit_cast(unsigned, s), 2));
    s += __builtin_bit_cast(float, DPP_ROR(__builtin_bit_cast(unsigned, s), 4)); s += __builtin_bit_cast(float, DPP_ROR(__builtin_bit_cast(unsigned, s), 8)); return s;
}
__device__ __forceinline__ void p13_topk(const Args& a, Frame& F) {
    const float* SC = (const float*)(a.ws + AR_SCORES); int* EXP = (int*)(a.ws + WS_EXP); float* GATE = (float*)(a.ws + WS_GATE);
    LAS float* tops = (LAS float*)(F.lds + F.wave * 2048); LAS int* topi = (LAS int*)(F.lds + F.wave * 2048 + 1024);
    const int q4 = F.lane >> 4, li = F.lane & 15;
    int ci[4], cj[4];
#pragma unroll
    for (int k = 0; k < 4; ++k) { const int t = li * 4 + k; int cnt = 0; ci[k] = -1; cj[k] = 0;
        for (int i = 0; i < 16; ++i) { const int ni = 16 / (i + 1); if (ci[k] < 0 && t < cnt + ni) { ci[k] = i; cj[k] = t - cnt; } cnt += ni; } }
    f32x4 nx[4][2];
    { const float* srow = SC + (size_t)(F.gw < NREAL ? F.gw : 0) * 2048;
#pragma unroll
      for (int it = 0; it < 4; ++it) { nx[it][0] = *(const f32x4*)(srow + (it * 4 + q4) * 128 + li * 8); nx[it][1] = *(const f32x4*)(srow + (it * 4 + q4) * 128 + li * 8 + 4); } }
    for (int tok = F.gw; tok < NREAL; tok += F.NGW) {
        f32x4 cx[4][2];
#pragma unroll
        for (int it = 0; it < 4; ++it) { cx[it][0] = nx[it][0]; cx[it][1] = nx[it][1]; }
        { const int tn = tok + F.NGW < NREAL ? tok + F.NGW : tok; const float* srow = SC + (size_t)tn * 2048;
#pragma unroll
          for (int it = 0; it < 4; ++it) { nx[it][0] = *(const f32x4*)(srow + (it * 4 + q4) * 128 + li * 8); nx[it][1] = *(const f32x4*)(srow + (it * 4 + q4) * 128 + li * 8 + 4); } }
#pragma unroll
        for (int it = 0; it < 4; ++it) {
            const int grp = it * 4 + q4;
            const f32x4 x0 = cx[it][0], x1 = cx[it][1];
            unsigned key[8];
#pragma unroll
            for (int j = 0; j < 8; ++j) { const float v = j < 4 ? x0[j] : x1[j - 4]; key[j] = (ord_key(v) & ~127u) | (unsigned)(127 - (li * 8 + j)); }
            unsigned mine = 0u;
#pragma unroll 4
            for (int rnd = 0; rnd < 16; ++rnd) {
                unsigned m = max(max(max(key[0], key[1]), max(key[2], key[3])), max(max(key[4], key[5]), max(key[6], key[7])));
                m = row16_max(m);
#pragma unroll
                for (int j = 0; j < 8; ++j) key[j] = (key[j] == m) ? 0u : key[j];
                mine = (li == rnd) ? m : mine;
            }
            tops[grp * 16 + li] = ord_val((mine & ~127u) | 64u); topi[grp * 16 + li] = 127 - (int)(mine & 127u);
        }
        asm volatile("s_waitcnt lgkmcnt(0)" ::: "memory");
#pragma unroll 1
        for (int it = 0; it < 2; ++it) {
            const int hh = it * 4 + q4;
            unsigned key[4];
#pragma unroll
            for (int k = 0; k < 4; ++k) { const int i = ci[k] < 0 ? 0 : ci[k]; const float sum = tops[(2 * hh) * 16 + i] + tops[(2 * hh + 1) * 16 + cj[k]];
                key[k] = ci[k] < 0 ? 0u : ((ord_key(sum) & ~255u) | (unsigned)(255 - (i * 16 + cj[k]))); }
            unsigned mine = 0u;
#pragma unroll 4
            for (int rnd = 0; rnd < 16; ++rnd) {
                unsigned m = max(max(key[0], key[1]), max(key[2], key[3]));
                m = row16_max(m);
#pragma unroll
                for (int k = 0; k < 4; ++k) key[k] = (key[k] == m) ? 0u : key[k];
                mine = (li == rnd) ? m : mine;
            }
            const int flat = 255 - (int)(mine & 255u);
            const float best = ord_val((mine & ~255u) | 128u);
            const int i1 = topi[(2 * hh) * 16 + (flat >> 4)], i2 = topi[(2 * hh + 1) * 16 + (flat & 15)];
            const float bmax = __shfl(best, F.lane & 48);
            const float e = __expf(best - bmax);
            const float se = row16_sum(e);
            EXP[(size_t)tok * 128 + hh * 16 + li] = i1 * 128 + i2;
            GATE[(size_t)tok * 128 + hh * 16 + li] = e / se;
        }
        asm volatile("s_waitcnt lgkmcnt(0)" ::: "memory");
    }
}

__device__ __forceinline__ float gelu_exact(float x) { return 0.5f * x * (1.0f + erff(x * 0.70710678118654752f)); }
__device__ __forceinline__ v6u_t ld_fp6(const unsigned char* p) { const v4u a = *(const v4u_a8*)p; const v2u b = *(const v2u*)(p + 16); return (v6u_t){a.x, a.y, a.z, a.w, b.x, b.y}; }
__device__ __forceinline__ void p14_gather(const Args& a, Frame& F) {
    const bf16* H1 = (const bf16*)(a.ws + AR_H1); const int* EXP = (const int*)(a.ws + WS_EXP); const float* GATE = (const float*)(a.ws + WS_GATE);
    const unsigned char* UB = a.ws + WS_UB8; const unsigned char* VB = a.ws + AR_VB8; const float* SCU = (const float*)(a.ws + WS_SCU); const float* SCV = (const float*)(a.ws + WS_SCV);
    const int lane = F.lane, lp = lane & 31, hf = lane >> 5;
    for (int tok = F.gw; tok < NREAL; tok += F.NGW) {
        float x[32], y[32];
        { const v4u* hp = (const v4u*)(H1 + (size_t)tok * D + lp * 32);
#pragma unroll
          for (int q = 0; q < 4; ++q) { const v4u w = hp[q]; const unsigned ww[4] = {w.x, w.y, w.z, w.w};
#pragma unroll
              for (int j = 0; j < 4; ++j) { x[8 * q + 2 * j] = bflo(ww[j]); x[8 * q + 2 * j + 1] = bfhi(ww[j]); } }
#pragma unroll
          for (int j = 0; j < 32; ++j) y[j] = 0.f; }
        const int e0 = EXP[(size_t)tok * 128 + lane], e1 = EXP[(size_t)tok * 128 + 64 + lane];
        const float gv0 = GATE[(size_t)tok * 128 + lane] * SCV[e0], gv1 = GATE[(size_t)tok * 128 + 64 + lane] * SCV[e1];
        const float su0 = SCU[e0], su1 = SCU[e1];
        v6u_t ucur[4];
#pragma unroll 1
        for (int bt = 0; bt < 16; ++bt) {
            v6u_t vv[4];
#pragma unroll
            for (int k = 0; k < 4; ++k) { const int sa = bt * 8 + 2 * k; const int ea = __builtin_amdgcn_readlane(sa < 64 ? e0 : e1, sa & 63), eb = __builtin_amdgcn_readlane(sa < 64 ? e0 : e1, (sa + 1) & 63);
                ucur[k] = ld_fp6(UB + (size_t)(hf ? eb : ea) * 768 + lp * 24); }
#pragma unroll
            for (int k = 0; k < 4; ++k) { const int sa = bt * 8 + 2 * k; const int ea = __builtin_amdgcn_readlane(sa < 64 ? e0 : e1, sa & 63), eb = __builtin_amdgcn_readlane(sa < 64 ? e0 : e1, (sa + 1) & 63);
                vv[k] = ld_fp6(VB + (size_t)(hf ? eb : ea) * 768 + lp * 24); }
            float d[4];
#pragma unroll
            for (int k = 0; k < 4; ++k) {
                const v32f_t r = __builtin_amdgcn_cvt_scalef32_pk32_f32_fp6(ucur[k], 1.0f);
                float s0 = 0.f, s1 = 0.f;
#pragma unroll
                for (int j = 0; j < 16; ++j) { s0 += x[2 * j] * r[2 * j]; s1 += x[2 * j + 1] * r[2 * j + 1]; }
                d[k] = s0 + s1;
            }
            float r2[2], r1;
#pragma unroll
            for (int i = 0; i < 2; ++i) { const bool up = lp & 16; const float keep = up ? d[i + 2] : d[i], send = up ? d[i] : d[i + 2]; r2[i] = keep + __shfl_xor(send, 16); }
            { const bool up = lp & 8; const float keep = up ? r2[1] : r2[0], send = up ? r2[0] : r2[1]; r1 = keep + __shfl_xor(send, 8); }
            r1 += __shfl_xor(r1, 4); r1 += __shfl_xor(r1, 2); r1 += __shfl_xor(r1, 1);
            const int myslot = bt * 8 + 2 * (lp >> 3) + hf;
            const float su = __shfl(myslot < 64 ? su0 : su1, myslot & 63), gv = __shfl(myslot < 64 ? gv0 : gv1, myslot & 63);
            const float wmine = gv * gelu_exact(r1 * su);
#pragma unroll
            for (int k = 0; k < 4; ++k) {
                const float wgt = __shfl(wmine, hf * 32 + 8 * k);
                const v32f_t r = __builtin_amdgcn_cvt_scalef32_pk32_f32_fp6(vv[k], 1.0f);
#pragma unroll
                for (int j = 0; j < 32; ++j) y[j] += wgt * r[j];
            }
        }
        float s = 0.f;
#pragma unroll
        for (int j = 0; j < 32; ++j) { y[j] += __shfl_xor(y[j], 32); y[j] = DN_ALPHA * x[j] + y[j]; s += y[j]; }
#pragma unroll
        for (int o = 1; o < 32; o <<= 1) s += __shfl_xor(s, o);
        const float mean = s * (1.f / D); float s2 = 0.f;
#pragma unroll
        for (int j = 0; j < 32; ++j) { y[j] -= mean; s2 += y[j] * y[j]; }
#pragma unroll
        for (int o = 1; o < 32; o <<= 1) s2 += __shfl_xor(s2, o);
        const float rstd = 1.f / sqrtf(s2 * (1.f / D) + LN_EPS);
#pragma unroll
        for (int q = 0; q < 4; ++q) {
            const int col = lp * 32 + hf * 16 + q * 4;
            const f32x4 gg = *(const f32x4*)(a.ln2_g + col), bb = *(const f32x4*)(a.ln2_b + col);
            f32x4 o;
#pragma unroll
            for (int e = 0; e < 4; ++e) { const float yv = hf ? y[16 + q * 4 + e] : y[q * 4 + e]; o[e] = yv * rstd * gg[e] + bb[e]; }
            *(f32x4*)(a.out + (size_t)tok * D + col) = o;
        }
    }
}

typedef short s16x4 __attribute__((ext_vector_type(4)));
typedef short bfx8 __attribute__((ext_vector_type(8)));
#ifndef R2_STAGGER
#define R2_STAGGER 0
#endif
constexpr int R2_QS = 544, R2_VS = 144, R2_PS = 80;
constexpr int R2_Q = 0, R2_K = 32 * R2_QS, R2_V = 2 * 32 * R2_QS, R2_P = R2_V + 32 * R2_VS, R2_Q2 = R2_P + 32 * R2_PS, R2_GRP = R2_Q2 + 32 * R2_QS;
__device__ __forceinline__ bfx8 tr16_frag(const LAS unsigned char* p0, const LAS unsigned char* p1) {
    const s16x4 a = __builtin_amdgcn_ds_read_tr16_b64_v4i16((LAS s16x4*)p0), b = __builtin_amdgcn_ds_read_tr16_b64_v4i16((LAS s16x4*)p1);
    return (bfx8){a[0], a[1], a[2], a[3], b[0], b[1], b[2], b[3]};
}
__device__ __forceinline__ bfx8 ld2x8(const LAS unsigned char* p0, const LAS unsigned char* p1) {
    const v2u a = *(const LAS v2u*)p0, b = *(const LAS v2u*)p1; const v4u w = {a.x, a.y, b.x, b.y}; return __builtin_bit_cast(bfx8, w);
}
__device__ __forceinline__ bfx8 pack_acc2(f32x4 a, f32x4 b, float sc) {
    const v4u w = {pk2(a[0] * sc, a[1] * sc), pk2(a[2] * sc, a[3] * sc), pk2(b[0] * sc, b[1] * sc), pk2(b[2] * sc, b[3] * sc)}; return __builtin_bit_cast(bfx8, w);
}
#define MFMA16(a, b, c) __builtin_amdgcn_mfma_f32_16x16x32_bf16((a), (b), (c), 0, 0, 0)

template <int VAR> __device__ __forceinline__ void p2_scan_ret(const Args& a, Frame& F) {
    const bf16* QKV = (const bf16*)(a.ws + AR_QKVR); bf16* OR = (bf16*)a.out;
    const int grp = F.wave >> 2, wq = F.wave & 3, tg = F.tid & 255, lane = F.lane, g = lane >> 4, l15 = lane & 15, q4 = (lane & 15) >> 2, p4 = lane & 3;
    LAS unsigned char* L = F.lds + grp * R2_GRP;
    constexpr int NSTEP = 65;
    if (VAR == 9) return;
    for (int u = blockIdx.x; u < BATCH * RH * 8; u += F.G) {
        const int bh_ = (u & 7) * 4 + ((u >> 3) >> 3), dvs = (u >> 3) & 7, b = bh_ >> 2, h = bh_ & 3;
        for (int i_ = 0; i_ < dvs * R2_STAGGER; ++i_) __builtin_amdgcn_s_sleep(8);
        const float xl = a.ret_decay[grp * RH + h];
        const float lg2 = -log2f(1.0f + __expf(-xl));
        const float gC = exp2f(32.f * lg2);
        f32x4 S[16];
#pragma unroll
        for (int d = 0; d < 16; ++d) S[d] = (f32x4){0.f, 0.f, 0.f, 0.f};
        v4u rqA[4], rkA[4], rvA;
        unsigned long long oldA[2] = {0ull, 0ull};
        const float vscale = exp2f((float)(31 - (tg >> 3)) * lg2);
        const float rs0 = exp2f((float)(l15 - 31) * lg2), rs1 = exp2f((float)(l15 + 16 - 31) * lg2);
#define R2_ROW(st, i, row)    \
        do { if (grp == 0) { if ((st) == 0) row = (i) >= 16 ? NREAL + (i) - 16 : -1; else row = b * SEQ + 32 * ((st) - 1) + (i); } \
             else { if ((st) == 0) row = -1; else row = b * SEQ + 32 * (64 - (st)) + 31 - (i); } } while (0)
#define R2_LOADS(st, rq, rk, rv) do { \
        _Pragma("unroll") for (int i_ = 0; i_ < 4; ++i_) { const int cid = tg + 256 * i_, ti = cid >> 5, c16 = cid & 31; int row; R2_ROW(((VAR == 5 || VAR == 6) ? 1 : (st)), ti, row); \
            row = row < 0 ? NREAL + NMETA : row;        \
            { const bf16* src = QKV + (size_t)row * 4096 + h * 256 + c16 * 8; rq[i_] = *(const v4u*)src; rk[i_] = *(const v4u*)(src + 1024); } } \
        { const int ti = tg >> 3, c16 = tg & 7; int row; R2_ROW(((VAR == 5 || VAR == 6) ? 1 : (st)), ti, row); \
            row = row < 0 ? NREAL + NMETA : row; rv = *(const v4u*)(QKV + (size_t)row * 4096 + 2048 + h * 512 + dvs * 64 + c16 * 8); } } while (0)
#define R2_OLD(st, old) do { _Pragma("unroll") for (int mt_ = 0; mt_ < 2; ++mt_) { int row; R2_ROW(st, 16 * mt_ + l15, row); \
            old[mt_] = __hip_atomic_load((unsigned long long*)(OR + (size_t)row * 2048 + h * 512 + dvs * 64 + 16 * wq + 4 * g), RLX_AGENT); } } while (0)
#define R2_STEP(st, rq, rk, rv, old, oldn, DIST) do { \
              \
            if (VAR == 4 || VAR == 8) { asm volatile("" :: "v"(rq[0]), "v"(rq[1]), "v"(rq[2]), "v"(rq[3]), "v"(rk[0]), "v"(rk[1]), "v"(rk[2]), "v"(rk[3]), "v"(rv)); } \
            if (VAR != 4 && VAR != 8) _Pragma("unroll") for (int i_ = 0; i_ < 4; ++i_) { const int cid = tg + 256 * i_, ti = cid >> 5, c16 = cid & 31; \
                *(LAS v4u*)(L + R2_Q + ti * R2_QS + c16 * 16) = rq[i_]; *(LAS v4u*)(L + R2_K + ti * R2_QS + c16 * 16) = rk[i_]; \
                { const int cc = c16 & 3, pb = (c16 >> 2) * 64 + (16 * (cc & 1) + 4 * (cc >> 1)) * 2; \
                  *(LAS v2u*)(L + R2_Q2 + ti * R2_QS + pb) = (v2u){rq[i_].x, rq[i_].y}; *(LAS v2u*)(L + R2_Q2 + ti * R2_QS + pb + 16) = (v2u){rq[i_].z, rq[i_].w}; } } \
            if (VAR != 4 && VAR != 8) { const int ti = tg >> 3, c16 = tg & 7; v4u w; \
                w.x = pk2(bflo(rv.x) * vscale, bfhi(rv.x) * vscale); w.y = pk2(bflo(rv.y) * vscale, bfhi(rv.y) * vscale); \
                w.z = pk2(bflo(rv.z) * vscale, bfhi(rv.z) * vscale); w.w = pk2(bflo(rv.w) * vscale, bfhi(rv.w) * vscale); \
                *(LAS v4u*)(L + R2_V + ti * R2_VS + c16 * 16) = w; } \
            __syncthreads(); \
              \
            if (VAR != 1 && (st) >= 33) { R2_OLD(st, old); } \
            if (VAR != 2 && VAR != 7 && VAR != 8 && (st) + (DIST) < NSTEP) { R2_LOADS((st) + (DIST), rq, rk, rv); } \
              \
            if (VAR != 3 && VAR != 5 && VAR != 7 && VAR != 8 && VAR != 10) { \
                const int mi = wq >> 1, ni = wq & 1; \
                f32x4 pacc = (f32x4){0.f, 0.f, 0.f, 0.f}; \
                const LAS unsigned char* qa = L + R2_Q + (16 * mi + l15) * R2_QS + g * 16; const LAS unsigned char* kb = L + R2_K + (16 * ni + l15) * R2_QS + g * 16; \
                _Pragma("unroll") for (int s_ = 0; s_ < 8; ++s_) pacc = MFMA16(*(const LAS bfx8*)(qa + s_ * 64), *(const LAS bfx8*)(kb + s_ * 64), pacc); \
                const int j = 16 * ni + l15; \
                _Pragma("unroll") for (int r = 0; r < 4; ++r) { const int i = 16 * mi + 4 * g + r; const bool keep = grp == 0 ? (j <= i) : (j < i); \
                    *(LAS bf16*)(L + R2_P + i * R2_PS + j * 2) = (bf16)f2bf(keep ? pacc[r] : 0.f); } \
            } \
            __syncthreads(); \
              \
            if (VAR != 3 && VAR != 5 && VAR != 7 && VAR != 8 && VAR != 11) { \
            const bfx8 vdf = tr16_frag(L + R2_V + (8 * g + q4) * R2_VS + (16 * wq + 4 * p4) * 2, L + R2_V + (8 * g + 4 + q4) * R2_VS + (16 * wq + 4 * p4) * 2); \
            f32x4 oT[2] = {(f32x4){0.f, 0.f, 0.f, 0.f}, (f32x4){0.f, 0.f, 0.f, 0.f}}; \
            _Pragma("unroll") for (int d = 0; d < 16; ++d) S[d] = S[d] * gC; \
            _Pragma("unroll") for (int sh_ = 0; sh_ < 2; ++sh_) { \
                bfx8 qf[4][2]; \
                _Pragma("unroll") for (int s4 = 0; s4 < 4; ++s4) _Pragma("unroll") for (int mt = 0; mt < 2; ++mt) { \
                    qf[s4][mt] = *(const LAS bfx8*)(L + R2_Q2 + (16 * mt + l15) * R2_QS + (32 * (4 * sh_ + s4) + 8 * g) * 2); } \
                __builtin_amdgcn_sched_barrier(0); \
                _Pragma("unroll") for (int s4 = 0; s4 < 4; ++s4) { const int s_ = 4 * sh_ + s4; \
                    const bfx8 sf = pack_acc2(S[2 * s_], S[2 * s_ + 1], 1.0f); \
                    oT[0] = MFMA16(sf, qf[s4][0], oT[0]); oT[1] = MFMA16(sf, qf[s4][1], oT[1]); } \
            } \
            _Pragma("unroll") for (int mt = 0; mt < 2; ++mt) oT[mt] = MFMA16(vdf, *(const LAS bfx8*)(L + R2_P + (16 * mt + l15) * R2_PS + g * 16), oT[mt]); \
            _Pragma("unroll") for (int d = 0; d < 16; ++d) { \
                const bfx8 kf = tr16_frag(L + R2_K + (8 * g + q4) * R2_QS + (16 * d + 4 * p4) * 2, L + R2_K + (8 * g + 4 + q4) * R2_QS + (16 * d + 4 * p4) * 2); \
                S[d] = MFMA16(kf, vdf, S[d]); \
            } \
              \
            if (VAR == 1) { asm volatile("" :: "v"(oT[0]), "v"(oT[1])); } \
            if (VAR != 1 && (st) >= 1) { \
                _Pragma("unroll") for (int mt = 0; mt < 2; ++mt) { \
                    int row; R2_ROW(st, 16 * mt + l15, row); \
                    unsigned long long* dst = (unsigned long long*)(OR + (size_t)row * 2048 + h * 512 + dvs * 64 + 16 * wq + 4 * g); \
                    const float rs = mt ? rs1 : rs0; \
                    float o0 = oT[mt][0] * rs, o1 = oT[mt][1] * rs, o2 = oT[mt][2] * rs, o3 = oT[mt][3] * rs; \
                    if ((st) >= 33) { const unsigned lo = (unsigned)old[mt], hi = (unsigned)(old[mt] >> 32); \
                        o0 += bflo(lo); o1 += bfhi(lo); o2 += bflo(hi); o3 += bfhi(hi); } \
                    *dst = (unsigned long long)pk2(o0, o1) | ((unsigned long long)pk2(o2, o3) << 32); \
                } \
            } \
            } \
            if ((st) == 32) asm volatile("s_waitcnt vmcnt(0)" ::: "memory");       \
            __syncthreads(); \
        } while (0)
        R2_LOADS(0, rqA, rkA, rvA);
#pragma unroll 1
        for (int st = 0; st < NSTEP; ++st) { R2_STEP(st, rqA, rkA, rvA, oldA, oldA, 1); }
#undef R2_STEP
#undef R2_OLD
#undef R2_ROW
#undef R2_LOADS
    }
}

constexpr size_t AR_TBUF = WS_AR + 32 * MiB;
constexpr int DN_REC = 4608, DN_NSTEP = 65;
static_assert(AR_TBUF + (size_t)BATCH * DH * 2 * DN_NSTEP * DN_REC <= AR_GBETA, "TBUF fits the dead RAW_D region");

__device__ __forceinline__ void dn_rows(int b, int dir, int st, int i, int& rq, int& rg) {
    if (dir == 0) { if (st == 0) { if (i >= 16) { rq = NREAL + b * NMETA + (i - 16); rg = NREAL + (i - 16); } else { rq = -1; rg = -1; } }
                    else { rq = b * SEQ + 32 * (st - 1) + i; rg = rq; } }
    else { if (st == 0) { rq = -1; rg = -1; } else { rq = b * SEQ + 32 * (64 - st) + 31 - i; rg = rq; } }
}

__device__ __forceinline__ void p4b_dn_tinv(const Args& a, Frame& F) {
    const bf16* QD = (const bf16*)(a.ws + AR_QKVD); const float* GB = (const float*)(a.ws + AR_GBETA); unsigned char* TB = a.ws + AR_TBUF;
    LAS float* Am = (LAS float*)(F.lds + F.wave * 4352);
    const int lane = F.lane, g = lane >> 4, l15 = lane & 15;
    for (int idx = F.gw; idx < BATCH * DH * 2 * DN_NSTEP; idx += F.NGW) {
        const int st = idx % DN_NSTEP, bhd = idx / DN_NSTEP, dir = bhd & 1, h = (bhd >> 1) & 7, b = bhd >> 4;
        if (dir == 1 && st == 0) continue;
        float gi = 0.f, bi = 0.f;
        { int rq, rg; dn_rows(b, dir, st, lane & 31, rq, rg); if (rg >= 0) { gi = GB[(size_t)rg * 32 + dir * 8 + h]; bi = GB[(size_t)rg * 32 + 16 + dir * 8 + h]; } }
        float bc = gi;
#pragma unroll
        for (int off = 1; off < 32; off <<= 1) { const float t = __shfl_up(bc, off); if ((lane & 31) >= off) bc += t; }
        bfx8 kf[2][4];
#pragma unroll
        for (int mi = 0; mi < 2; ++mi) { int rq, rg; dn_rows(b, dir, st, 16 * mi + l15, rq, rg);
#pragma unroll
            for (int s = 0; s < 4; ++s) { if (rq >= 0) kf[mi][s] = *(const bfx8*)(QD + (size_t)rq * 3072 + 1024 + h * 128 + 32 * s + 8 * g); else kf[mi][s] = (bfx8){0, 0, 0, 0, 0, 0, 0, 0}; } }
#pragma unroll
        for (int mi = 0; mi < 2; ++mi)
#pragma unroll
            for (int ni = 0; ni < 2; ++ni) {
                f32x4 acc = (f32x4){0.f, 0.f, 0.f, 0.f};
#pragma unroll
                for (int s = 0; s < 4; ++s) acc = MFMA16(kf[mi][s], kf[ni][s], acc);
                const int j = 16 * ni + l15; const float bj = __shfl(bc, j);
#pragma unroll
                for (int r = 0; r < 4; ++r) { const int i = 16 * mi + 4 * g + r; const float bi_ = __shfl(bc, i), be = __shfl(bi, i);
                    Am[i * 33 + j] = (i > j) ? be * acc[r] * __expf(bi_ - bj) : 0.f; }
            }
        asm volatile("s_waitcnt lgkmcnt(0)" ::: "memory");
        float T[32];
        const int c = lane & 31;
#pragma unroll
        for (int i = 0; i < 32; ++i) {
            float s0 = (i == c) ? 1.f : 0.f, s1 = 0.f;
#pragma unroll
            for (int j = 0; j < i; ++j) { const float av = Am[i * 33 + j]; if (j & 1) s1 -= av * T[j]; else s0 -= av * T[j]; }
            T[i] = s0 + s1;
        }
        unsigned char* rec = TB + (size_t)idx * DN_REC;
        const float csc = bi * __expf(bc);
        if (lane < 32) {
#pragma unroll
            for (int i = 0; i < 32; ++i) { ((bf16*)rec)[i * 32 + c] = (bf16)f2bf(T[i]); ((bf16*)(rec + 2048))[i * 32 + c] = (bf16)f2bf(T[i] * csc); }
            ((float*)(rec + 4096))[c] = bc; ((float*)(rec + 4224))[c] = bi;
        }
        asm volatile("s_waitcnt lgkmcnt(0)" ::: "memory");
    }
}

constexpr int D5_QS = 288, D5_VS = 144, D5_TS = 80;
constexpr int D5_Q = 0, D5_K = 9216, D5_V = 18432, D5_T = 23040, D5_T2 = 25600, D5_A = 28160, D5_W = 30720, D5_VEC = 39936, D5_Q2 = 40192, D5_GRP = 49408;
__device__ __forceinline__ void p5_scan_dn(const Args& a, Frame& F) {
    const bf16* QD = (const bf16*)(a.ws + AR_QKVD); const unsigned char* TB = a.ws + AR_TBUF; bf16* OD = (bf16*)(a.ws + AR_OD);
    const int sg = F.wave >> 2, grp = (F.wave >> 1) & 1, wq = (F.wave & 1) + 2 * (F.wave >> 2), cw = F.wave & 1, tg = F.tid & 255, lane = F.lane, g = lane >> 4, l15 = lane & 15, q4 = (lane & 15) >> 2, p4 = lane & 3;
    const bool chain = F.wave < 4;
    LAS unsigned char* LS = F.lds + sg * D5_GRP;
    LAS unsigned char* L = F.lds + grp * D5_GRP;
    const LAS float* bcv = (const LAS float*)(L + D5_VEC);
    for (int u = blockIdx.x; u < BATCH * DH * 4; u += F.G) {
        const int bh_ = (u & 7) * 8 + ((u >> 3) >> 2), dvq = (u >> 3) & 3, b = bh_ >> 3, h = bh_ & 7;
        const unsigned char* recbase = TB + (size_t)(((b * DH + h) * 2 + sg) * DN_NSTEP) * DN_REC;
        f32x4 S[8];
#pragma unroll
        for (int d = 0; d < 8; ++d) S[d] = (f32x4){0.f, 0.f, 0.f, 0.f};
        v4u rqA[2], rkA[2], rvA, rtA, rvecA, rqB[2], rkB[2], rvB, rtB, rvecB; float rbetaA, rbetaB;
        unsigned long long oldA[2] = {0ull, 0ull}, oldB[2] = {0ull, 0ull};
#define D5_LOADS(st, rq, rk, rv, rt, rvec, rbeta) do { \
        _Pragma("unroll") for (int i_ = 0; i_ < 2; ++i_) { const int cid = tg + 256 * i_, ti = cid >> 4, c16 = cid & 15; int r_, rg_; dn_rows(b, sg, (st), ti, r_, rg_); \
            if (r_ >= 0) { const bf16* src = QD + (size_t)r_ * 3072 + h * 128 + c16 * 8; rq[i_] = *(const v4u*)src; rk[i_] = *(const v4u*)(src + 1024); } \
            else { rq[i_] = (v4u){0u, 0u, 0u, 0u}; rk[i_] = (v4u){0u, 0u, 0u, 0u}; } } \
        { const int ti = (tg >> 2) & 31, c16 = tg & 3; int r_, rg_; dn_rows(b, sg, (st), ti, r_, rg_); \
            if (r_ >= 0 && tg < 128) rv = *(const v4u*)(QD + (size_t)r_ * 3072 + 2048 + h * 128 + dvq * 32 + c16 * 8); else rv = (v4u){0u, 0u, 0u, 0u}; } \
        if (sg == 0 || (st) >= 1) { const unsigned char* rec = recbase + (size_t)(st) * DN_REC; rt = *(const v4u*)(rec + tg * 16); rbeta = *(const float*)(rec + 4224 + ((tg >> 2) & 31) * 4); \
            if (tg < 16) rvec = *(const v4u*)(rec + 4096 + tg * 16); } \
        else { rt = (v4u){0u, 0u, 0u, 0u}; rbeta = 0.f; rvec = (v4u){0u, 0u, 0u, 0u}; } } while (0)
#define D5_OLD(st, old) do { _Pragma("unroll") for (int mt_ = 0; mt_ < 2; ++mt_) { int row, rg_; dn_rows(b, grp, (st), 16 * mt_ + l15, row, rg_); \
            old[mt_] = __hip_atomic_load((unsigned long long*)(OD + (size_t)row * 1024 + h * 128 + dvq * 32 + 16 * cw + 4 * g), RLX_AGENT); } } while (0)
#define D5_STEP(st, rq, rk, rv, rt, rvec, rbeta, old, oldn) do { \
              \
            _Pragma("unroll") for (int i_ = 0; i_ < 2; ++i_) { const int cid = tg + 256 * i_, ti = cid >> 4, c16 = cid & 15; \
                *(LAS v4u*)(LS + D5_Q + ti * D5_QS + c16 * 16) = rq[i_]; *(LAS v4u*)(LS + D5_K + ti * D5_QS + c16 * 16) = rk[i_]; \
                { const int cc = c16 & 3, pb = (c16 >> 2) * 64 + (16 * (cc & 1) + 4 * (cc >> 1)) * 2; \
                  *(LAS v2u*)(LS + D5_Q2 + ti * D5_QS + pb) = (v2u){rq[i_].x, rq[i_].y}; *(LAS v2u*)(LS + D5_Q2 + ti * D5_QS + pb + 16) = (v2u){rq[i_].z, rq[i_].w}; } } \
            if (tg < 128) { const int ti = tg >> 2, c16 = tg & 3; v4u w; \
                w.x = pk2(bflo(rv.x) * rbeta, bfhi(rv.x) * rbeta); w.y = pk2(bflo(rv.y) * rbeta, bfhi(rv.y) * rbeta); \
                w.z = pk2(bflo(rv.z) * rbeta, bfhi(rv.z) * rbeta); w.w = pk2(bflo(rv.w) * rbeta, bfhi(rv.w) * rbeta); \
                *(LAS v4u*)(LS + D5_V + ti * D5_VS + c16 * 16) = w; } \
            { const int tsel = tg >> 7, c = tg & 127; *(LAS v4u*)(LS + (tsel ? D5_T2 : D5_T) + (c >> 2) * D5_TS + (c & 3) * 16) = rt; } \
            if (tg < 16) *(LAS v4u*)(LS + D5_VEC + tg * 16) = rvec; \
            __syncthreads(); \
            if (chain && (st) == 33) { D5_OLD(33, old); } \
            if (chain && (st) + 1 >= 34 && (st) + 1 < DN_NSTEP) { D5_OLD((st) + 1, oldn); } \
            if ((st) + 2 < DN_NSTEP) { D5_LOADS((st) + 2, rq, rk, rv, rt, rvec, rbeta); } \
              \
            { \
                const int mi = wq >> 1, ni = wq & 1; \
                f32x4 pacc = (f32x4){0.f, 0.f, 0.f, 0.f}; \
                const LAS unsigned char* qa = L + D5_Q + (16 * mi + l15) * D5_QS + g * 16; const LAS unsigned char* kb = L + D5_K + (16 * ni + l15) * D5_QS + g * 16; \
                _Pragma("unroll") for (int s_ = 0; s_ < 4; ++s_) pacc = MFMA16(*(const LAS bfx8*)(qa + s_ * 64), *(const LAS bfx8*)(kb + s_ * 64), pacc); \
                const int j = 16 * ni + l15; const float bj = bcv[j]; \
                _Pragma("unroll") for (int r = 0; r < 4; ++r) { const int i = 16 * mi + 4 * g + r; \
                    *(LAS bf16*)(L + D5_A + i * D5_TS + (8 * ((j & 15) >> 2) + 4 * (j >> 4) + (j & 3)) * 2) = (bf16)f2bf((j <= i) ? pacc[r] * __expf(bcv[i] - bj) : 0.f); } \
                _Pragma("unroll") for (int dd = 0; dd < 2; ++dd) { const int d = 2 * wq + dd; \
                    const bfx8 kf = tr16_frag(L + D5_K + (8 * g + q4) * D5_QS + (16 * d + 4 * p4) * 2, L + D5_K + (8 * g + 4 + q4) * D5_QS + (16 * d + 4 * p4) * 2); \
                    _Pragma("unroll") for (int mt = 0; mt < 2; ++mt) { \
                        f32x4 wacc = MFMA16(kf, *(const LAS bfx8*)(L + D5_T2 + (16 * mt + l15) * D5_TS + g * 16), ((f32x4){0.f, 0.f, 0.f, 0.f})); \
                        v2u w; w.x = pk2(-wacc[0], -wacc[1]); w.y = pk2(-wacc[2], -wacc[3]); \
                        *(LAS v2u*)(L + D5_W + (16 * mt + l15) * D5_QS + (32 * (d >> 1) + 8 * g + 4 * (d & 1)) * 2) = w; \
                    } \
                } \
            } \
            __syncthreads(); \
              \
            if (chain) { \
            const float blast = bcv[31], eL = __expf(blast); \
            const bfx8 vf = tr16_frag(L + D5_V + (8 * g + q4) * D5_VS + (16 * cw + 4 * p4) * 2, L + D5_V + (8 * g + 4 + q4) * D5_VS + (16 * cw + 4 * p4) * 2); \
            f32x4 vn[2], o1[2]; \
            _Pragma("unroll") for (int mt = 0; mt < 2; ++mt) { vn[mt] = MFMA16(*(const LAS bfx8*)(L + D5_T + (16 * mt + l15) * D5_TS + g * 16), vf, ((f32x4){0.f, 0.f, 0.f, 0.f})); o1[mt] = (f32x4){0.f, 0.f, 0.f, 0.f}; } \
            _Pragma("unroll") for (int s_ = 0; s_ < 4; ++s_) { \
                const bfx8 sf = pack_acc2(S[2 * s_], S[2 * s_ + 1], 1.0f); \
                _Pragma("unroll") for (int mt = 0; mt < 2; ++mt) { \
                    vn[mt] = MFMA16(*(const LAS bfx8*)(L + D5_W + (16 * mt + l15) * D5_QS + (32 * s_ + 8 * g) * 2), sf, vn[mt]); \
                    o1[mt] = MFMA16(sf, *(const LAS bfx8*)(L + D5_Q2 + (16 * mt + l15) * D5_QS + (32 * s_ + 8 * g) * 2), o1[mt]); \
                } \
            } \
            const bfx8 vnf = pack_acc2(vn[0], vn[1], 1.0f); \
            f32x4 vs0, vs1; \
            _Pragma("unroll") for (int r = 0; r < 4; ++r) { vs0[r] = vn[0][r] * __expf(blast - bcv[4 * g + r]); vs1[r] = vn[1][r] * __expf(blast - bcv[16 + 4 * g + r]); } \
            const bfx8 vnsf = pack_acc2(vs0, vs1, 1.0f); \
            f32x4 o2[2]; \
            _Pragma("unroll") for (int mt = 0; mt < 2; ++mt) o2[mt] = MFMA16(vnf, *(const LAS bfx8*)(L + D5_A + (16 * mt + l15) * D5_TS + g * 16), ((f32x4){0.f, 0.f, 0.f, 0.f})); \
            _Pragma("unroll") for (int d = 0; d < 8; ++d) { \
                const bfx8 kp = tr16_frag(L + D5_K + (4 * g + q4) * D5_QS + (16 * d + 4 * p4) * 2, L + D5_K + (16 + 4 * g + q4) * D5_QS + (16 * d + 4 * p4) * 2); \
                S[d] = MFMA16(kp, vnsf, S[d] * eL); \
            } \
              \
            if ((st) >= 1) { \
                _Pragma("unroll") for (int mt = 0; mt < 2; ++mt) { \
                    const int i = 16 * mt + l15; int row, rg_; dn_rows(b, grp, (st), i, row, rg_); \
                    unsigned long long* dst = (unsigned long long*)(OD + (size_t)row * 1024 + h * 128 + dvq * 32 + 16 * cw + 4 * g); \
                    const float ei = __expf(bcv[i]); \
                    float x0 = o1[mt][0] * ei + o2[mt][0], x1 = o1[mt][1] * ei + o2[mt][1], x2 = o1[mt][2] * ei + o2[mt][2], x3 = o1[mt][3] * ei + o2[mt][3]; \
                    if ((st) >= 33) { const unsigned lo = (unsigned)old[mt], hi = (unsigned)(old[mt] >> 32); \
                        x0 += bflo(lo); x1 += bfhi(lo); x2 += bflo(hi); x3 += bfhi(hi); } \
                    *dst = (unsigned long long)pk2(x0, x1) | ((unsigned long long)pk2(x2, x3) << 32); \
                } \
            } \
            } \
            if ((st) == 32) asm volatile("s_waitcnt vmcnt(0)" ::: "memory"); \
            __syncthreads(); \
        } while (0)
        D5_LOADS(0, rqA, rkA, rvA, rtA, rvecA, rbetaA);
        D5_LOADS(1, rqB, rkB, rvB, rtB, rvecB, rbetaB);
#pragma unroll 1
        for (int st = 0; st < DN_NSTEP; st += 2) {
            D5_STEP(st, rqA, rkA, rvA, rtA, rvecA, rbetaA, oldA, oldB);
            if (st + 1 < DN_NSTEP) { D5_STEP(st + 1, rqB, rkB, rvB, rtB, rvecB, rbetaB, oldB, oldA); }
        }
#undef D5_STEP
#undef D5_OLD
#undef D5_LOADS
    }
}

#ifndef PROBE_VARIANT
#define PROBE_VARIANT 0
#endif
#ifndef PROBE_PHASE
#define PROBE_PHASE -1
#endif

constexpr int NPHASES = 16;
__global__ void __launch_bounds__(NTHREADS, 2) fwd_kernel(Args args) {
    extern __shared__ __attribute__((aligned(16))) unsigned char lds_raw[];
    Frame F;
    F.lds = (LAS unsigned char*)lds_raw;
    F.tid = threadIdx.x; F.lane = F.tid & 63; F.wave = __builtin_amdgcn_readfirstlane(F.tid >> 6);
    F.G = gridDim.x; F.gw = blockIdx.x * NWAVES + F.wave; F.NGW = F.G * NWAVES;
    volatile LAS unsigned* MISC = (volatile LAS unsigned*)(F.lds + MISC_OFF);
    for (int u = F.tid; u < (LDS_BYTES - RING_BYTES) / 4; u += NTHREADS) ((LAS unsigned*)(F.lds + RING_BYTES))[u] = 0u;
    __syncthreads();
    unsigned* ctl = (unsigned*)(args.ws + WS_CTL);
    const int lo = args.ph_lo, hi = args.ph_hi;
    XcdBarrier bar; bar.bar = ctl + CW_BAR; bar.x = 0; bar.st = nullptr;
    if (hi - lo > 1) bar = xcd_barrier_post(ctl + CW_BAR, MISC + 8);
#define IN(k) (lo <= (k) && (k) < hi)
#define SEAM(k) do { if (IN(k) && IN((k) + 1)) xcd_barrier(bar); } while (0)
    unsigned char* ws = args.ws;
    bf16* HB = (bf16*)(ws + WS_HB); bf16* WT = (bf16*)(ws + WS_WT);

    if (IN(0)) { p0_prologue(args, F); } SEAM(0);
    if (IN(1)) {
        pg8::Gemm g{HB, WT + (size_t)WT_A0 * D, MROWS, WT_A_N, D}; pg8::StaticOrder S; S.init(MROWS, WT_A_N, F.G, (int)blockIdx.x);
        ep::EpiRot E{(bf16*)(ws + AR_QKVR)};
        pg8::gemm_phase<ep::EpiRot, pg8::StaticOrder, true, true>(F.lds, g, S, E);
    } SEAM(1);
    if (IN(2)) { if (args.variant == 0) p2_scan_ret<0>(args, F); else p2_scan_ret<PROBE_VARIANT>(args, F); } SEAM(2);
    if (IN(3)) {
        pg8::Gemm g{HB, WT + (size_t)WT_B0 * D, MROWS, WT_B_N, D}; pg8::StaticOrder S; S.init(MROWS, WT_B_N, F.G, (int)blockIdx.x);
        ep::EpiDn E{(bf16*)(ws + AR_RAWD), (float*)(ws + AR_GBETA), args.dn_a_log, args.dn_dt_bias};
        pg8::gemm_phase<ep::EpiDn, pg8::StaticOrder, true, true>(F.lds, g, S, E);
    } SEAM(3);
    if (IN(4)) { p4_conv(args, F); } SEAM(4);
    if (IN(5)) { p4b_dn_tinv(args, F); } SEAM(5);
    if (IN(6)) { p5_scan_dn(args, F); } SEAM(6);
    if (IN(7)) {
        p6_small_weights(args, F);
        __syncthreads();
        pg8::Gemm g{HB, WT + (size_t)WT_C0 * D, NREAL, WT_C_N, D}; pg8::StaticOrder S; S.init(NREAL, WT_C_N, F.G, (int)blockIdx.x);
        ep::EpiGates E{(bf16*)(ws + AR_GRG), (bf16*)(ws + AR_GDZ), (bf16*)(ws + AR_GGA), (bf16*)(ws + AR_GGB)};
        pg8::gemm_phase<ep::EpiGates, pg8::StaticOrder, true, true>(F.lds, g, S, E);
    } SEAM(7);
    if (IN(8)) { p7_gate_norm(args, F); } SEAM(8);
    if (IN(9)) {
        pg8::Gemm g{(const bf16*)args.out, (const bf16*)(ws + AR_PRETT), NREAL, 1024, 2048}; pg8::StaticOrder S; S.init(NREAL, 1024, F.G, (int)blockIdx.x);
        ep::EpiMerge<false> E{(const bf16*)(ws + AR_GGA), nullptr, (bf16*)(ws + AR_M1)};
        pg8::gemm_phase<ep::EpiMerge<false>, pg8::StaticOrder, true, true>(F.lds, g, S, E);
    } SEAM(9);
    if (IN(10)) {
        pg8::Gemm g{(const bf16*)(ws + AR_OD), (const bf16*)(ws + AR_PDNT), NREAL, 1024, 1024}; pg8::StaticOrder S; S.init(NREAL, 1024, F.G, (int)blockIdx.x);
        ep::EpiMerge<true> E{(const bf16*)(ws + AR_GGB), (const bf16*)(ws + AR_M1), (bf16*)(ws + AR_MERGED)};
        pg8::gemm_phase<ep::EpiMerge<true>, pg8::StaticOrder, true, true>(F.lds, g, S, E);
    } SEAM(10);
    if (IN(11)) {
        pg8::Gemm g{(const bf16*)(ws + AR_MERGED), (const bf16*)(ws + AR_WOUTT), NREAL, 1024, 1024}; pg8::StaticOrder S; S.init(NREAL, 1024, F.G, (int)blockIdx.x);
        ep::EpiRes E{HB, (float*)(ws + AR_PRE)};
        pg8::gemm_phase<ep::EpiRes, pg8::StaticOrder, true, true>(F.lds, g, S, E);
    } SEAM(11);
    if (IN(12)) { p11_ln1_tables(args, F); } SEAM(12);
    if (IN(13)) {
        pg8::Gemm g{(const bf16*)(ws + AR_H1), (const bf16*)(ws + AR_W2T), NREAL, 2048, 1024}; pg8::StaticOrder S; S.init(NREAL, 2048, F.G, (int)blockIdx.x);
        ep::EpiF32 E{(float*)(ws + AR_SCORES), 2048};
        pg8::gemm_phase<ep::EpiF32, pg8::StaticOrder, true, true>(F.lds, g, S, E);
    } SEAM(13);
    if (IN(14)) { p13_topk(args, F); } SEAM(14);
    if (IN(15)) { p14_gather(args, F); }
#undef IN
#undef SEAM
}

#ifndef N_LAUNCH_MODE
#define N_LAUNCH_MODE 1
#endif
extern "C" void kernel_launch(void* const* d_in, const int* in_sizes, int n_in, void* d_out, int out_size, void* d_ws, size_t ws_size, hipStream_t stream) {
    static int grid = 0;
    if (grid == 0) {
        if (n_in != 21 || out_size != NREAL * D || ws_size < WS_END) { fprintf(stderr, "kernel_launch: unexpected shapes (n_in %d, out %d, ws %zu)\n", n_in, out_size, ws_size); grid = -1; return; }
        int dev = 0, cus = 0;
        if (hipGetDevice(&dev) != hipSuccess || hipDeviceGetAttribute(&cus, hipDeviceAttributeMultiprocessorCount, dev) != hipSuccess) { grid = -1; return; }
        if (hipFuncSetAttribute((const void*)fwd_kernel, hipFuncAttributeMaxDynamicSharedMemorySize, LDS_BYTES) != hipSuccess) { grid = -1; return; }
        int per_cu = 0;
        (void)hipOccupancyMaxActiveBlocksPerMultiprocessor(&per_cu, (const void*)fwd_kernel, NTHREADS, LDS_BYTES);
        (void)hipGetLastError();
        grid = cus;
    }
    if (grid < 0) return;
    (void)hipMemsetAsync((char*)d_ws + WS_CTL, 0, CTL_ZERO_BYTES, stream);
    Args a{};
    const float** fp = (const float**)&a;
    for (int i = 0; i < 21; ++i) fp[i] = (const float*)d_in[i];
    a.out = (float*)d_out; a.ws = (unsigned char*)d_ws;
    if (N_LAUNCH_MODE == 1) {
#if PROBE_PHASE >= 0 && PROBE_PHASE < 13
        a.ph_lo = PROBE_PHASE; a.ph_hi = PROBE_PHASE + 1; a.variant = 1;
        hipLaunchKernelGGL(fwd_kernel, dim3(grid), dim3(NTHREADS), LDS_BYTES, stream, a);
        a.variant = 0;
#endif
        a.ph_lo = 0; a.ph_hi = NPHASES;
        hipLaunchKernelGGL(fwd_kernel, dim3(grid), dim3(NTHREADS), LDS_BYTES, stream, a);
#if PROBE_PHASE >= 13
        a.ph_lo = PROBE_PHASE; a.ph_hi = PROBE_PHASE + 1;
        hipLaunchKernelGGL(fwd_kernel, dim3(grid), dim3(NTHREADS), LDS_BYTES, stream, a);
#endif
    } else {
        for (int p = 0; p < NPHASES; ++p) { a.ph_lo = p; a.ph_hi = p + 1; hipLaunchKernelGGL(fwd_kernel, dim3(grid), dim3(NTHREADS), LDS_BYTES, stream, a); }
    }
}
```
